# Optimizing an MI355X kernel written in HIP

```python
import jax, jax.numpy as jnp
from jax import lax
import numpy as np

D_MODEL = 1024
BATCH = 8
SEQ = 2048
DEPTH = 2
DEC_BATCH = 128
DEC_SEQ = 8
PAST_LEN = 16384
PAGE_SIZE = 128

N_META = 16
N_MIXERS = 2
N_GDN_LAYERS = (DEPTH + 1) // 2
N_RWKV_LAYERS = DEPTH // 2
GDN_QK_HEADS = 8
GDN_V_HEADS = 16
GDN_HEAD_K = 128
GDN_HEAD_V = 128
GDN_KEY_DIM = GDN_QK_HEADS * GDN_HEAD_K
GDN_VALUE_DIM = GDN_V_HEADS * GDN_HEAD_V
GDN_CONV_DIM = 2 * GDN_KEY_DIM + GDN_VALUE_DIM
GDN_IN_DIM = GDN_CONV_DIM + GDN_VALUE_DIM + 2 * GDN_V_HEADS
CONV_W = 4
CHUNK = 64
RWKV_HEAD = 64
RWKV_HEADS = D_MODEL // RWKV_HEAD
DECAY_LORA = 64
A_LORA = 64
RMS_EPS = 1e-6
GN_EPS = 64e-5

kernel_name = "gdn_rwkv7_hybrid_step"


def rmsnorm(x, w):
    xf = x.astype(jnp.float32)
    return xf * lax.rsqrt(jnp.mean(xf * xf, -1, keepdims=True) + RMS_EPS) * w.astype(jnp.float32)


def l2norm(x, eps=1e-6):
    return x * lax.rsqrt(jnp.sum(x * x, -1, keepdims=True) + eps)


def causal_conv(u, buf, w):
    T = u.shape[1]
    up = jnp.concatenate([buf.astype(u.dtype), u], 1)
    y = up[:, 0:T] * w[:, 0]
    for j in range(1, CONV_W):
        y = y + up[:, j:j + T] * w[:, j]
    return jax.nn.silu(y), up[:, up.shape[1] - (CONV_W - 1):]


def gdn_chunked(q, k, v, g, beta, S0, chunk):
    B, T, H, DK = q.shape
    DV = v.shape[-1]
    n = T // chunk

    def blocks(t):
        t = t.reshape((B, n, chunk) + t.shape[2:])
        return t.transpose((1, 0, 3, 2) + tuple(range(4, t.ndim)))

    q, k, v, g, beta = blocks(q), blocks(k), blocks(v), blocks(g), blocks(beta)
    gc = jnp.cumsum(g, axis=-1)
    causal = jnp.tril(jnp.ones((chunk, chunk), bool))
    strict = jnp.tril(jnp.ones((chunk, chunk), bool), -1)
    decay = jnp.exp(jnp.where(causal, gc[..., :, None] - gc[..., None, :], -jnp.inf))
    kb = k * beta[..., None]
    vb = v * beta[..., None]
    L = jnp.where(strict, jnp.einsum('nbhik,nbhjk->nbhij', kb, k) * decay, 0.0)
    A = L + jnp.eye(chunk, dtype=L.dtype)
    rhs = jnp.concatenate([vb, kb * jnp.exp(gc)[..., None]], -1)
    sol = lax.linalg.triangular_solve(A, rhs, left_side=True, lower=True, unit_diagonal=True)
    u, wk = sol[..., :DV], sol[..., DV:]
    attn = jnp.einsum('nbhik,nbhjk->nbhij', q, k) * decay
    g_last = gc[..., -1]
    k_dec = k * jnp.exp(g_last[..., None] - gc)[..., None]
    q_dec = q * jnp.exp(gc)[..., None]

    def step(S, inp):
        u_c, w_c, a_c, qd_c, kd_c, gl_c = inp
        v_new = u_c - jnp.einsum('bhck,bhkv->bhcv', w_c, S)
        o = jnp.einsum('bhck,bhkv->bhcv', qd_c, S) + jnp.einsum('bhij,bhjv->bhiv', a_c, v_new)
        S = S * jnp.exp(gl_c)[..., None, None] + jnp.einsum('bhck,bhcv->bhkv', kd_c, v_new)
        return S, o

    S, o = lax.scan(step, S0.astype(jnp.float32), (u, wk, attn, q_dec, k_dec, g_last))
    return o.transpose(1, 0, 3, 2, 4).reshape(B, T, H, DV), S


def gdn_mixer(xn, S0, conv_buf, w_in, conv_w, a_log, dt_bias, gn_w, w_out, segments):
    B, T, _ = xn.shape
    proj = xn @ w_in
    c1 = GDN_CONV_DIM
    c2 = c1 + GDN_VALUE_DIM
    c3 = c2 + GDN_V_HEADS
    qkv, z, b, a = proj[..., :c1], proj[..., c1:c2], proj[..., c2:c3], proj[..., c3:]
    qkv, new_buf = causal_conv(qkv, conv_buf, conv_w)
    rep = GDN_V_HEADS // GDN_QK_HEADS
    q = jnp.repeat(l2norm(qkv[..., :GDN_KEY_DIM].reshape(B, T, GDN_QK_HEADS, GDN_HEAD_K)), rep, axis=2) * (GDN_HEAD_K ** -0.5)
    k = jnp.repeat(l2norm(qkv[..., GDN_KEY_DIM:2 * GDN_KEY_DIM].reshape(B, T, GDN_QK_HEADS, GDN_HEAD_K)), rep, axis=2)
    v = qkv[..., 2 * GDN_KEY_DIM:].reshape(B, T, GDN_V_HEADS, GDN_HEAD_V)
    beta = jax.nn.sigmoid(b)
    g = -jnp.exp(a_log.astype(jnp.float32)) * jax.nn.softplus(a + dt_bias)
    S = S0
    outs = []
    start = 0
    for length, chunk in segments:
        o_seg, S = gdn_chunked(q[:, start:start + length], k[:, start:start + length], v[:, start:start + length],
                               g[:, start:start + length], beta[:, start:start + length], S, chunk)
        outs.append(o_seg)
        start += length
    o = jnp.concatenate(outs, 1)
    o = rmsnorm(o, gn_w) * jax.nn.silu(z.reshape(B, T, GDN_V_HEADS, GDN_HEAD_V))
    return o.reshape(B, T, GDN_VALUE_DIM) @ w_out, S, new_buf


def rwkv_mixer(xn, S0, shift_prev, mu, w_rkvz, w0, w1, w2, a0, a1, a2, k_k, k_a, r_k, lnx_w, lnx_b, w_o):
    B, T, D = xn.shape
    H, N = RWKV_HEADS, RWKV_HEAD
    xprev = jnp.concatenate([shift_prev[:, None].astype(jnp.float32), xn[:, :-1]], 1)
    xx = xprev - xn
    xs = xn[None] + xx[None] * mu[:, None, None, :]
    rkvz = jnp.einsum('sbtd,sde->sbte', xs[:4], w_rkvz)
    r, k, v, z = rkvz[0], rkvz[1], rkvz[2], rkvz[3]
    w = -jax.nn.softplus(-(w0 + jnp.tanh(xs[4] @ w1) @ w2)) - 0.5
    a = jax.nn.sigmoid(a0 + (xs[5] @ a1) @ a2)
    kk = l2norm((k * k_k).reshape(B, T, H, N))
    k = k * (1.0 + (a - 1.0) * k_a)
    decay = jnp.exp(-jnp.exp(w))
    hs = lambda t: t.reshape(B, T, H, N)
    r_h, k_h, v_h, a_h, d_h = hs(r), hs(k), hs(v), hs(a), hs(decay)
    b_h = kk * a_h
    tm = lambda t: t.transpose(1, 0, 2, 3)

    def step(S, inp):
        r_t, k_t, v_t, d_t, kk_t, b_t = inp
        S = (S * d_t[:, :, None, :]
             + jnp.einsum('bhvk,bhk->bhv', S, -kk_t)[..., None] * b_t[:, :, None, :]
             + v_t[..., None] * k_t[:, :, None, :])
        return S, jnp.einsum('bhvk,bhk->bhv', S, r_t)

    S, y = lax.scan(step, S0.astype(jnp.float32), (tm(r_h), tm(k_h), tm(v_h), tm(d_h), tm(kk), tm(b_h)))
    y = y.transpose(1, 0, 2, 3)
    mean = jnp.mean(y, -1, keepdims=True)
    var = jnp.mean(jnp.square(y - mean), -1, keepdims=True)
    y = (y - mean) * lax.rsqrt(var + GN_EPS) * lnx_w.reshape(H, N) + lnx_b.reshape(H, N)
    y = y + jnp.sum(r_h * k_h * r_k, -1, keepdims=True) * v_h
    y = y.reshape(B, T, D) * jax.nn.silu(z)
    return y @ w_o, S, xn[:, -1]


def trunk(x, gdn_S, gdn_conv, rwkv_S, rwkv_shift, norm_w, final_norm_w, gdn_p, rwkv_p, segments):
    new_gdn_S, new_gdn_conv, new_rwkv_S, new_rwkv_shift = [], [], [], []
    for i in range(DEPTH):
        xn = rmsnorm(x, norm_w[i])
        j = i // N_MIXERS
        if i % N_MIXERS == 0:
            out, S, buf = gdn_mixer(xn, gdn_S[j], gdn_conv[j], *[p[j] for p in gdn_p], segments)
            new_gdn_S.append(S)
            new_gdn_conv.append(buf)
        else:
            out, S, sh = rwkv_mixer(xn, rwkv_S[j], rwkv_shift[j], *[p[j] for p in rwkv_p])
            new_rwkv_S.append(S)
            new_rwkv_shift.append(sh)
        x = x + out.astype(x.dtype)
    y = rmsnorm(x, final_norm_w).astype(x.dtype)
    return y, jnp.stack(new_gdn_S), jnp.stack(new_gdn_conv), jnp.stack(new_rwkv_S), jnp.stack(new_rwkv_shift)


def setup_inputs(seed: int = 0) -> dict:
    key = jax.random.key(seed)
    ks = jax.random.split(key, 32)
    nrm = jax.random.normal
    uni = jax.random.uniform
    D = D_MODEL
    NA, NB = N_GDN_LAYERS, N_RWKV_LAYERS
    dt = jnp.exp(uni(ks[12], (NA, GDN_V_HEADS), minval=float(np.log(1e-3)), maxval=float(np.log(1e-1))))
    return {
        'x_prompt': nrm(ks[0], (BATCH, SEQ, D)),
        'x_sample': nrm(ks[1], (DEC_BATCH, DEC_SEQ, D)),
        'state_gdn': 0.05 * nrm(ks[2], (NA, DEC_BATCH, GDN_V_HEADS, GDN_HEAD_K, GDN_HEAD_V)),
        'state_gdn_conv': nrm(ks[3], (NA, DEC_BATCH, CONV_W - 1, GDN_CONV_DIM)),
        'state_rwkv': 0.1 * nrm(ks[4], (NB, DEC_BATCH, RWKV_HEADS, RWKV_HEAD, RWKV_HEAD)),
        'state_rwkv_shift': nrm(ks[5], (NB, DEC_BATCH, D)),
        'meta_tokens': nrm(ks[6], (N_META, D)),
        'norm_w': 1.0 + 0.01 * nrm(ks[7], (DEPTH, D)),
        'final_norm_w': 1.0 + 0.01 * nrm(ks[8], (D,)),
        'gdn_w_in': nrm(ks[9], (NA, D, GDN_IN_DIM)) * D ** -0.5,
        'gdn_conv_w': nrm(ks[10], (NA, GDN_CONV_DIM, CONV_W)) * CONV_W ** -0.5,
        'gdn_a_log': jnp.log(uni(ks[11], (NA, GDN_V_HEADS), minval=1.0, maxval=16.0)),
        'gdn_dt_bias': dt + jnp.log(-jnp.expm1(-dt)),
        'gdn_norm_w': 1.0 + 0.01 * nrm(ks[13], (NA, GDN_HEAD_V)),
        'gdn_w_out': nrm(ks[14], (NA, GDN_VALUE_DIM, D)) * GDN_VALUE_DIM ** -0.5,
        'rwkv_mu': uni(ks[15], (NB, 6, D)),
        'rwkv_w_rkvz': nrm(ks[16], (NB, 4, D, D)) * D ** -0.5,
        'rwkv_w0': uni(ks[17], (NB, D), minval=-6.0, maxval=-1.0),
        'rwkv_w1': 0.1 * nrm(ks[18], (NB, D, DECAY_LORA)) * D ** -0.5,
        'rwkv_w2': 0.1 * nrm(ks[19], (NB, DECAY_LORA, D)) * DECAY_LORA ** -0.5,
        'rwkv_a0': 0.1 * nrm(ks[20], (NB, D)),
        'rwkv_a1': nrm(ks[21], (NB, D, A_LORA)) * D ** -0.5,
        'rwkv_a2': 0.1 * nrm(ks[22], (NB, A_LORA, D)) * A_LORA ** -0.5,
        'rwkv_k_k': 0.85 + 0.05 * nrm(ks[23], (NB, D)),
        'rwkv_k_a': 1.0 + 0.05 * nrm(ks[24], (NB, D)),
        'rwkv_r_k': 0.1 * nrm(ks[25], (NB, RWKV_HEADS, RWKV_HEAD)),
        'rwkv_lnx_w': 1.0 + 0.01 * nrm(ks[26], (NB, D)),
        'rwkv_lnx_b': 0.01 * nrm(ks[27], (NB, D)),
        'rwkv_w_o': nrm(ks[28], (NB, D, D)) * D ** -0.5,
    }


def reference(x_prompt, x_sample, state_gdn, state_gdn_conv, state_rwkv, state_rwkv_shift,
              meta_tokens, norm_w, final_norm_w,
              gdn_w_in, gdn_conv_w, gdn_a_log, gdn_dt_bias, gdn_norm_w, gdn_w_out,
              rwkv_mu, rwkv_w_rkvz, rwkv_w0, rwkv_w1, rwkv_w2, rwkv_a0, rwkv_a1, rwkv_a2,
              rwkv_k_k, rwkv_k_a, rwkv_r_k, rwkv_lnx_w, rwkv_lnx_b, rwkv_w_o):
    gdn_p = (gdn_w_in, gdn_conv_w, gdn_a_log, gdn_dt_bias, gdn_norm_w, gdn_w_out)
    rwkv_p = (rwkv_mu, rwkv_w_rkvz, rwkv_w0, rwkv_w1, rwkv_w2, rwkv_a0, rwkv_a1, rwkv_a2,
              rwkv_k_k, rwkv_k_a, rwkv_r_k, rwkv_lnx_w, rwkv_lnx_b, rwkv_w_o)
    f32 = jnp.float32
    Bp, Tp, _ = x_prompt.shape
    meta = jnp.broadcast_to(meta_tokens.astype(x_prompt.dtype)[None], (Bp, N_META, D_MODEL))
    xp = jnp.concatenate([meta, x_prompt], 1)
    z_gdn = jnp.zeros((N_GDN_LAYERS, Bp, GDN_V_HEADS, GDN_HEAD_K, GDN_HEAD_V), f32)
    z_conv = jnp.zeros((N_GDN_LAYERS, Bp, CONV_W - 1, GDN_CONV_DIM), f32)
    z_rwkv = jnp.zeros((N_RWKV_LAYERS, Bp, RWKV_HEADS, RWKV_HEAD, RWKV_HEAD), f32)
    z_shift = jnp.zeros((N_RWKV_LAYERS, Bp, D_MODEL), f32)
    y_p, p_gdn, p_gdn_conv, p_rwkv, p_rwkv_shift = trunk(
        xp, z_gdn, z_conv, z_rwkv, z_shift, norm_w, final_norm_w, gdn_p, rwkv_p,
        ((N_META, N_META), (Tp, CHUNK)))
    y_prompt = y_p[:, N_META:]
    Ts = x_sample.shape[1]
    y_sample, s_gdn, s_gdn_conv, s_rwkv, s_rwkv_shift = trunk(
        x_sample, state_gdn, state_gdn_conv, state_rwkv, state_rwkv_shift, norm_w, final_norm_w,
        gdn_p, rwkv_p, ((Ts, Ts),))
    return (y_prompt, y_sample, p_gdn, p_gdn_conv, p_rwkv, p_rwkv_shift, s_gdn, s_gdn_conv, s_rwkv, s_rwkv_shift)
```

```cpp
#include <hip/hip_runtime.h>
#include <hip/hip_cooperative_groups.h>
#include <cstdio>
#include <cstring>
namespace cg = cooperative_groups;

#ifndef MK_COOP
#define MK_COOP 1
#endif

typedef _Float16 h16;
typedef _Float16 h16x8 __attribute__((ext_vector_type(8)));
typedef _Float16 h16x4 __attribute__((ext_vector_type(4)));
typedef _Float16 h16x2 __attribute__((ext_vector_type(2)));
typedef float f32x4 __attribute__((ext_vector_type(4)));
typedef float f32x2 __attribute__((ext_vector_type(2)));

namespace pg8 {
#define PG8_LAS __attribute__((address_space(3)))
constexpr int BM = 256, BK = 64, HALF = 128, HTB = HALF * BK * 2, STAGE_BYTES = 8 * HTB, NXCD = 8, WGM = 8;
__host__ __device__ __forceinline__ int lds_byte(int r, int c) { const int st = (r >> 4) * 2 + (c >> 5), rr = r & 15, cc = c & 31, ob = rr * 64 + cc * 2; return st * 1024 + (ob ^ (((ob >> 9) & 1) << 5)); }
__host__ __device__ __forceinline__ void stage_rc(int b, int& R, int& C) { const int st = b / 1024, sb = b % 1024, swz = sb ^ (((sb >> 9) & 1) << 5); R = (st >> 1) * 16 + swz / 64; C = (st & 1) * 32 + (swz % 64) / 2; }
__host__ __device__ __forceinline__ int perm32(int rho) { const int n = rho >> 4, i = rho & 15; return 8 * (i >> 2) + 4 * n + (i & 3); }
struct Unit { int pm, pn; };
struct Gemm { const h16* A; const h16* Bt; int M, N, K; };
struct StaticOrder {
    int nM, nN, nwg, G, c;
    __host__ __device__ void init(int M, int N, int G_, int c_) { nM = M / BM; nN = N / BM; nwg = nM * nN; G = G_; c = c_; }
    __host__ __device__ bool next(int i, Unit& u) const {
        const long L = (long)i * G + c; if (L >= nwg) return false;
        int wgid = (int)L; { const int q = nwg / NXCD, r = nwg % NXCD, xcd = wgid % NXCD, off = wgid / NXCD; wgid = (xcd < r ? xcd * (q + 1) : r * (q + 1) + (xcd - r) * q) + off; }
        const int nig = WGM * nN, gid = wgid / nig, fm = gid * WGM, gsz = (nM - fm) < WGM ? (nM - fm) : WGM;
        u.pm = fm + ((wgid % nig) % gsz); u.pn = (wgid % nig) / gsz; return true;
    }
};

template <class Epi, class Sched>
__device__ __forceinline__ void gemm_phase(PG8_LAS unsigned char* lds, const Gemm g, const Sched& S, const Epi& E) {
    const int tid = threadIdx.x, wid = __builtin_amdgcn_readfirstlane(tid >> 6), lane = tid & 63, wr = wid >> 2, wc = wid & 3, fr = lane & 15, fq = lane >> 4;
    const int K = g.K, nt = K / BK;
    unsigned voffA[2], voffB[2];
#pragma unroll
    for (int i = 0; i < 2; ++i) { int R, C; stage_rc(tid * 16 + i * 8192, R, C); const int Rb = Epi::PERM ? ((R & ~31) + perm32(R & 31)) : R;
        voffA[i] = (unsigned)(R * K + C) * 2u; voffB[i] = (unsigned)(Rb * K + C) * 2u; }
    const size_t kstep = (size_t)(BK * 2);
    const size_t hstep = (size_t)HALF * K * 2;
    const size_t tstep = 2 * hstep;
    const unsigned ldsw = (unsigned)wid * 1024u;
    const int aoff = lds_byte(wr * 64 + fr, fq * 8), boff = lds_byte(wc * 32 + fr, fq * 8);
#define PG8_SA(b, h) (((b) * 2 + (h)) * HTB)
#define PG8_SB(b, h) ((4 + (b) * 2 + (h)) * HTB)
#define PG8_STAGE(bufoff, gbase, voff) do { _Pragma("unroll") for (int _i = 0; _i < 2; ++_i) \
        __builtin_amdgcn_global_load_lds((const unsigned*)((const char*)(gbase) + (voff)[_i]), (PG8_LAS unsigned*)(lds + (bufoff) + ldsw + _i * 8192), 16, 0, 0); } while (0)
#define PG8_LDA(dst, b, h) do { _Pragma("unroll") for (int m = 0; m < 4; ++m) _Pragma("unroll") for (int k = 0; k < 2; ++k) dst[m][k] = *(const PG8_LAS h16x8*)(lds + PG8_SA(b, h) + aoff + m * 2048 + k * 1024); } while (0)
#define PG8_LDB(dst, b, h) do { _Pragma("unroll") for (int n = 0; n < 2; ++n) _Pragma("unroll") for (int k = 0; k < 2; ++k) dst[n][k] = *(const PG8_LAS h16x8*)(lds + PG8_SB(b, h) + boff + n * 2048 + k * 1024); } while (0)
#define PG8_MMA(ai, bj, At, Bt) do { __builtin_amdgcn_s_setprio(1); _Pragma("unroll") for (int m = 0; m < 4; ++m) _Pragma("unroll") for (int n = 0; n < 2; ++n) _Pragma("unroll") for (int k = 0; k < 2; ++k) \
        acc[ai][bj][m][n] = __builtin_amdgcn_mfma_f32_16x16x32_f16(Bt[n][k], At[m][k], acc[ai][bj][m][n], 0, 0, 0); __builtin_amdgcn_s_setprio(0); } while (0)
#define PG8_WAIT_V(n) asm volatile("s_waitcnt vmcnt(" #n ")" ::: "memory")
#define PG8_WAIT_L(n) asm volatile("s_waitcnt lgkmcnt(" #n ")" ::: "memory")
#define PG8_BAR __builtin_amdgcn_s_barrier()
#define PG8_SCHED __builtin_amdgcn_sched_barrier(0)
    Unit cur, nxt; int ui = 0;
    if (!S.next(0, cur)) return;
    f32x4 acc[2][2][4][2];
#pragma unroll
    for (int a = 0; a < 2; ++a)
#pragma unroll
        for (int b = 0; b < 2; ++b)
#pragma unroll
            for (int m = 0; m < 4; ++m)
#pragma unroll
                for (int n = 0; n < 2; ++n) acc[a][b][m][n] = (f32x4){0.f, 0.f, 0.f, 0.f};
    h16x8 At[4][2], B0[2][2], B1[2][2];
    const char* cA = (const char*)g.A + (size_t)cur.pm * tstep; const char* cB = (const char*)g.Bt + (size_t)cur.pn * tstep;
    PG8_STAGE(PG8_SB(0, 0), cB, voffB); PG8_STAGE(PG8_SA(0, 0), cA, voffA); PG8_STAGE(PG8_SB(0, 1), cB + hstep, voffB); PG8_STAGE(PG8_SA(0, 1), cA + hstep, voffA);
    if (wr == 1) PG8_BAR;
    PG8_WAIT_V(4); PG8_BAR;
    PG8_STAGE(PG8_SB(1, 0), cB + kstep, voffB); PG8_STAGE(PG8_SA(1, 0), cA + kstep, voffA); PG8_STAGE(PG8_SB(1, 1), cB + hstep + kstep, voffB);
    PG8_WAIT_V(6); PG8_BAR;
    for (;;) {
        const bool has_next = S.next(ui + 1, nxt);
        const char* nA = has_next ? (const char*)g.A + (size_t)nxt.pm * tstep : cA; const char* nB = has_next ? (const char*)g.Bt + (size_t)nxt.pn * tstep : cB;
        for (int t = 0; t < nt; t += 2) {
            const bool last = (t == nt - 2);
            const char* a1 = cA + (size_t)(t + 1) * kstep;
            const char* a2 = last ? nA : cA + (size_t)(t + 2) * kstep; const char* b2 = last ? nB : cB + (size_t)(t + 2) * kstep;
            const char* a3 = a2 + kstep; const char* b3 = b2 + kstep;
            PG8_LDB(B0, 0, 0); PG8_SCHED; PG8_LDA(At, 0, 0); PG8_STAGE(PG8_SA(1, 1), a1 + hstep, voffA);
            PG8_WAIT_L(8); PG8_BAR; PG8_WAIT_L(0); PG8_MMA(0, 0, At, B0); PG8_BAR; PG8_SCHED;
            PG8_LDB(B1, 0, 1); PG8_STAGE(PG8_SB(0, 0), b2, voffB);
            PG8_BAR; PG8_WAIT_L(0); PG8_MMA(0, 1, At, B1); PG8_BAR;
            PG8_LDA(At, 0, 1); PG8_STAGE(PG8_SA(0, 0), a2, voffA);
            PG8_BAR; PG8_WAIT_L(0); PG8_MMA(1, 0, At, B0); PG8_BAR; PG8_SCHED;
            PG8_STAGE(PG8_SB(0, 1), b2 + hstep, voffB);
            PG8_WAIT_V(6); PG8_BAR; PG8_MMA(1, 1, At, B1); PG8_BAR;
            PG8_LDB(B0, 1, 0); PG8_SCHED; PG8_LDA(At, 1, 0); PG8_STAGE(PG8_SA(0, 1), a2 + hstep, voffA);
            PG8_WAIT_L(8); PG8_BAR; PG8_WAIT_L(0); PG8_MMA(0, 0, At, B0); PG8_BAR; PG8_SCHED;
            PG8_LDB(B1, 1, 1); PG8_STAGE(PG8_SB(1, 0), b3, voffB);
            PG8_BAR; PG8_WAIT_L(0); PG8_MMA(0, 1, At, B1); PG8_BAR;
            PG8_LDA(At, 1, 1); PG8_STAGE(PG8_SA(1, 0), a3, voffA);
            PG8_BAR; PG8_WAIT_L(0); PG8_MMA(1, 0, At, B0); PG8_BAR; PG8_SCHED;
            PG8_STAGE(PG8_SB(1, 1), b3 + hstep, voffB);
            PG8_WAIT_V(6); PG8_BAR; PG8_MMA(1, 1, At, B1); PG8_BAR;
        }
        E(acc, cur, wr, wc, fr, fq);
        if (!has_next) break;
#pragma unroll
        for (int a = 0; a < 2; ++a)
#pragma unroll
            for (int b = 0; b < 2; ++b)
#pragma unroll
                for (int m = 0; m < 4; ++m)
#pragma unroll
                    for (int n = 0; n < 2; ++n) acc[a][b][m][n] = (f32x4){0.f, 0.f, 0.f, 0.f};
        cur = nxt; cA = nA; cB = nB; ++ui;
    }
    PG8_WAIT_V(0);
    if (wr == 0) PG8_BAR;
    PG8_BAR;
#undef PG8_SA
#undef PG8_SB
#undef PG8_STAGE
#undef PG8_LDA
#undef PG8_LDB
#undef PG8_MMA
#undef PG8_WAIT_V
#undef PG8_WAIT_L
#undef PG8_BAR
#undef PG8_SCHED
}
}

constexpr int DM = 1024, TP = 2064, NPR = 8 * TP  , NR = NPR + 1024  , MP = 17664  , MT = 69;
constexpr int NTHREADS = 512, LDS_BYTES = pg8::STAGE_BYTES;
constexpr size_t UB = (size_t)MP * 1024 * 2;
constexpr size_t WS_WIN = 0;
constexpr size_t WS_WOUT = WS_WIN + (size_t)6400 * 1024 * 2;
constexpr size_t WS_WR = WS_WOUT + (size_t)1024 * 2048 * 2;
constexpr size_t WS_WL2 = WS_WR + (size_t)4608 * 1024 * 2;
constexpr size_t WS_WO = WS_WL2 + (size_t)2048 * 256 * 2;
constexpr size_t WS_WEND = WS_WO + (size_t)1024 * 1024 * 2;
static_assert(WS_WEND <= UB, "weights fit one unit");
constexpr size_t WS_X1 = 1 * UB;
constexpr size_t WS_QKVPRE = 3 * UB;
constexpr size_t WS_OBUF = 3 * UB;
constexpr size_t WS_XS = 3 * UB;
constexpr size_t WS_LOUT = 3 * UB;
constexpr size_t WS_X2 = 3 * UB;
constexpr size_t WS_YBUF = 5 * UB;
constexpr size_t WS_Z = 7 * UB;
constexpr size_t WS_YG = 7 * UB;
constexpr size_t WS_QKV = 9 * UB;
constexpr size_t WS_OG = 9 * UB;
constexpr size_t WS_RKVZ = 9 * UB;
constexpr size_t WS_XN0 = 13 * UB;
constexpr size_t WS_BA = 14 * UB;
constexpr size_t WS_GB = WS_BA + (size_t)MP * 32 * 4;
constexpr size_t WS_LH = WS_GB + (size_t)MP * 32 * 4;
constexpr size_t WS_RK = WS_LH + (size_t)MP * 256 * 2;
constexpr size_t WS_END = WS_RK + (size_t)MP * 16 * 4;
constexpr size_t O_YP = 0, O_YS = 16777216, O_PG = 17825792, O_PGC = 19922944, O_PR = 20021248, O_PRS = 20545536, O_SG = 20553728, O_SGC = 54108160, O_SR = 55681024, O_SRS = 64069632;

struct TJob { const float* src; h16* dst; int srcK, srcN, dst_ld, row0, nrows, col0, ncols, tile0; };
struct Args {
    const float* in[29];
    float* out; unsigned char* ws;
    int ph_lo, ph_hi;
};
constexpr int NTILES_PREP = 3648;
enum { I_XP = 0, I_XS, I_SG, I_SGC, I_SR, I_SRS, I_META, I_NW, I_FNW, I_WIN, I_CW, I_ALOG, I_DTB, I_GNW, I_WOUT, I_MU, I_WRKVZ, I_W0, I_W1, I_W2, I_A0, I_A1, I_A2, I_KK, I_KA, I_RK, I_LNW, I_LNB, I_WO };

__device__ __forceinline__ float wave_sum(float v) {
#pragma unroll
    for (int o = 32; o > 0; o >>= 1) v += __shfl_xor(v, o);
    return v;
}
__device__ __forceinline__ float sigmoidf_(float x) { return 1.0f / (1.0f + expf(-x)); }
__device__ __forceinline__ float siluf_(float x) { return x / (1.0f + expf(-x)); }
__device__ __forceinline__ float softplusf_(float x) { return x > 20.0f ? x : log1pf(expf(x)); }
__device__ __forceinline__ void row_bt(int r, int& b, int& t, bool& samp) {
    if (r < NPR) { b = r / TP; t = r - b * TP; samp = false; } else { const int q = r - NPR; b = q >> 3; t = q & 7; samp = true; }
}
__device__ __forceinline__ const float* xrow(const Args& a, int r) {
    if (r < NPR) { const int b = r / TP, t = r - b * TP; return t < 16 ? a.in[I_META] + (size_t)t * DM : a.in[I_XP] + ((size_t)b * 2048 + (t - 16)) * DM; }
    return a.in[I_XS] + (size_t)(r - NPR) * DM;
}
__device__ __forceinline__ h16x8 pack8(const f32x4 v0, const f32x4 v1) {
    h16x8 w; w[0] = (h16)v0[0]; w[1] = (h16)v0[1]; w[2] = (h16)v0[2]; w[3] = (h16)v0[3]; w[4] = (h16)v1[0]; w[5] = (h16)v1[1]; w[6] = (h16)v1[2]; w[7] = (h16)v1[3]; return w;
}

__device__ __forceinline__ void phase_prep(const Args& a, float* ldsf) {
    const int tid = threadIdx.x, lane = tid & 63, wid = tid >> 6;
    for (int tile = blockIdx.x; tile < NTILES_PREP; tile += gridDim.x) {
        TJob jb;
        { h16* Win = (h16*)(a.ws + WS_WIN); h16* Wout = (h16*)(a.ws + WS_WOUT); h16* Wr = (h16*)(a.ws + WS_WR); h16* Wl2 = (h16*)(a.ws + WS_WL2); h16* Wo = (h16*)(a.ws + WS_WO);
          if (tile < 1600)      jb = TJob{a.in[I_WIN], Win, 1024, 6176, 1024, 0, 6400, 0, 1024, 0};
          else if (tile < 2112) jb = TJob{a.in[I_WOUT], Wout, 2048, 1024, 2048, 0, 1024, 0, 2048, 1600};
          else if (tile < 3136) { const int s = (tile - 2112) >> 8; jb = TJob{a.in[I_WRKVZ] + (size_t)s * 1024 * 1024, Wr, 1024, 1024, 1024, s * 1024, 1024, 0, 1024, 2112 + s * 256}; }
          else if (tile < 3200) jb = TJob{a.in[I_W1], Wr, 1024, 64, 1024, 4096, 256, 0, 1024, 3136};
          else if (tile < 3264) jb = TJob{a.in[I_A1], Wr, 1024, 64, 1024, 4352, 256, 0, 1024, 3200};
          else if (tile < 3328) jb = TJob{a.in[I_W2], Wl2, 64, 1024, 256, 0, 1024, 0, 256, 3264};
          else if (tile < 3392) jb = TJob{a.in[I_A2], Wl2, 64, 1024, 256, 1024, 1024, 64, 256, 3328};
          else                  jb = TJob{a.in[I_WO], Wo, 1024, 1024, 1024, 0, 1024, 0, 1024, 3392}; }
        const int lt = tile - jb.tile0, nck = jb.ncols >> 6, tn = lt / nck, tk = lt - tn * nck;
        __syncthreads();
#pragma unroll
        for (int e = 0; e < 8; ++e) {
            const int idx = e * 512 + tid, kk = idx >> 6, nn = idx & 63;
            const int ks = tk * 64 + kk - jb.col0, ns = tn * 64 + nn;
            float v = 0.f;
            if (ks >= 0 && ks < jb.srcK && ns < jb.srcN) v = jb.src[(size_t)ks * jb.srcN + ns];
            ldsf[kk * 65 + nn] = v;
        }
        __syncthreads();
#pragma unroll
        for (int e = 0; e < 8; ++e) {
            const int idx = e * 512 + tid, nn = idx >> 6, kk = idx & 63;
            jb.dst[(size_t)(jb.row0 + tn * 64 + nn) * jb.dst_ld + tk * 64 + kk] = (h16)ldsf[kk * 65 + nn];
        }
    }
    h16* xn0 = (h16*)(a.ws + WS_XN0);
    const float* nw = a.in[I_NW];
    for (int row = blockIdx.x * 8 + wid; row < MP; row += gridDim.x * 8) {
        h16* op = xn0 + (size_t)row * DM;
        if (row >= NR) {
#pragma unroll
            for (int i = 0; i < 4; ++i) *(h16x4*)(op + i * 256 + lane * 4) = (h16x4){(h16)0.f, (h16)0.f, (h16)0.f, (h16)0.f};
            continue;
        }
        const float* xp = xrow(a, row);
        f32x4 v[4]; float ss = 0.f;
#pragma unroll
        for (int i = 0; i < 4; ++i) { v[i] = *(const f32x4*)(xp + i * 256 + lane * 4); ss += v[i][0] * v[i][0] + v[i][1] * v[i][1] + v[i][2] * v[i][2] + v[i][3] * v[i][3]; }
        ss = wave_sum(ss);
        const float sc = rsqrtf(ss * (1.0f / 1024.0f) + 1e-6f);
#pragma unroll
        for (int i = 0; i < 4; ++i) { const f32x4 w = *(const f32x4*)(nw + i * 256 + lane * 4); h16x4 o;
#pragma unroll
            for (int j = 0; j < 4; ++j) o[j] = (h16)(v[i][j] * sc * w[j]);
            *(h16x4*)(op + i * 256 + lane * 4) = o; }
    }
}

struct EpiProj {
    static constexpr bool PERM = true;
    h16* qkv; h16* z; float* ba;
    __device__ __forceinline__ void operator()(const f32x4 (&acc)[2][2][4][2], const pg8::Unit& u, int wr, int wc, int fr, int fq) const {
        const int row0 = u.pm * 256 + wr * 64 + fr;
        if (u.pn < 24) {
            h16* base = u.pn < 16 ? qkv : z; const int ld = u.pn < 16 ? 4096 : 2048; const int col0 = (u.pn < 16 ? u.pn : u.pn - 16) * 256 + wc * 32 + 8 * fq;
#pragma unroll
            for (int ai = 0; ai < 2; ++ai)
#pragma unroll
                for (int m = 0; m < 4; ++m) { h16* rowp = base + (size_t)(row0 + ai * 128 + m * 16) * ld + col0;
#pragma unroll
                    for (int bj = 0; bj < 2; ++bj) *(h16x8*)(rowp + bj * 128) = pack8(acc[ai][bj][m][0], acc[ai][bj][m][1]); }
        } else if (wc == 0) {
#pragma unroll
            for (int ai = 0; ai < 2; ++ai)
#pragma unroll
                for (int m = 0; m < 4; ++m) { float* rowp = ba + (size_t)(row0 + ai * 128 + m * 16) * 32 + 8 * fq;
                    *(f32x4*)rowp = acc[ai][0][m][0]; *(f32x4*)(rowp + 4) = acc[ai][0][m][1]; }
        }
    }
};
struct EpiH16 {
    static constexpr bool PERM = true;
    h16* O; int ld;
    __device__ __forceinline__ void operator()(const f32x4 (&acc)[2][2][4][2], const pg8::Unit& u, int wr, int wc, int fr, int fq) const {
        const int row0 = u.pm * 256 + wr * 64 + fr, col0 = u.pn * 256 + wc * 32 + 8 * fq;
#pragma unroll
        for (int ai = 0; ai < 2; ++ai)
#pragma unroll
            for (int m = 0; m < 4; ++m) { h16* rowp = O + (size_t)(row0 + ai * 128 + m * 16) * ld + col0;
#pragma unroll
                for (int bj = 0; bj < 2; ++bj) *(h16x8*)(rowp + bj * 128) = pack8(acc[ai][bj][m][0], acc[ai][bj][m][1]); }
    }
};
struct EpiResX {
    static constexpr bool PERM = false;
    const float* meta; const float* xpr; const float* xsm; float* O;
    __device__ __forceinline__ void operator()(const f32x4 (&acc)[2][2][4][2], const pg8::Unit& u, int wr, int wc, int fr, int fq) const {
        const int row0 = u.pm * 256 + wr * 64 + fr, col0 = u.pn * 256 + wc * 32 + 4 * fq;
#pragma unroll
        for (int ai = 0; ai < 2; ++ai)
#pragma unroll
            for (int m = 0; m < 4; ++m) { const int row = row0 + ai * 128 + m * 16; if (row >= NR) continue;
                const float* xp;
                if (row < NPR) { const int b = row / TP, t = row - b * TP; xp = t < 16 ? meta + (size_t)t * DM : xpr + ((size_t)b * 2048 + (t - 16)) * DM; } else xp = xsm + (size_t)(row - NPR) * DM;
                xp += col0; float* rowp = O + (size_t)row * DM + col0;
#pragma unroll
                for (int bj = 0; bj < 2; ++bj)
#pragma unroll
                    for (int n = 0; n < 2; ++n) *(f32x4*)(rowp + bj * 128 + n * 16) = *(const f32x4*)(xp + bj * 128 + n * 16) + acc[ai][bj][m][n]; }
    }
};
struct EpiResB {
    static constexpr bool PERM = false;
    const float* base; float* O;
    __device__ __forceinline__ void operator()(const f32x4 (&acc)[2][2][4][2], const pg8::Unit& u, int wr, int wc, int fr, int fq) const {
        const int row0 = u.pm * 256 + wr * 64 + fr, col0 = u.pn * 256 + wc * 32 + 4 * fq;
#pragma unroll
        for (int ai = 0; ai < 2; ++ai)
#pragma unroll
            for (int m = 0; m < 4; ++m) { const int row = row0 + ai * 128 + m * 16; if (row >= NR) continue;
                const float* xp = base + (size_t)row * DM + col0; float* rowp = O + (size_t)row * DM + col0;
#pragma unroll
                for (int bj = 0; bj < 2; ++bj)
#pragma unroll
                    for (int n = 0; n < 2; ++n) *(f32x4*)(rowp + bj * 128 + n * 16) = *(const f32x4*)(xp + bj * 128 + n * 16) + acc[ai][bj][m][n]; }
    }
};
struct EpiG {
    static constexpr bool PERM = true;
    h16* rkvz; h16* lh;
    __device__ __forceinline__ void operator()(const f32x4 (&acc)[2][2][4][2], const pg8::Unit& u, int wr, int wc, int fr, int fq) const {
        const int s = u.pm / MT, i = u.pm - s * MT, row0 = i * 256 + wr * 64 + fr;
        if (s < 4) {
            h16* base = rkvz + (size_t)s * MP * 1024; const int col0 = (u.pn - 4 * s) * 256 + wc * 32 + 8 * fq;
#pragma unroll
            for (int ai = 0; ai < 2; ++ai)
#pragma unroll
                for (int m = 0; m < 4; ++m) { h16* rowp = base + (size_t)(row0 + ai * 128 + m * 16) * 1024 + col0;
#pragma unroll
                    for (int bj = 0; bj < 2; ++bj) *(h16x8*)(rowp + bj * 128) = pack8(acc[ai][bj][m][0], acc[ai][bj][m][1]); }
        } else if (wc < 2) {
            const int cb = (s == 4 ? 0 : 64) + wc * 32 + 8 * fq;
#pragma unroll
            for (int ai = 0; ai < 2; ++ai)
#pragma unroll
                for (int m = 0; m < 4; ++m) { h16* rowp = lh + (size_t)(row0 + ai * 128 + m * 16) * 256;
                    f32x4 v0 = acc[ai][0][m][0], v1 = acc[ai][0][m][1];
                    if (s == 4) {
#pragma unroll
                        for (int j = 0; j < 4; ++j) { v0[j] = tanhf(v0[j]); v1[j] = tanhf(v1[j]); } }
                    *(h16x8*)(rowp + cb) = pack8(v0, v1);
                    *(h16x8*)(rowp + 128 + cb) = pack8((f32x4){0.f, 0.f, 0.f, 0.f}, (f32x4){0.f, 0.f, 0.f, 0.f}); }
        }
    }
};
struct OrderG {
    pg8::StaticOrder so; int G, c;
    __device__ void init(int G_, int c_) { so.init(4 * MT * 256, 1024, G_, c_); G = G_; c = c_; }
    __device__ bool next(int i, pg8::Unit& u) const {
        long L = (long)i * G + c;
        if (L < 4 * MT * 4) { pg8::Unit v; so.next(i, v); u.pm = v.pm; u.pn = (v.pm / MT) * 4 + v.pn; return true; }
        L -= 4 * MT * 4; if (L >= 2 * MT) return false;
        const int s = 4 + (int)(L / MT), ii = (int)(L % MT); u.pm = s * MT + ii; u.pn = 12 + s; return true;
    }
};

__device__ __forceinline__ void phase_conv(const Args& a) {
    const int lane = threadIdx.x & 63, wid = threadIdx.x >> 6;
    const h16* pre = (const h16*)(a.ws + WS_QKVPRE); h16* qkv = (h16*)(a.ws + WS_QKV);
    const float* ba = (const float*)(a.ws + WS_BA); float* gb = (float*)(a.ws + WS_GB);
    const float* cwp = a.in[I_CW]; const float* cst = a.in[I_SGC];
    for (int row = blockIdx.x * 8 + wid; row < NR; row += gridDim.x * 8) {
        int b, t; bool samp; row_bt(row, b, t, samp);
        for (int seg = 0; seg < 8; ++seg) {
            const int c0 = seg * 512 + lane * 8;
            float y[8], ut[8];
#pragma unroll
            for (int j = 0; j < 8; ++j) { y[j] = 0.f; ut[j] = 0.f; }
            f32x4 w[8];
#pragma unroll
            for (int j = 0; j < 8; ++j) w[j] = *(const f32x4*)(cwp + (size_t)(c0 + j) * 4);
#pragma unroll
            for (int jj = 0; jj < 4; ++jj) {
                const int idx = t + jj;
                float x[8];
                if (idx >= 3) { const h16x8 hv = *(const h16x8*)(pre + (size_t)(row - 3 + jj) * 4096 + c0);
#pragma unroll
                    for (int j = 0; j < 8; ++j) x[j] = (float)hv[j]; }
                else if (samp) { const float* bp = cst + ((size_t)b * 3 + idx) * 4096 + c0; const f32x4 p0 = *(const f32x4*)bp, p1 = *(const f32x4*)(bp + 4);
#pragma unroll
                    for (int j = 0; j < 4; ++j) { x[j] = p0[j]; x[4 + j] = p1[j]; } }
                else {
#pragma unroll
                    for (int j = 0; j < 8; ++j) x[j] = 0.f; }
#pragma unroll
                for (int j = 0; j < 8; ++j) y[j] += x[j] * w[j][jj];
                if (jj == 3) {
#pragma unroll
                    for (int j = 0; j < 8; ++j) ut[j] = x[j]; }
            }
            float ss = 0.f;
#pragma unroll
            for (int j = 0; j < 8; ++j) { y[j] = siluf_(y[j]); ss += y[j] * y[j]; }
            float sc = 1.0f;
            if (seg < 4) {
                ss += __shfl_xor(ss, 1); ss += __shfl_xor(ss, 2); ss += __shfl_xor(ss, 4); ss += __shfl_xor(ss, 8);
                sc = rsqrtf(ss + 1e-6f) * (seg < 2 ? 0.08838834764831845f : 1.0f);
            }
            h16x8 o;
#pragma unroll
            for (int j = 0; j < 8; ++j) o[j] = (h16)(y[j] * sc);
            *(h16x8*)(qkv + (size_t)row * 4096 + c0) = o;
            float* cso = nullptr;
            if (!samp && t >= TP - 3) cso = a.out + O_PGC + ((size_t)b * 3 + (t - (TP - 3))) * 4096 + c0;
            if (samp && t >= 5) cso = a.out + O_SGC + ((size_t)b * 3 + (t - 5)) * 4096 + c0;
            if (cso) { *(f32x4*)cso = (f32x4){ut[0], ut[1], ut[2], ut[3]}; *(f32x4*)(cso + 4) = (f32x4){ut[4], ut[5], ut[6], ut[7]}; }
        }
        if (lane < 16) {
            const float bv = ba[(size_t)row * 32 + lane], av = ba[(size_t)row * 32 + 16 + lane];
            gb[(size_t)row * 32 + lane] = sigmoidf_(bv);
            gb[(size_t)row * 32 + 16 + lane] = -expf(a.in[I_ALOG][lane]) * softplusf_(av + a.in[I_DTB][lane]);
        }
    }
}

__device__ __forceinline__ void phase_gdn_scan(const Args& a, float* ldsf) {
    const int lane = threadIdx.x & 63, wid = threadIdx.x >> 6;
    const int vl = lane >> 2, kq = lane & 3;
    float* L = ldsf + wid * 2208;
    float* Lq = L, *Lk = L + 1024, *Lv = L + 2048, *Lg = L + 2176, *Lb = L + 2184;
    const h16* qkv = (const h16*)(a.ws + WS_QKV); const float* gb = (const float*)(a.ws + WS_GB); float* obuf = (float*)(a.ws + WS_OBUF);
    const int NW = gridDim.x * 8, gw = wid * gridDim.x + blockIdx.x;
    for (int it = gw; it < 1024 + 16384; it += NW) {
        const bool samp = it >= 1024; const int q = samp ? it - 1024 : it;
        const int seq = q >> 3, vg = q & 7, b = seq >> 4, hv = seq & 15, hq = hv >> 1;
        const int T = samp ? 8 : TP, row0 = samp ? NPR + b * 8 : b * TP;
        const int v = vg * 16 + vl;
        float S[32];
        if (samp) { const float* sp = a.in[I_SG] + ((size_t)(b * 16 + hv) * 128 + kq * 32) * 128 + v;
#pragma unroll
            for (int i = 0; i < 32; ++i) S[i] = sp[(size_t)i * 128]; }
        else {
#pragma unroll
            for (int i = 0; i < 32; ++i) S[i] = 0.f; }
        for (int t0 = 0; t0 < T; t0 += 8) {
            __builtin_amdgcn_wave_barrier();
            { const int tt = lane >> 3, part = lane & 7; const h16* rp = qkv + (size_t)(row0 + t0 + tt) * 4096;
              const h16x8 q0 = *(const h16x8*)(rp + hq * 128 + part * 16), q1 = *(const h16x8*)(rp + hq * 128 + part * 16 + 8);
              const h16x8 k0 = *(const h16x8*)(rp + 1024 + hq * 128 + part * 16), k1 = *(const h16x8*)(rp + 1024 + hq * 128 + part * 16 + 8);
              float* dq = Lq + tt * 128 + part * 16; float* dk = Lk + tt * 128 + part * 16;
#pragma unroll
              for (int j = 0; j < 8; ++j) { dq[j] = (float)q0[j]; dq[8 + j] = (float)q1[j]; dk[j] = (float)k0[j]; dk[8 + j] = (float)k1[j]; }
              if (lane < 8) { const h16* vp = qkv + (size_t)(row0 + t0 + lane) * 4096 + 2048 + hv * 128 + vg * 16;
                  const h16x8 v0 = *(const h16x8*)vp, v1 = *(const h16x8*)(vp + 8);
#pragma unroll
                  for (int j = 0; j < 8; ++j) { Lv[lane * 16 + j] = (float)v0[j]; Lv[lane * 16 + 8 + j] = (float)v1[j]; }
                  Lb[lane] = gb[(size_t)(row0 + t0 + lane) * 32 + hv]; Lg[lane] = gb[(size_t)(row0 + t0 + lane) * 32 + 16 + hv]; } }
            __builtin_amdgcn_fence(__ATOMIC_RELEASE, "wavefront");
            __builtin_amdgcn_wave_barrier();
            for (int tt = 0; tt < 8; ++tt) {
                const float al = expf(Lg[tt]), be = Lb[tt], vv = Lv[tt * 16 + vl];
                const f32x4* kp = (const f32x4*)(Lk + tt * 128 + kq * 32); const f32x4* qp = (const f32x4*)(Lq + tt * 128 + kq * 32);
                float kr[32];
                float dot = 0.f;
#pragma unroll
                for (int i = 0; i < 8; ++i) { const f32x4 kv = kp[i]; kr[4 * i] = kv[0]; kr[4 * i + 1] = kv[1]; kr[4 * i + 2] = kv[2]; kr[4 * i + 3] = kv[3]; }
#pragma unroll
                for (int i = 0; i < 32; ++i) dot += kr[i] * S[i];
                dot += __shfl_xor(dot, 1); dot += __shfl_xor(dot, 2);
                const float c = be * (vv - al * dot);
                float od = 0.f;
#pragma unroll
                for (int i = 0; i < 8; ++i) { const f32x4 qv = qp[i];
#pragma unroll
                    for (int j = 0; j < 4; ++j) { const float s = al * S[4 * i + j] + kr[4 * i + j] * c; S[4 * i + j] = s; od += qv[j] * s; } }
                od += __shfl_xor(od, 1); od += __shfl_xor(od, 2);
                if (kq == 0) obuf[(size_t)(row0 + t0 + tt) * 2048 + hv * 128 + v] = od;
            }
        }
        float* so = a.out + (samp ? O_SG : O_PG) + ((size_t)(b * 16 + hv) * 128 + kq * 32) * 128 + v;
#pragma unroll
        for (int i = 0; i < 32; ++i) so[(size_t)i * 128] = S[i];
    }
}

__device__ __forceinline__ void phase_gdn_gate(const Args& a) {
    const int lane = threadIdx.x & 63, wid = threadIdx.x >> 6;
    const float* obuf = (const float*)(a.ws + WS_OBUF); const h16* z = (const h16*)(a.ws + WS_Z); h16* og = (h16*)(a.ws + WS_OG);
    const f32x2 gw = *(const f32x2*)(a.in[I_GNW] + lane * 2);
    for (int row = blockIdx.x * 8 + wid; row < NR; row += gridDim.x * 8) {
        for (int h = 0; h < 16; ++h) {
            const f32x2 o = *(const f32x2*)(obuf + (size_t)row * 2048 + h * 128 + lane * 2);
            const h16x2 zz = *(const h16x2*)(z + (size_t)row * 2048 + h * 128 + lane * 2);
            const float ss = wave_sum(o[0] * o[0] + o[1] * o[1]);
            const float sc = rsqrtf(ss * (1.0f / 128.0f) + 1e-6f);
            h16x2 r; r[0] = (h16)(o[0] * sc * gw[0] * siluf_((float)zz[0])); r[1] = (h16)(o[1] * sc * gw[1] * siluf_((float)zz[1]));
            *(h16x2*)(og + (size_t)row * 2048 + h * 128 + lane * 2) = r;
        }
    }
}

__device__ __forceinline__ void phase_shift(const Args& a) {
    const int lane = threadIdx.x & 63, wid = threadIdx.x >> 6;
    const float* x1 = (const float*)(a.ws + WS_X1); h16* xs = (h16*)(a.ws + WS_XS);
    const float* nw = a.in[I_NW] + DM; const float* mu = a.in[I_MU];
    for (int row = blockIdx.x * 8 + wid; row < NR; row += gridDim.x * 8) {
        int b, t; bool samp; row_bt(row, b, t, samp);
        f32x4 xn[4], xp[4];
        { const float* p = x1 + (size_t)row * DM; float ss = 0.f;
#pragma unroll
          for (int i = 0; i < 4; ++i) { xn[i] = *(const f32x4*)(p + i * 256 + lane * 4); ss += xn[i][0] * xn[i][0] + xn[i][1] * xn[i][1] + xn[i][2] * xn[i][2] + xn[i][3] * xn[i][3]; }
          ss = wave_sum(ss); const float sc = rsqrtf(ss * (1.0f / 1024.0f) + 1e-6f);
#pragma unroll
          for (int i = 0; i < 4; ++i) xn[i] = xn[i] * sc * *(const f32x4*)(nw + i * 256 + lane * 4); }
        if (t > 0) { const float* p = x1 + (size_t)(row - 1) * DM; float ss = 0.f;
#pragma unroll
          for (int i = 0; i < 4; ++i) { xp[i] = *(const f32x4*)(p + i * 256 + lane * 4); ss += xp[i][0] * xp[i][0] + xp[i][1] * xp[i][1] + xp[i][2] * xp[i][2] + xp[i][3] * xp[i][3]; }
          ss = wave_sum(ss); const float sc = rsqrtf(ss * (1.0f / 1024.0f) + 1e-6f);
#pragma unroll
          for (int i = 0; i < 4; ++i) xp[i] = xp[i] * sc * *(const f32x4*)(nw + i * 256 + lane * 4); }
        else if (samp) {
#pragma unroll
          for (int i = 0; i < 4; ++i) xp[i] = *(const f32x4*)(a.in[I_SRS] + (size_t)b * DM + i * 256 + lane * 4); }
        else {
#pragma unroll
          for (int i = 0; i < 4; ++i) xp[i] = (f32x4){0.f, 0.f, 0.f, 0.f}; }
        for (int s = 0; s < 6; ++s) {
#pragma unroll
            for (int i = 0; i < 4; ++i) { const f32x4 m = *(const f32x4*)(mu + (size_t)s * DM + i * 256 + lane * 4); const f32x4 r = xn[i] + (xp[i] - xn[i]) * m;
                h16x4 o; o[0] = (h16)r[0]; o[1] = (h16)r[1]; o[2] = (h16)r[2]; o[3] = (h16)r[3];
                *(h16x4*)(xs + ((size_t)s * MP + row) * DM + i * 256 + lane * 4) = o; }
        }
        float* so = nullptr;
        if (!samp && t == TP - 1) so = a.out + O_PRS + (size_t)b * DM;
        if (samp && t == 7) so = a.out + O_SRS + (size_t)b * DM;
        if (so) {
#pragma unroll
            for (int i = 0; i < 4; ++i) *(f32x4*)(so + i * 256 + lane * 4) = xn[i]; }
    }
}

__device__ __forceinline__ void phase_rwkv_scan(const Args& a, float* ldsf) {
    const int lane = threadIdx.x & 63, wid = threadIdx.x >> 6;
    const int vl = lane >> 2, kq = lane & 3;
    float* L = ldsf + wid * 2688;
    float* Lr = L, *Lk = L + 512, *Ld = L + 1024, *Lkk = L + 1536, *Lbb = L + 2048, *Lv = L + 2560;
    const h16* rkvz = (const h16*)(a.ws + WS_RKVZ); const h16* lo = (const h16*)(a.ws + WS_LOUT);
    float* ybuf = (float*)(a.ws + WS_YBUF); float* rkb = (float*)(a.ws + WS_RK);
    const int NW = gridDim.x * 8, gw = wid * gridDim.x + blockIdx.x;
    for (int it = gw; it < 512 + 8192; it += NW) {
        const bool samp = it >= 512; const int q = samp ? it - 512 : it;
        const int seq = q >> 2, vq = q & 3, b = seq >> 4, h = seq & 15;
        const int T = samp ? 8 : TP, row0 = samp ? NPR + b * 8 : b * TP;
        const int v = vq * 16 + vl, c = h * 64 + lane;
        const float w0 = a.in[I_W0][c], a0 = a.in[I_A0][c], k_k = a.in[I_KK][c], k_a = a.in[I_KA][c], r_k = a.in[I_RK][c];
        float S[16];
        if (samp) { const float* sp = a.in[I_SR] + ((size_t)(b * 16 + h) * 64 + v) * 64 + kq * 16;
#pragma unroll
            for (int i = 0; i < 4; ++i) { const f32x4 x = *(const f32x4*)(sp + 4 * i); S[4 * i] = x[0]; S[4 * i + 1] = x[1]; S[4 * i + 2] = x[2]; S[4 * i + 3] = x[3]; } }
        else {
#pragma unroll
            for (int i = 0; i < 16; ++i) S[i] = 0.f; }
        for (int t0 = 0; t0 < T; t0 += 8) {
            __builtin_amdgcn_wave_barrier();
            for (int tt = 0; tt < 8; ++tt) {
                const size_t row = (size_t)(row0 + t0 + tt);
                const float r = (float)rkvz[row * 1024 + c], k = (float)rkvz[((size_t)MP + row) * 1024 + c], vv = (float)rkvz[((size_t)2 * MP + row) * 1024 + c];
                const float wl = (float)lo[row * 2048 + c], al = (float)lo[row * 2048 + 1024 + c];
                const float w = -softplusf_(-(w0 + wl)) - 0.5f;
                const float d = expf(-expf(w));
                const float aa = sigmoidf_(a0 + al);
                const float kkv = k * k_k;
                const float ss = wave_sum(kkv * kkv);
                const float kk = kkv * rsqrtf(ss + 1e-6f);
                const float k2 = k * (1.0f + (aa - 1.0f) * k_a);
                const float rk = wave_sum(r * k2 * r_k);
                if (vq == 0 && lane == 0) rkb[row * 16 + h] = rk;
                Lr[tt * 64 + lane] = r; Lk[tt * 64 + lane] = k2; Ld[tt * 64 + lane] = d; Lkk[tt * 64 + lane] = kk; Lbb[tt * 64 + lane] = kk * aa;
                if ((lane >> 4) == vq) Lv[tt * 16 + (lane & 15)] = vv;
            }
            __builtin_amdgcn_fence(__ATOMIC_RELEASE, "wavefront");
            __builtin_amdgcn_wave_barrier();
            for (int tt = 0; tt < 8; ++tt) {
                const float vv = Lv[tt * 16 + vl];
                const f32x4* pk = (const f32x4*)(Lkk + tt * 64 + kq * 16); const f32x4* pd = (const f32x4*)(Ld + tt * 64 + kq * 16);
                const f32x4* pb = (const f32x4*)(Lbb + tt * 64 + kq * 16); const f32x4* pkk = (const f32x4*)(Lk + tt * 64 + kq * 16); const f32x4* pr = (const f32x4*)(Lr + tt * 64 + kq * 16);
                float sa = 0.f;
#pragma unroll
                for (int i = 0; i < 4; ++i) { const f32x4 x = pk[i]; sa += S[4 * i] * x[0] + S[4 * i + 1] * x[1] + S[4 * i + 2] * x[2] + S[4 * i + 3] * x[3]; }
                sa += __shfl_xor(sa, 1); sa += __shfl_xor(sa, 2);
                const float nsa = -sa;
                float y = 0.f;
#pragma unroll
                for (int i = 0; i < 4; ++i) { const f32x4 dd = pd[i], bb = pb[i], k2 = pkk[i], rr = pr[i];
#pragma unroll
                    for (int j = 0; j < 4; ++j) { const float s = S[4 * i + j] * dd[j] + nsa * bb[j] + vv * k2[j]; S[4 * i + j] = s; y += s * rr[j]; } }
                y += __shfl_xor(y, 1); y += __shfl_xor(y, 2);
                if (kq == 0) ybuf[(size_t)(row0 + t0 + tt) * 1024 + h * 64 + v] = y;
            }
        }
        float* so = a.out + (samp ? O_SR : O_PR) + ((size_t)(b * 16 + h) * 64 + v) * 64 + kq * 16;
#pragma unroll
        for (int i = 0; i < 4; ++i) *(f32x4*)(so + 4 * i) = (f32x4){S[4 * i], S[4 * i + 1], S[4 * i + 2], S[4 * i + 3]};
    }
}

__device__ __forceinline__ void phase_rwkv_gate(const Args& a) {
    const int lane = threadIdx.x & 63, wid = threadIdx.x >> 6;
    const float* ybuf = (const float*)(a.ws + WS_YBUF); const float* rkb = (const float*)(a.ws + WS_RK);
    const h16* rkvz = (const h16*)(a.ws + WS_RKVZ); h16* yg = (h16*)(a.ws + WS_YG);
    for (int row = blockIdx.x * 8 + wid; row < NR; row += gridDim.x * 8) {
        for (int h = 0; h < 16; ++h) {
            const int c = h * 64 + lane;
            const float y = ybuf[(size_t)row * 1024 + c];
            const float mean = wave_sum(y) * (1.0f / 64.0f);
            const float dy = y - mean;
            const float var = wave_sum(dy * dy) * (1.0f / 64.0f);
            float yn = dy * rsqrtf(var + 64e-5f) * a.in[I_LNW][c] + a.in[I_LNB][c];
            const float vv = (float)rkvz[((size_t)2 * MP + row) * 1024 + c], zz = (float)rkvz[((size_t)3 * MP + row) * 1024 + c];
            yn += rkb[(size_t)row * 16 + h] * vv;
            yg[(size_t)row * 1024 + c] = (h16)(yn * siluf_(zz));
        }
    }
}

__device__ __forceinline__ void phase_final(const Args& a) {
    const int lane = threadIdx.x & 63, wid = threadIdx.x >> 6;
    const float* x2 = (const float*)(a.ws + WS_X2); const float* nw = a.in[I_FNW];
    for (int row = blockIdx.x * 8 + wid; row < NR; row += gridDim.x * 8) {
        int b, t; bool samp; row_bt(row, b, t, samp);
        if (!samp && t < 16) continue;
        float* op = samp ? a.out + O_YS + (size_t)(row - NPR) * DM : a.out + O_YP + ((size_t)b * 2048 + (t - 16)) * DM;
        const float* p = x2 + (size_t)row * DM; f32x4 v[4]; float ss = 0.f;
#pragma unroll
        for (int i = 0; i < 4; ++i) { v[i] = *(const f32x4*)(p + i * 256 + lane * 4); ss += v[i][0] * v[i][0] + v[i][1] * v[i][1] + v[i][2] * v[i][2] + v[i][3] * v[i][3]; }
        ss = wave_sum(ss); const float sc = rsqrtf(ss * (1.0f / 1024.0f) + 1e-6f);
#pragma unroll
        for (int i = 0; i < 4; ++i) *(f32x4*)(op + i * 256 + lane * 4) = v[i] * sc * *(const f32x4*)(nw + i * 256 + lane * 4);
    }
}

constexpr int NPHASE = 13;
__global__ void __launch_bounds__(NTHREADS, 2) mk_fwd(Args a) {
    extern __shared__ __attribute__((aligned(16))) unsigned char smem[];
    PG8_LAS unsigned char* lds = (PG8_LAS unsigned char*)smem;
    float* ldsf = (float*)smem;
    const int G = gridDim.x, c = blockIdx.x;
#if MK_COOP
    cg::grid_group grid = cg::this_grid();
#define SEAM(p) do { if ((p) + 1 < a.ph_hi) grid.sync(); } while (0)
#else
#define SEAM(p) do { } while (0)
#endif
#define IN(p) (a.ph_lo <= (p) && (p) < a.ph_hi)
    if (IN(0)) { phase_prep(a, ldsf); SEAM(0); }
    if (IN(1)) { __syncthreads();
        pg8::Gemm g{(const h16*)(a.ws + WS_XN0), (const h16*)(a.ws + WS_WIN), MP, 6400, 1024}; pg8::StaticOrder S; S.init(MP, 6400, G, c);
        EpiProj E{(h16*)(a.ws + WS_QKVPRE), (h16*)(a.ws + WS_Z), (float*)(a.ws + WS_BA)};
        pg8::gemm_phase<EpiProj, pg8::StaticOrder>(lds, g, S, E); SEAM(1); }
    if (IN(2)) { phase_conv(a); SEAM(2); }
    if (IN(3)) { __syncthreads(); phase_gdn_scan(a, ldsf); SEAM(3); }
    if (IN(4)) { phase_gdn_gate(a); SEAM(4); }
    if (IN(5)) { __syncthreads();
        pg8::Gemm g{(const h16*)(a.ws + WS_OG), (const h16*)(a.ws + WS_WOUT), MP, 1024, 2048}; pg8::StaticOrder S; S.init(MP, 1024, G, c);
        EpiResX E{a.in[I_META], a.in[I_XP], a.in[I_XS], (float*)(a.ws + WS_X1)};
        pg8::gemm_phase<EpiResX, pg8::StaticOrder>(lds, g, S, E); SEAM(5); }
    if (IN(6)) { phase_shift(a); SEAM(6); }
    if (IN(7)) { __syncthreads();
        pg8::Gemm g{(const h16*)(a.ws + WS_XS), (const h16*)(a.ws + WS_WR), 6 * MP, 4608, 1024}; OrderG S; S.init(G, c);
        EpiG E{(h16*)(a.ws + WS_RKVZ), (h16*)(a.ws + WS_LH)};
        pg8::gemm_phase<EpiG, OrderG>(lds, g, S, E); SEAM(7); }
    if (IN(8)) { __syncthreads();
        pg8::Gemm g{(const h16*)(a.ws + WS_LH), (const h16*)(a.ws + WS_WL2), MP, 2048, 256}; pg8::StaticOrder S; S.init(MP, 2048, G, c);
        EpiH16 E{(h16*)(a.ws + WS_LOUT), 2048};
        pg8::gemm_phase<EpiH16, pg8::StaticOrder>(lds, g, S, E); SEAM(8); }
    if (IN(9)) { __syncthreads(); phase_rwkv_scan(a, ldsf); SEAM(9); }
    if (IN(10)) { phase_rwkv_gate(a); SEAM(10); }
    if (IN(11)) { __syncthreads();
        pg8::Gemm g{(const h16*)(a.ws + WS_YG), (const h16*)(a.ws + WS_WO), MP, 1024, 1024}; pg8::StaticOrder S; S.init(MP, 1024, G, c);
        EpiResB E{(const float*)(a.ws + WS_X1), (float*)(a.ws + WS_X2)};
        pg8::gemm_phase<EpiResB, pg8::StaticOrder>(lds, g, S, E); SEAM(11); }
    if (IN(12)) { phase_final(a); }
#undef IN
#undef SEAM
}

extern "C" void kernel_launch(void* const* d_in, const int* in_sizes, int n_in, void* d_out, int out_size, void* d_ws, size_t ws_size, hipStream_t stream) {
    static int grid = 0;
    if (grid == 0) {
        if (n_in != 29 || ws_size < WS_END) { fprintf(stderr, "kernel_launch: unexpected n_in %d or ws_size %zu (< %zu)\n", n_in, ws_size, (size_t)WS_END); grid = -1; return; }
        int dev = 0, cus = 0, per_cu = 0;
        hipGetDevice(&dev); hipDeviceGetAttribute(&cus, hipDeviceAttributeMultiprocessorCount, dev);
        if (hipFuncSetAttribute((const void*)mk_fwd, hipFuncAttributeMaxDynamicSharedMemorySize, LDS_BYTES) != hipSuccess) { fprintf(stderr, "kernel_launch: hipFuncSetAttribute failed\n"); }
        if (hipOccupancyMaxActiveBlocksPerMultiprocessor(&per_cu, (const void*)mk_fwd, NTHREADS, LDS_BYTES) != hipSuccess || per_cu < 1) { fprintf(stderr, "kernel_launch: occupancy query gave %d\n", per_cu); per_cu = 1; }
        (void)hipGetLastError();
        grid = cus * 1;
        if (grid <= 0) grid = 256;
    }
    if (grid < 0) return;
    Args a; memset(&a, 0, sizeof(a));
    for (int i = 0; i < 29; ++i) a.in[i] = (const float*)d_in[i];
    a.out = (float*)d_out; a.ws = (unsigned char*)d_ws;
#if MK_COOP
    a.ph_lo = 0; a.ph_hi = NPHASE;
    void* args[] = {&a};
    hipError_t e = hipLaunchCooperativeKernel((const void*)mk_fwd, dim3(grid), dim3(NTHREADS), args, LDS_BYTES, stream);
    if (e != hipSuccess) fprintf(stderr, "cooperative launch failed: %s (grid %d)\n", hipGetErrorString(e), grid);
#else
    for (int p = 0; p < NPHASE; ++p) { a.ph_lo = p; a.ph_hi = p + 1; hipLaunchKernelGGL(mk_fwd, dim3(grid), dim3(NTHREADS), LDS_BYTES, stream, a); }
#endif
}
```

```cpp
#include <hip/hip_runtime.h>
#include <hip/hip_cooperative_groups.h>
#include <cstdio>
#include <cstring>
namespace cg = cooperative_groups;

#ifndef MK_COOP
#define MK_COOP 1
#endif

typedef _Float16 h16;
typedef _Float16 h16x8 __attribute__((ext_vector_type(8)));
typedef _Float16 h16x4 __attribute__((ext_vector_type(4)));
typedef _Float16 h16x2 __attribute__((ext_vector_type(2)));
typedef float f32x4 __attribute__((ext_vector_type(4)));
typedef float f32x2 __attribute__((ext_vector_type(2)));

namespace pg8 {
#define PG8_LAS __attribute__((address_space(3)))
constexpr int BM = 256, BK = 64, HALF = 128, HTB = HALF * BK * 2, STAGE_BYTES = 8 * HTB, NXCD = 8, WGM = 8;
__host__ __device__ __forceinline__ int lds_byte(int r, int c) { const int st = (r >> 4) * 2 + (c >> 5), rr = r & 15, cc = c & 31, ob = rr * 64 + cc * 2; return st * 1024 + (ob ^ (((ob >> 9) & 1) << 5)); }
__host__ __device__ __forceinline__ void stage_rc(int b, int& R, int& C) { const int st = b / 1024, sb = b % 1024, swz = sb ^ (((sb >> 9) & 1) << 5); R = (st >> 1) * 16 + swz / 64; C = (st & 1) * 32 + (swz % 64) / 2; }
__host__ __device__ __forceinline__ int perm32(int rho) { const int n = rho >> 4, i = rho & 15; return 8 * (i >> 2) + 4 * n + (i & 3); }
struct Unit { int pm, pn; };
struct Gemm { const h16* A; const h16* Bt; int M, N, K; };
struct StaticOrder {
    int nM, nN, nwg, G, c;
    __host__ __device__ void init(int M, int N, int G_, int c_) { nM = M / BM; nN = N / BM; nwg = nM * nN; G = G_; c = c_; }
    __host__ __device__ bool next(int i, Unit& u) const {
        const long L = (long)i * G + c; if (L >= nwg) return false;
        int wgid = (int)L; { const int q = nwg / NXCD, r = nwg % NXCD, xcd = wgid % NXCD, off = wgid / NXCD; wgid = (xcd < r ? xcd * (q + 1) : r * (q + 1) + (xcd - r) * q) + off; }
        const int nig = WGM * nN, gid = wgid / nig, fm = gid * WGM, gsz = (nM - fm) < WGM ? (nM - fm) : WGM;
        u.pm = fm + ((wgid % nig) % gsz); u.pn = (wgid % nig) / gsz; return true;
    }
};

template <class Epi, class Sched>
__device__ __forceinline__ void gemm_phase(PG8_LAS unsigned char* lds, const Gemm g, const Sched& S, const Epi& E) {
    const int tid = threadIdx.x, wid = __builtin_amdgcn_readfirstlane(tid >> 6), lane = tid & 63, wr = wid >> 2, wc = wid & 3, fr = lane & 15, fq = lane >> 4;
    const int K = g.K, nt = K / BK;
    unsigned voffA[2], voffB[2];
#pragma unroll
    for (int i = 0; i < 2; ++i) { int R, C; stage_rc(tid * 16 + i * 8192, R, C); const int Rb = Epi::PERM ? ((R & ~31) + perm32(R & 31)) : R;
        voffA[i] = (unsigned)(R * K + C) * 2u; voffB[i] = (unsigned)(Rb * K + C) * 2u; }
    const size_t kstep = (size_t)(BK * 2);
    const size_t hstep = (size_t)HALF * K * 2;
    const size_t tstep = 2 * hstep;
    const unsigned ldsw = (unsigned)wid * 1024u;
    const int aoff = lds_byte(wr * 64 + fr, fq * 8), boff = lds_byte(wc * 32 + fr, fq * 8);
#define PG8_SA(b, h) (((b) * 2 + (h)) * HTB)
#define PG8_SB(b, h) ((4 + (b) * 2 + (h)) * HTB)
#define PG8_STAGE(bufoff, gbase, voff) do { _Pragma("unroll") for (int _i = 0; _i < 2; ++_i) \
        __builtin_amdgcn_global_load_lds((const unsigned*)((const char*)(gbase) + (voff)[_i]), (PG8_LAS unsigned*)(lds + (bufoff) + ldsw + _i * 8192), 16, 0, 0); } while (0)
#define PG8_LDA(dst, b, h) do { _Pragma("unroll") for (int m = 0; m < 4; ++m) _Pragma("unroll") for (int k = 0; k < 2; ++k) dst[m][k] = *(const PG8_LAS h16x8*)(lds + PG8_SA(b, h) + aoff + m * 2048 + k * 1024); } while (0)
#define PG8_LDB(dst, b, h) do { _Pragma("unroll") for (int n = 0; n < 2; ++n) _Pragma("unroll") for (int k = 0; k < 2; ++k) dst[n][k] = *(const PG8_LAS h16x8*)(lds + PG8_SB(b, h) + boff + n * 2048 + k * 1024); } while (0)
#define PG8_MMA(ai, bj, At, Bt) do { __builtin_amdgcn_s_setprio(1); _Pragma("unroll") for (int m = 0; m < 4; ++m) _Pragma("unroll") for (int n = 0; n < 2; ++n) _Pragma("unroll") for (int k = 0; k < 2; ++k) \
        acc[ai][bj][m][n] = __builtin_amdgcn_mfma_f32_16x16x32_f16(Bt[n][k], At[m][k], acc[ai][bj][m][n], 0, 0, 0); __builtin_amdgcn_s_setprio(0); } while (0)
#define PG8_WAIT_V(n) asm volatile("s_waitcnt vmcnt(" #n ")" ::: "memory")
#define PG8_WAIT_L(n) asm volatile("s_waitcnt lgkmcnt(" #n ")" ::: "memory")
#define PG8_BAR __builtin_amdgcn_s_barrier()
#define PG8_SCHED __builtin_amdgcn_sched_barrier(0)
    Unit cur, nxt; int ui = 0;
    if (!S.next(0, cur)) return;
    f32x4 acc[2][2][4][2];
#pragma unroll
    for (int a = 0; a < 2; ++a)
#pragma unroll
        for (int b = 0; b < 2; ++b)
#pragma unroll
            for (int m = 0; m < 4; ++m)
#pragma unroll
                for (int n = 0; n < 2; ++n) acc[a][b][m][n] = (f32x4){0.f, 0.f, 0.f, 0.f};
    h16x8 At[4][2], B0[2][2], B1[2][2];
    const char* cA = (const char*)g.A + (size_t)cur.pm * tstep; const char* cB = (const char*)g.Bt + (size_t)cur.pn * tstep;
    PG8_STAGE(PG8_SB(0, 0), cB, voffB); PG8_STAGE(PG8_SA(0, 0), cA, voffA); PG8_STAGE(PG8_SB(0, 1), cB + hstep, voffB); PG8_STAGE(PG8_SA(0, 1), cA + hstep, voffA);
    if (wr == 1) PG8_BAR;
    PG8_WAIT_V(4); PG8_BAR;
    PG8_STAGE(PG8_SB(1, 0), cB + kstep, voffB); PG8_STAGE(PG8_SA(1, 0), cA + kstep, voffA); PG8_STAGE(PG8_SB(1, 1), cB + hstep + kstep, voffB);
    PG8_WAIT_V(6); PG8_BAR;
    for (;;) {
        const bool has_next = S.next(ui + 1, nxt);
        const char* nA = has_next ? (const char*)g.A + (size_t)nxt.pm * tstep : cA; const char* nB = has_next ? (const char*)g.Bt + (size_t)nxt.pn * tstep : cB;
        for (int t = 0; t < nt; t += 2) {
            const bool last = (t == nt - 2);
            const char* a1 = cA + (size_t)(t + 1) * kstep;
            const char* a2 = last ? nA : cA + (size_t)(t + 2) * kstep; const char* b2 = last ? nB : cB + (size_t)(t + 2) * kstep;
            const char* a3 = a2 + kstep; const char* b3 = b2 + kstep;
            PG8_LDB(B0, 0, 0); PG8_SCHED; PG8_LDA(At, 0, 0); PG8_STAGE(PG8_SA(1, 1), a1 + hstep, voffA);
            PG8_WAIT_L(8); PG8_BAR; PG8_WAIT_L(0); PG8_MMA(0, 0, At, B0); PG8_BAR; PG8_SCHED;
            PG8_LDB(B1, 0, 1); PG8_STAGE(PG8_SB(0, 0), b2, voffB);
            PG8_BAR; PG8_WAIT_L(0); PG8_MMA(0, 1, At, B1); PG8_BAR;
            PG8_LDA(At, 0, 1); PG8_STAGE(PG8_SA(0, 0), a2, voffA);
            PG8_BAR; PG8_WAIT_L(0); PG8_MMA(1, 0, At, B0); PG8_BAR; PG8_SCHED;
            PG8_STAGE(PG8_SB(0, 1), b2 + hstep, voffB);
            PG8_WAIT_V(6); PG8_BAR; PG8_MMA(1, 1, At, B1); PG8_BAR;
            PG8_LDB(B0, 1, 0); PG8_SCHED; PG8_LDA(At, 1, 0); PG8_STAGE(PG8_SA(0, 1), a2 + hstep, voffA);
            PG8_WAIT_L(8); PG8_BAR; PG8_WAIT_L(0); PG8_MMA(0, 0, At, B0); PG8_BAR; PG8_SCHED;
            PG8_LDB(B1, 1, 1); PG8_STAGE(PG8_SB(1, 0), b3, voffB);
            PG8_BAR; PG8_WAIT_L(0); PG8_MMA(0, 1, At, B1); PG8_BAR;
            PG8_LDA(At, 1, 1); PG8_STAGE(PG8_SA(1, 0), a3, voffA);
            PG8_BAR; PG8_WAIT_L(0); PG8_MMA(1, 0, At, B0); PG8_BAR; PG8_SCHED;
            PG8_STAGE(PG8_SB(1, 1), b3 + hstep, voffB);
            PG8_WAIT_V(6); PG8_BAR; PG8_MMA(1, 1, At, B1); PG8_BAR;
        }
        E(acc, cur, wr, wc, fr, fq);
        if (!has_next) break;
#pragma unroll
        for (int a = 0; a < 2; ++a)
#pragma unroll
            for (int b = 0; b < 2; ++b)
#pragma unroll
                for (int m = 0; m < 4; ++m)
#pragma unroll
                    for (int n = 0; n < 2; ++n) acc[a][b][m][n] = (f32x4){0.f, 0.f, 0.f, 0.f};
        cur = nxt; cA = nA; cB = nB; ++ui;
    }
    PG8_WAIT_V(0);
    if (wr == 0) PG8_BAR;
    PG8_BAR;
#undef PG8_SA
#undef PG8_SB
#undef PG8_STAGE
#undef PG8_LDA
#undef PG8_LDB
#undef PG8_MMA
#undef PG8_WAIT_V
#undef PG8_WAIT_L
#undef PG8_BAR
#undef PG8_SCHED
}
}

constexpr int DM = 1024, TP = 2064, NPR = 8 * TP  , NR = NPR + 1024  , MP = 17664  , MT = 69;
constexpr int NTHREADS = 512, LDS_BYTES = pg8::STAGE_BYTES;
constexpr size_t UB = (size_t)MP * 1024 * 2;
constexpr size_t WS_WIN = 0;
constexpr size_t WS_WOUT = WS_WIN + (size_t)6400 * 1024 * 2;
constexpr size_t WS_WR = WS_WOUT + (size_t)1024 * 2048 * 2;
constexpr size_t WS_WL2 = WS_WR + (size_t)4608 * 1024 * 2;
constexpr size_t WS_WO = WS_WL2 + (size_t)2048 * 256 * 2;
constexpr size_t WS_WEND = WS_WO + (size_t)1024 * 1024 * 2;
static_assert(WS_WEND <= UB, "weights fit one unit");
constexpr size_t WS_X1 = 1 * UB;
constexpr size_t WS_QKVPRE = 3 * UB;
constexpr size_t WS_OBUF = 3 * UB;
constexpr size_t WS_XS = 3 * UB;
constexpr size_t WS_LOUT = 3 * UB;
constexpr size_t WS_X2 = 3 * UB;
constexpr size_t WS_YBUF = 3 * UB;
constexpr size_t WS_DB = 5 * UB;
constexpr size_t WS_KKB = 7 * UB;
constexpr size_t WS_BBB = 8 * UB;
constexpr size_t WS_Z = 7 * UB;
constexpr size_t WS_YG = 13 * UB;
constexpr size_t WS_QKV = 9 * UB;
constexpr size_t WS_OG = 9 * UB;
constexpr size_t WS_RKVZ = 9 * UB;
constexpr size_t WS_XN0 = 13 * UB;
constexpr size_t WS_BA = 14 * UB;
constexpr size_t WS_GB = WS_BA + (size_t)MP * 32 * 4;
constexpr size_t WS_LH = WS_GB + (size_t)MP * 32 * 4;
constexpr size_t WS_RK = WS_LH + (size_t)MP * 256 * 2;
constexpr size_t WS_END = WS_RK + (size_t)MP * 16 * 4;
constexpr size_t O_YP = 0, O_YS = 16777216, O_PG = 17825792, O_PGC = 19922944, O_PR = 20021248, O_PRS = 20545536, O_SG = 20553728, O_SGC = 54108160, O_SR = 55681024, O_SRS = 64069632;

struct TJob { const float* src; h16* dst; int srcK, srcN, dst_ld, row0, nrows, col0, ncols, tile0; };
struct Args {
    const float* in[29];
    float* out; unsigned char* ws;
    int ph_lo, ph_hi;
};
constexpr int NTILES_PREP = 3648;
enum { I_XP = 0, I_XS, I_SG, I_SGC, I_SR, I_SRS, I_META, I_NW, I_FNW, I_WIN, I_CW, I_ALOG, I_DTB, I_GNW, I_WOUT, I_MU, I_WRKVZ, I_W0, I_W1, I_W2, I_A0, I_A1, I_A2, I_KK, I_KA, I_RK, I_LNW, I_LNB, I_WO };

__device__ __forceinline__ float wave_sum(float v) {
#pragma unroll
    for (int o = 32; o > 0; o >>= 1) v += __shfl_xor(v, o);
    return v;
}
__device__ __forceinline__ float sigmoidf_(float x) { return 1.0f / (1.0f + expf(-x)); }
__device__ __forceinline__ float siluf_(float x) { return x / (1.0f + expf(-x)); }
__device__ __forceinline__ float softplusf_(float x) { return x > 20.0f ? x : log1pf(expf(x)); }
__device__ __forceinline__ void row_bt(int r, int& b, int& t, bool& samp) {
    if (r < NPR) { b = r / TP; t = r - b * TP; samp = false; } else { const int q = r - NPR; b = q >> 3; t = q & 7; samp = true; }
}
__device__ __forceinline__ const float* xrow(const Args& a, int r) {
    if (r < NPR) { const int b = r / TP, t = r - b * TP; return t < 16 ? a.in[I_META] + (size_t)t * DM : a.in[I_XP] + ((size_t)b * 2048 + (t - 16)) * DM; }
    return a.in[I_XS] + (size_t)(r - NPR) * DM;
}
__device__ __forceinline__ h16x8 pack8(const f32x4 v0, const f32x4 v1) {
    h16x8 w; w[0] = (h16)v0[0]; w[1] = (h16)v0[1]; w[2] = (h16)v0[2]; w[3] = (h16)v0[3]; w[4] = (h16)v1[0]; w[5] = (h16)v1[1]; w[6] = (h16)v1[2]; w[7] = (h16)v1[3]; return w;
}

__device__ __forceinline__ void phase_prep(const Args& a, float* ldsf) {
    const int tid = threadIdx.x, lane = tid & 63, wid = tid >> 6;
    for (int tile = blockIdx.x; tile < NTILES_PREP; tile += gridDim.x) {
        TJob jb;
        { h16* Win = (h16*)(a.ws + WS_WIN); h16* Wout = (h16*)(a.ws + WS_WOUT); h16* Wr = (h16*)(a.ws + WS_WR); h16* Wl2 = (h16*)(a.ws + WS_WL2); h16* Wo = (h16*)(a.ws + WS_WO);
          if (tile < 1600)      jb = TJob{a.in[I_WIN], Win, 1024, 6176, 1024, 0, 6400, 0, 1024, 0};
          else if (tile < 2112) jb = TJob{a.in[I_WOUT], Wout, 2048, 1024, 2048, 0, 1024, 0, 2048, 1600};
          else if (tile < 3136) { const int s = (tile - 2112) >> 8; jb = TJob{a.in[I_WRKVZ] + (size_t)s * 1024 * 1024, Wr, 1024, 1024, 1024, s * 1024, 1024, 0, 1024, 2112 + s * 256}; }
          else if (tile < 3200) jb = TJob{a.in[I_W1], Wr, 1024, 64, 1024, 4096, 256, 0, 1024, 3136};
          else if (tile < 3264) jb = TJob{a.in[I_A1], Wr, 1024, 64, 1024, 4352, 256, 0, 1024, 3200};
          else if (tile < 3328) jb = TJob{a.in[I_W2], Wl2, 64, 1024, 256, 0, 1024, 0, 256, 3264};
          else if (tile < 3392) jb = TJob{a.in[I_A2], Wl2, 64, 1024, 256, 1024, 1024, 64, 256, 3328};
          else                  jb = TJob{a.in[I_WO], Wo, 1024, 1024, 1024, 0, 1024, 0, 1024, 3392}; }
        const int lt = tile - jb.tile0, nck = jb.ncols >> 6, tn = lt / nck, tk = lt - tn * nck;
        __syncthreads();
#pragma unroll
        for (int e = 0; e < 8; ++e) {
            const int idx = e * 512 + tid, kk = idx >> 6, nn = idx & 63;
            const int ks = tk * 64 + kk - jb.col0, ns = tn * 64 + nn;
            float v = 0.f;
            if (ks >= 0 && ks < jb.srcK && ns < jb.srcN) v = jb.src[(size_t)ks * jb.srcN + ns];
            ldsf[kk * 65 + nn] = v;
        }
        __syncthreads();
#pragma unroll
        for (int e = 0; e < 8; ++e) {
            const int idx = e * 512 + tid, nn = idx >> 6, kk = idx & 63;
            jb.dst[(size_t)(jb.row0 + tn * 64 + nn) * jb.dst_ld + tk * 64 + kk] = (h16)ldsf[kk * 65 + nn];
        }
    }
    h16* xn0 = (h16*)(a.ws + WS_XN0);
    const float* nw = a.in[I_NW];
    for (int row = blockIdx.x * 8 + wid; row < MP; row += gridDim.x * 8) {
        h16* op = xn0 + (size_t)row * DM;
        if (row >= NR) {
#pragma unroll
            for (int i = 0; i < 4; ++i) *(h16x4*)(op + i * 256 + lane * 4) = (h16x4){(h16)0.f, (h16)0.f, (h16)0.f, (h16)0.f};
            continue;
        }
        const float* xp = xrow(a, row);
        f32x4 v[4]; float ss = 0.f;
#pragma unroll
        for (int i = 0; i < 4; ++i) { v[i] = *(const f32x4*)(xp + i * 256 + lane * 4); ss += v[i][0] * v[i][0] + v[i][1] * v[i][1] + v[i][2] * v[i][2] + v[i][3] * v[i][3]; }
        ss = wave_sum(ss);
        const float sc = rsqrtf(ss * (1.0f / 1024.0f) + 1e-6f);
#pragma unroll
        for (int i = 0; i < 4; ++i) { const f32x4 w = *(const f32x4*)(nw + i * 256 + lane * 4); h16x4 o;
#pragma unroll
            for (int j = 0; j < 4; ++j) o[j] = (h16)(v[i][j] * sc * w[j]);
            *(h16x4*)(op + i * 256 + lane * 4) = o; }
    }
}

struct EpiProj {
    static constexpr bool PERM = true;
    h16* qkv; h16* z; float* ba;
    __device__ __forceinline__ void operator()(const f32x4 (&acc)[2][2][4][2], const pg8::Unit& u, int wr, int wc, int fr, int fq) const {
        const int row0 = u.pm * 256 + wr * 64 + fr;
        if (u.pn < 24) {
            h16* base = u.pn < 16 ? qkv : z; const int ld = u.pn < 16 ? 4096 : 2048; const int col0 = (u.pn < 16 ? u.pn : u.pn - 16) * 256 + wc * 32 + 8 * fq;
#pragma unroll
            for (int ai = 0; ai < 2; ++ai)
#pragma unroll
                for (int m = 0; m < 4; ++m) { h16* rowp = base + (size_t)(row0 + ai * 128 + m * 16) * ld + col0;
#pragma unroll
                    for (int bj = 0; bj < 2; ++bj) *(h16x8*)(rowp + bj * 128) = pack8(acc[ai][bj][m][0], acc[ai][bj][m][1]); }
        } else if (wc == 0) {
#pragma unroll
            for (int ai = 0; ai < 2; ++ai)
#pragma unroll
                for (int m = 0; m < 4; ++m) { float* rowp = ba + (size_t)(row0 + ai * 128 + m * 16) * 32 + 8 * fq;
                    *(f32x4*)rowp = acc[ai][0][m][0]; *(f32x4*)(rowp + 4) = acc[ai][0][m][1]; }
        }
    }
};
struct EpiH16 {
    static constexpr bool PERM = true;
    h16* O; int ld;
    __device__ __forceinline__ void operator()(const f32x4 (&acc)[2][2][4][2], const pg8::Unit& u, int wr, int wc, int fr, int fq) const {
        const int row0 = u.pm * 256 + wr * 64 + fr, col0 = u.pn * 256 + wc * 32 + 8 * fq;
#pragma unroll
        for (int ai = 0; ai < 2; ++ai)
#pragma unroll
            for (int m = 0; m < 4; ++m) { h16* rowp = O + (size_t)(row0 + ai * 128 + m * 16) * ld + col0;
#pragma unroll
                for (int bj = 0; bj < 2; ++bj) *(h16x8*)(rowp + bj * 128) = pack8(acc[ai][bj][m][0], acc[ai][bj][m][1]); }
    }
};
struct EpiResX {
    static constexpr bool PERM = false;
    const float* meta; const float* xpr; const float* xsm; float* O;
    __device__ __forceinline__ void operator()(const f32x4 (&acc)[2][2][4][2], const pg8::Unit& u, int wr, int wc, int fr, int fq) const {
        const int row0 = u.pm * 256 + wr * 64 + fr, col0 = u.pn * 256 + wc * 32 + 4 * fq;
#pragma unroll
        for (int ai = 0; ai < 2; ++ai)
#pragma unroll
            for (int m = 0; m < 4; ++m) { const int row = row0 + ai * 128 + m * 16; if (row >= NR) continue;
                const float* xp;
                if (row < NPR) { const int b = row / TP, t = row - b * TP; xp = t < 16 ? meta + (size_t)t * DM : xpr + ((size_t)b * 2048 + (t - 16)) * DM; } else xp = xsm + (size_t)(row - NPR) * DM;
                xp += col0; float* rowp = O + (size_t)row * DM + col0;
#pragma unroll
                for (int bj = 0; bj < 2; ++bj)
#pragma unroll
                    for (int n = 0; n < 2; ++n) *(f32x4*)(rowp + bj * 128 + n * 16) = *(const f32x4*)(xp + bj * 128 + n * 16) + acc[ai][bj][m][n]; }
    }
};
struct EpiResB {
    static constexpr bool PERM = false;
    const float* base; float* O;
    __device__ __forceinline__ void operator()(const f32x4 (&acc)[2][2][4][2], const pg8::Unit& u, int wr, int wc, int fr, int fq) const {
        const int row0 = u.pm * 256 + wr * 64 + fr, col0 = u.pn * 256 + wc * 32 + 4 * fq;
#pragma unroll
        for (int ai = 0; ai < 2; ++ai)
#pragma unroll
            for (int m = 0; m < 4; ++m) { const int row = row0 + ai * 128 + m * 16; if (row >= NR) continue;
                const float* xp = base + (size_t)row * DM + col0; float* rowp = O + (size_t)row * DM + col0;
#pragma unroll
                for (int bj = 0; bj < 2; ++bj)
#pragma unroll
                    for (int n = 0; n < 2; ++n) *(f32x4*)(rowp + bj * 128 + n * 16) = *(const f32x4*)(xp + bj * 128 + n * 16) + acc[ai][bj][m][n]; }
    }
};
struct EpiG {
    static constexpr bool PERM = true;
    h16* rkvz; h16* lh;
    __device__ __forceinline__ void operator()(const f32x4 (&acc)[2][2][4][2], const pg8::Unit& u, int wr, int wc, int fr, int fq) const {
        const int s = u.pm / MT, i = u.pm - s * MT, row0 = i * 256 + wr * 64 + fr;
        if (s < 4) {
            h16* base = rkvz + (size_t)s * MP * 1024; const int col0 = (u.pn - 4 * s) * 256 + wc * 32 + 8 * fq;
#pragma unroll
            for (int ai = 0; ai < 2; ++ai)
#pragma unroll
                for (int m = 0; m < 4; ++m) { h16* rowp = base + (size_t)(row0 + ai * 128 + m * 16) * 1024 + col0;
#pragma unroll
                    for (int bj = 0; bj < 2; ++bj) *(h16x8*)(rowp + bj * 128) = pack8(acc[ai][bj][m][0], acc[ai][bj][m][1]); }
        } else if (wc < 2) {
            const int cb = (s == 4 ? 0 : 64) + wc * 32 + 8 * fq;
#pragma unroll
            for (int ai = 0; ai < 2; ++ai)
#pragma unroll
                for (int m = 0; m < 4; ++m) { h16* rowp = lh + (size_t)(row0 + ai * 128 + m * 16) * 256;
                    f32x4 v0 = acc[ai][0][m][0], v1 = acc[ai][0][m][1];
                    if (s == 4) {
#pragma unroll
                        for (int j = 0; j < 4; ++j) { v0[j] = tanhf(v0[j]); v1[j] = tanhf(v1[j]); } }
                    *(h16x8*)(rowp + cb) = pack8(v0, v1);
                    *(h16x8*)(rowp + 128 + cb) = pack8((f32x4){0.f, 0.f, 0.f, 0.f}, (f32x4){0.f, 0.f, 0.f, 0.f}); }
        }
    }
};
struct OrderG {
    pg8::StaticOrder so; int G, c;
    __device__ void init(int G_, int c_) { so.init(4 * MT * 256, 1024, G_, c_); G = G_; c = c_; }
    __device__ bool next(int i, pg8::Unit& u) const {
        long L = (long)i * G + c;
        if (L < 4 * MT * 4) { pg8::Unit v; so.next(i, v); u.pm = v.pm; u.pn = (v.pm / MT) * 4 + v.pn; return true; }
        L -= 4 * MT * 4; if (L >= 2 * MT) return false;
        const int s = 4 + (int)(L / MT), ii = (int)(L % MT); u.pm = s * MT + ii; u.pn = 12 + s; return true;
    }
};

__device__ __forceinline__ void phase_conv(const Args& a) {
    const int lane = threadIdx.x & 63, wid = threadIdx.x >> 6;
    const h16* pre = (const h16*)(a.ws + WS_QKVPRE); h16* qkv = (h16*)(a.ws + WS_QKV);
    const float* ba = (const float*)(a.ws + WS_BA); float* gb = (float*)(a.ws + WS_GB);
    const float* cwp = a.in[I_CW]; const float* cst = a.in[I_SGC];
    for (int row = blockIdx.x * 8 + wid; row < NR; row += gridDim.x * 8) {
        int b, t; bool samp; row_bt(row, b, t, samp);
        for (int seg = 0; seg < 8; ++seg) {
            const int c0 = seg * 512 + lane * 8;
            float y[8], ut[8];
#pragma unroll
            for (int j = 0; j < 8; ++j) { y[j] = 0.f; ut[j] = 0.f; }
            f32x4 w[8];
#pragma unroll
            for (int j = 0; j < 8; ++j) w[j] = *(const f32x4*)(cwp + (size_t)(c0 + j) * 4);
#pragma unroll
            for (int jj = 0; jj < 4; ++jj) {
                const int idx = t + jj;
                float x[8];
                if (idx >= 3) { const h16x8 hv = *(const h16x8*)(pre + (size_t)(row - 3 + jj) * 4096 + c0);
#pragma unroll
                    for (int j = 0; j < 8; ++j) x[j] = (float)hv[j]; }
                else if (samp) { const float* bp = cst + ((size_t)b * 3 + idx) * 4096 + c0; const f32x4 p0 = *(const f32x4*)bp, p1 = *(const f32x4*)(bp + 4);
#pragma unroll
                    for (int j = 0; j < 4; ++j) { x[j] = p0[j]; x[4 + j] = p1[j]; } }
                else {
#pragma unroll
                    for (int j = 0; j < 8; ++j) x[j] = 0.f; }
#pragma unroll
                for (int j = 0; j < 8; ++j) y[j] += x[j] * w[j][jj];
                if (jj == 3) {
#pragma unroll
                    for (int j = 0; j < 8; ++j) ut[j] = x[j]; }
            }
            float ss = 0.f;
#pragma unroll
            for (int j = 0; j < 8; ++j) { y[j] = siluf_(y[j]); ss += y[j] * y[j]; }
            float sc = 1.0f;
            if (seg < 4) {
                ss += __shfl_xor(ss, 1); ss += __shfl_xor(ss, 2); ss += __shfl_xor(ss, 4); ss += __shfl_xor(ss, 8);
                sc = rsqrtf(ss + 1e-6f) * (seg < 2 ? 0.08838834764831845f : 1.0f);
            }
            h16x8 o;
#pragma unroll
            for (int j = 0; j < 8; ++j) o[j] = (h16)(y[j] * sc);
            *(h16x8*)(qkv + (size_t)row * 4096 + c0) = o;
            float* cso = nullptr;
            if (!samp && t >= TP - 3) cso = a.out + O_PGC + ((size_t)b * 3 + (t - (TP - 3))) * 4096 + c0;
            if (samp && t >= 5) cso = a.out + O_SGC + ((size_t)b * 3 + (t - 5)) * 4096 + c0;
            if (cso) { *(f32x4*)cso = (f32x4){ut[0], ut[1], ut[2], ut[3]}; *(f32x4*)(cso + 4) = (f32x4){ut[4], ut[5], ut[6], ut[7]}; }
        }
        if (lane < 16) {
            const float bv = ba[(size_t)row * 32 + lane], av = ba[(size_t)row * 32 + 16 + lane];
            gb[(size_t)row * 32 + lane] = sigmoidf_(bv);
            gb[(size_t)row * 32 + 16 + lane] = -expf(a.in[I_ALOG][lane]) * softplusf_(av + a.in[I_DTB][lane]);
        }
    }
}

__device__ __forceinline__ void phase_gdn_scan(const Args& a, float* ldsf) {
    const int lane = threadIdx.x & 63, wid = threadIdx.x >> 6;
    const int vl = lane >> 2, kq = lane & 3;
    float* L = ldsf + wid * 2208;
    float* Lq = L, *Lk = L + 1024, *Lv = L + 2048, *Lg = L + 2176, *Lb = L + 2184;
    const h16* qkv = (const h16*)(a.ws + WS_QKV); const float* gb = (const float*)(a.ws + WS_GB); float* obuf = (float*)(a.ws + WS_OBUF);
    const int NW = gridDim.x * 8, gw = wid * gridDim.x + blockIdx.x;
    for (int it = gw; it < 1024 + 16384; it += NW) {
        const bool samp = it >= 1024; const int q = samp ? it - 1024 : it;
        const int seq = q >> 3, vg = q & 7, b = seq >> 4, hv = seq & 15, hq = hv >> 1;
        const int T = samp ? 8 : TP, row0 = samp ? NPR + b * 8 : b * TP;
        const int v = vg * 16 + vl;
        float S[32];
        if (samp) { const float* sp = a.in[I_SG] + ((size_t)(b * 16 + hv) * 128 + kq * 32) * 128 + v;
#pragma unroll
            for (int i = 0; i < 32; ++i) S[i] = sp[(size_t)i * 128]; }
        else {
#pragma unroll
            for (int i = 0; i < 32; ++i) S[i] = 0.f; }
        for (int t0 = 0; t0 < T; t0 += 8) {
            __builtin_amdgcn_wave_barrier();
            { const int tt = lane >> 3, part = lane & 7; const h16* rp = qkv + (size_t)(row0 + t0 + tt) * 4096;
              const h16x8 q0 = *(const h16x8*)(rp + hq * 128 + part * 16), q1 = *(const h16x8*)(rp + hq * 128 + part * 16 + 8);
              const h16x8 k0 = *(const h16x8*)(rp + 1024 + hq * 128 + part * 16), k1 = *(const h16x8*)(rp + 1024 + hq * 128 + part * 16 + 8);
              float* dq = Lq + tt * 128 + part * 16; float* dk = Lk + tt * 128 + part * 16;
#pragma unroll
              for (int j = 0; j < 8; ++j) { dq[j] = (float)q0[j]; dq[8 + j] = (float)q1[j]; dk[j] = (float)k0[j]; dk[8 + j] = (float)k1[j]; }
              if (lane < 8) { const h16* vp = qkv + (size_t)(row0 + t0 + lane) * 4096 + 2048 + hv * 128 + vg * 16;
                  const h16x8 v0 = *(const h16x8*)vp, v1 = *(const h16x8*)(vp + 8);
#pragma unroll
                  for (int j = 0; j < 8; ++j) { Lv[lane * 16 + j] = (float)v0[j]; Lv[lane * 16 + 8 + j] = (float)v1[j]; }
                  Lb[lane] = gb[(size_t)(row0 + t0 + lane) * 32 + hv]; Lg[lane] = gb[(size_t)(row0 + t0 + lane) * 32 + 16 + hv]; } }
            __builtin_amdgcn_fence(__ATOMIC_RELEASE, "wavefront");
            __builtin_amdgcn_wave_barrier();
            for (int tt = 0; tt < 8; ++tt) {
                const float al = expf(Lg[tt]), be = Lb[tt], vv = Lv[tt * 16 + vl];
                const f32x4* kp = (const f32x4*)(Lk + tt * 128 + kq * 32); const f32x4* qp = (const f32x4*)(Lq + tt * 128 + kq * 32);
                float kr[32];
                float dot = 0.f;
#pragma unroll
                for (int i = 0; i < 8; ++i) { const f32x4 kv = kp[i]; kr[4 * i] = kv[0]; kr[4 * i + 1] = kv[1]; kr[4 * i + 2] = kv[2]; kr[4 * i + 3] = kv[3]; }
#pragma unroll
                for (int i = 0; i < 32; ++i) dot += kr[i] * S[i];
                dot += __shfl_xor(dot, 1); dot += __shfl_xor(dot, 2);
                const float c = be * (vv - al * dot);
                float od = 0.f;
#pragma unroll
                for (int i = 0; i < 8; ++i) { const f32x4 qv = qp[i];
#pragma unroll
                    for (int j = 0; j < 4; ++j) { const float s = al * S[4 * i + j] + kr[4 * i + j] * c; S[4 * i + j] = s; od += qv[j] * s; } }
                od += __shfl_xor(od, 1); od += __shfl_xor(od, 2);
                if (kq == 0) obuf[(size_t)(row0 + t0 + tt) * 2048 + hv * 128 + v] = od;
            }
        }
        float* so = a.out + (samp ? O_SG : O_PG) + ((size_t)(b * 16 + hv) * 128 + kq * 32) * 128 + v;
#pragma unroll
        for (int i = 0; i < 32; ++i) so[(size_t)i * 128] = S[i];
    }
}

__device__ __forceinline__ void phase_gdn_gate(const Args& a) {
    const int lane = threadIdx.x & 63, wid = threadIdx.x >> 6;
    const float* obuf = (const float*)(a.ws + WS_OBUF); const h16* z = (const h16*)(a.ws + WS_Z); h16* og = (h16*)(a.ws + WS_OG);
    const f32x2 gw = *(const f32x2*)(a.in[I_GNW] + lane * 2);
    for (int row = blockIdx.x * 8 + wid; row < NR; row += gridDim.x * 8) {
        for (int h = 0; h < 16; ++h) {
            const f32x2 o = *(const f32x2*)(obuf + (size_t)row * 2048 + h * 128 + lane * 2);
            const h16x2 zz = *(const h16x2*)(z + (size_t)row * 2048 + h * 128 + lane * 2);
            const float ss = wave_sum(o[0] * o[0] + o[1] * o[1]);
            const float sc = rsqrtf(ss * (1.0f / 128.0f) + 1e-6f);
            h16x2 r; r[0] = (h16)(o[0] * sc * gw[0] * siluf_((float)zz[0])); r[1] = (h16)(o[1] * sc * gw[1] * siluf_((float)zz[1]));
            *(h16x2*)(og + (size_t)row * 2048 + h * 128 + lane * 2) = r;
        }
    }
}

__device__ __forceinline__ void phase_shift(const Args& a) {
    const int lane = threadIdx.x & 63, wid = threadIdx.x >> 6;
    const float* x1 = (const float*)(a.ws + WS_X1); h16* xs = (h16*)(a.ws + WS_XS);
    const float* nw = a.in[I_NW] + DM; const float* mu = a.in[I_MU];
    for (int row = blockIdx.x * 8 + wid; row < NR; row += gridDim.x * 8) {
        int b, t; bool samp; row_bt(row, b, t, samp);
        f32x4 xn[4], xp[4];
        { const float* p = x1 + (size_t)row * DM; float ss = 0.f;
#pragma unroll
          for (int i = 0; i < 4; ++i) { xn[i] = *(const f32x4*)(p + i * 256 + lane * 4); ss += xn[i][0] * xn[i][0] + xn[i][1] * xn[i][1] + xn[i][2] * xn[i][2] + xn[i][3] * xn[i][3]; }
          ss = wave_sum(ss); const float sc = rsqrtf(ss * (1.0f / 1024.0f) + 1e-6f);
#pragma unroll
          for (int i = 0; i < 4; ++i) xn[i] = xn[i] * sc * *(const f32x4*)(nw + i * 256 + lane * 4); }
        if (t > 0) { const float* p = x1 + (size_t)(row - 1) * DM; float ss = 0.f;
#pragma unroll
          for (int i = 0; i < 4; ++i) { xp[i] = *(const f32x4*)(p + i * 256 + lane * 4); ss += xp[i][0] * xp[i][0] + xp[i][1] * xp[i][1] + xp[i][2] * xp[i][2] + xp[i][3] * xp[i][3]; }
          ss = wave_sum(ss); const float sc = rsqrtf(ss * (1.0f / 1024.0f) + 1e-6f);
#pragma unroll
          for (int i = 0; i < 4; ++i) xp[i] = xp[i] * sc * *(const f32x4*)(nw + i * 256 + lane * 4); }
        else if (samp) {
#pragma unroll
          for (int i = 0; i < 4; ++i) xp[i] = *(const f32x4*)(a.in[I_SRS] + (size_t)b * DM + i * 256 + lane * 4); }
        else {
#pragma unroll
          for (int i = 0; i < 4; ++i) xp[i] = (f32x4){0.f, 0.f, 0.f, 0.f}; }
        for (int s = 0; s < 6; ++s) {
#pragma unroll
            for (int i = 0; i < 4; ++i) { const f32x4 m = *(const f32x4*)(mu + (size_t)s * DM + i * 256 + lane * 4); const f32x4 r = xn[i] + (xp[i] - xn[i]) * m;
                h16x4 o; o[0] = (h16)r[0]; o[1] = (h16)r[1]; o[2] = (h16)r[2]; o[3] = (h16)r[3];
                *(h16x4*)(xs + ((size_t)s * MP + row) * DM + i * 256 + lane * 4) = o; }
        }
        float* so = nullptr;
        if (!samp && t == TP - 1) so = a.out + O_PRS + (size_t)b * DM;
        if (samp && t == 7) so = a.out + O_SRS + (size_t)b * DM;
        if (so) {
#pragma unroll
            for (int i = 0; i < 4; ++i) *(f32x4*)(so + i * 256 + lane * 4) = xn[i]; }
    }
}

#define DPP_ADD(x, ctrl) ((x) + __builtin_bit_cast(float, __builtin_amdgcn_update_dpp(0, __builtin_bit_cast(int, (x)), (ctrl), 0xF, 0xF, true)))
__device__ __forceinline__ float red4(float x) { x = DPP_ADD(x, 0xB1); x = DPP_ADD(x, 0x4E); return x; }
__device__ __forceinline__ float red16(float x) { x = DPP_ADD(x, 0xB1); x = DPP_ADD(x, 0x4E); x = DPP_ADD(x, 0x141); x = DPP_ADD(x, 0x140); return x; }

__device__ __forceinline__ void phase_rwkv_prep(const Args& a) {
    const int lane = threadIdx.x & 63, wid = threadIdx.x >> 6;
    h16* rkvz = (h16*)(a.ws + WS_RKVZ); const h16* lo = (const h16*)(a.ws + WS_LOUT);
    float* dbuf = (float*)(a.ws + WS_DB); h16* kkb = (h16*)(a.ws + WS_KKB); h16* bbb = (h16*)(a.ws + WS_BBB); float* rkb = (float*)(a.ws + WS_RK);
    for (int row = blockIdx.x * 8 + wid; row < NR; row += gridDim.x * 8) {
#pragma unroll 4
        for (int h = 0; h < 16; ++h) {
            const int c = h * 64 + lane;
            const float r = (float)rkvz[(size_t)row * 1024 + c], k = (float)rkvz[((size_t)MP + row) * 1024 + c];
            const float wl = (float)lo[(size_t)row * 2048 + c], al = (float)lo[(size_t)row * 2048 + 1024 + c];
            const float w = -softplusf_(-(a.in[I_W0][c] + wl)) - 0.5f;
            const float d = expf(-expf(w));
            const float aa = sigmoidf_(a.in[I_A0][c] + al);
            const float kkv = k * a.in[I_KK][c];
            const float ss = wave_sum(kkv * kkv);
            const float kk = kkv * rsqrtf(ss + 1e-6f);
            const float k2 = k * (1.0f + (aa - 1.0f) * a.in[I_KA][c]);
            const float rk = wave_sum(r * k2 * a.in[I_RK][c]);
            if (lane == 0) rkb[(size_t)row * 16 + h] = rk;
            rkvz[((size_t)MP + row) * 1024 + c] = (h16)k2;
            dbuf[(size_t)row * 1024 + c] = d; kkb[(size_t)row * 1024 + c] = (h16)kk; bbb[(size_t)row * 1024 + c] = (h16)(kk * aa);
        }
    }
}

__device__ __forceinline__ void phase_rwkv_scan(const Args& a, float* ldsf) {
    const int tid = threadIdx.x, lane = tid & 63, wid = tid >> 6;
    const int rl = lane >> 4, kq = lane & 15;
    const h16* rkvz = (const h16*)(a.ws + WS_RKVZ); const float* dbuf = (const float*)(a.ws + WS_DB);
    const h16* kkb = (const h16*)(a.ws + WS_KKB); const h16* bbb = (const h16*)(a.ws + WS_BBB);
    float* ybuf = (float*)(a.ws + WS_YBUF);
    const int stt = tid >> 6, sch = tid & 63;
    for (int it = blockIdx.x; it < 256 + 4096; it += gridDim.x) {
        const bool samp = it >= 256; const int q = samp ? it - 256 : it;
        const int seq = q >> 1, half = q & 1, b = seq >> 4, h = seq & 15;
        const int T = samp ? 8 : TP, row0 = samp ? NPR + b * 8 : b * TP;
        const int v = half * 32 + wid * 4 + rl;
        f32x4 S;
        if (samp) S = *(const f32x4*)(a.in[I_SR] + ((size_t)(b * 16 + h) * 64 + v) * 64 + kq * 4);
        else S = (f32x4){0.f, 0.f, 0.f, 0.f};
        float pr, pk, pd, pkk, pb, pv;
        { const size_t e = (size_t)(row0 + stt) * 1024 + h * 64 + sch;
          pr = (float)rkvz[e]; pk = (float)rkvz[(size_t)MP * 1024 + e]; pv = (float)rkvz[(size_t)2 * MP * 1024 + e]; pd = dbuf[e]; pkk = (float)kkb[e]; pb = (float)bbb[e]; }
        __syncthreads();
        int cur = 0;
        for (int t0 = 0; t0 < T; t0 += 8) {
            float* Lb = ldsf + cur * 3072;
            Lb[stt * 64 + sch] = pr; Lb[512 + stt * 64 + sch] = pk; Lb[1024 + stt * 64 + sch] = pd; Lb[1536 + stt * 64 + sch] = pkk; Lb[2048 + stt * 64 + sch] = pb; Lb[2560 + stt * 64 + sch] = pv;
            __syncthreads();
            if (t0 + 8 < T) { const size_t e = (size_t)(row0 + t0 + 8 + stt) * 1024 + h * 64 + sch;
                pr = (float)rkvz[e]; pk = (float)rkvz[(size_t)MP * 1024 + e]; pv = (float)rkvz[(size_t)2 * MP * 1024 + e]; pd = dbuf[e]; pkk = (float)kkb[e]; pb = (float)bbb[e]; }
#pragma unroll
            for (int tt = 0; tt < 8; ++tt) {
                const f32x4 kk4 = *(const f32x4*)(Lb + 1536 + tt * 64 + kq * 4), d4 = *(const f32x4*)(Lb + 1024 + tt * 64 + kq * 4), b4 = *(const f32x4*)(Lb + 2048 + tt * 64 + kq * 4);
                const f32x4 k4 = *(const f32x4*)(Lb + 512 + tt * 64 + kq * 4), r4 = *(const f32x4*)(Lb + tt * 64 + kq * 4);
                const float vv = Lb[2560 + tt * 64 + v];
                float sa = S[0] * kk4[0] + S[1] * kk4[1] + S[2] * kk4[2] + S[3] * kk4[3];
                sa = red16(sa);
                const float nsa = -sa;
                S = S * d4 + nsa * b4 + vv * k4;
                float y = S[0] * r4[0] + S[1] * r4[1] + S[2] * r4[2] + S[3] * r4[3];
                y = red16(y);
                if (kq == 0) ybuf[(size_t)(row0 + t0 + tt) * 1024 + h * 64 + v] = y;
            }
            cur ^= 1;
        }
        *(f32x4*)(a.out + (samp ? O_SR : O_PR) + ((size_t)(b * 16 + h) * 64 + v) * 64 + kq * 4) = S;
    }
}

__device__ __forceinline__ void phase_rwkv_gate(const Args& a) {
    const int lane = threadIdx.x & 63, wid = threadIdx.x >> 6;
    const float* ybuf = (const float*)(a.ws + WS_YBUF); const float* rkb = (const float*)(a.ws + WS_RK);
    const h16* rkvz = (const h16*)(a.ws + WS_RKVZ); h16* yg = (h16*)(a.ws + WS_YG);
    for (int row = blockIdx.x * 8 + wid; row < NR; row += gridDim.x * 8) {
        for (int h = 0; h < 16; ++h) {
            const int c = h * 64 + lane;
            const float y = ybuf[(size_t)row * 1024 + c];
            const float mean = wave_sum(y) * (1.0f / 64.0f);
            const float dy = y - mean;
            const float var = wave_sum(dy * dy) * (1.0f / 64.0f);
            float yn = dy * rsqrtf(var + 64e-5f) * a.in[I_LNW][c] + a.in[I_LNB][c];
            const float vv = (float)rkvz[((size_t)2 * MP + row) * 1024 + c], zz = (float)rkvz[((size_t)3 * MP + row) * 1024 + c];
            yn += rkb[(size_t)row * 16 + h] * vv;
            yg[(size_t)row * 1024 + c] = (h16)(yn * siluf_(zz));
        }
    }
}

__device__ __forceinline__ void phase_final(const Args& a) {
    const int lane = threadIdx.x & 63, wid = threadIdx.x >> 6;
    const float* x2 = (const float*)(a.ws + WS_X2); const float* nw = a.in[I_FNW];
    for (int row = blockIdx.x * 8 + wid; row < NR; row += gridDim.x * 8) {
        int b, t; bool samp; row_bt(row, b, t, samp);
        if (!samp && t < 16) continue;
        float* op = samp ? a.out + O_YS + (size_t)(row - NPR) * DM : a.out + O_YP + ((size_t)b * 2048 + (t - 16)) * DM;
        const float* p = x2 + (size_t)row * DM; f32x4 v[4]; float ss = 0.f;
#pragma unroll
        for (int i = 0; i < 4; ++i) { v[i] = *(const f32x4*)(p + i * 256 + lane * 4); ss += v[i][0] * v[i][0] + v[i][1] * v[i][1] + v[i][2] * v[i][2] + v[i][3] * v[i][3]; }
        ss = wave_sum(ss); const float sc = rsqrtf(ss * (1.0f / 1024.0f) + 1e-6f);
#pragma unroll
        for (int i = 0; i < 4; ++i) *(f32x4*)(op + i * 256 + lane * 4) = v[i] * sc * *(const f32x4*)(nw + i * 256 + lane * 4);
    }
}

constexpr int NPHASE = 14;
__global__ void __launch_bounds__(NTHREADS, 2) mk_fwd(Args a) {
    extern __shared__ __attribute__((aligned(16))) unsigned char smem[];
    PG8_LAS unsigned char* lds = (PG8_LAS unsigned char*)smem;
    float* ldsf = (float*)smem;
    const int G = gridDim.x, c = blockIdx.x;
#if MK_COOP
    cg::grid_group grid = cg::this_grid();
#define SEAM(p) do { if ((p) + 1 < a.ph_hi) grid.sync(); } while (0)
#else
#define SEAM(p) do { } while (0)
#endif
#define IN(p) (a.ph_lo <= (p) && (p) < a.ph_hi)
    if (IN(0)) { phase_prep(a, ldsf); SEAM(0); }
    if (IN(1)) { __syncthreads();
        pg8::Gemm g{(const h16*)(a.ws + WS_XN0), (const h16*)(a.ws + WS_WIN), MP, 6400, 1024}; pg8::StaticOrder S; S.init(MP, 6400, G, c);
        EpiProj E{(h16*)(a.ws + WS_QKVPRE), (h16*)(a.ws + WS_Z), (float*)(a.ws + WS_BA)};
        pg8::gemm_phase<EpiProj, pg8::StaticOrder>(lds, g, S, E); SEAM(1); }
    if (IN(2)) { phase_conv(a); SEAM(2); }
    if (IN(3)) { __syncthreads(); phase_gdn_scan(a, ldsf); SEAM(3); }
    if (IN(4)) { phase_gdn_gate(a); SEAM(4); }
    if (IN(5)) { __syncthreads();
        pg8::Gemm g{(const h16*)(a.ws + WS_OG), (const h16*)(a.ws + WS_WOUT), MP, 1024, 2048}; pg8::StaticOrder S; S.init(MP, 1024, G, c);
        EpiResX E{a.in[I_META], a.in[I_XP], a.in[I_XS], (float*)(a.ws + WS_X1)};
        pg8::gemm_phase<EpiResX, pg8::StaticOrder>(lds, g, S, E); SEAM(5); }
    if (IN(6)) { phase_shift(a); SEAM(6); }
    if (IN(7)) { __syncthreads();
        pg8::Gemm g{(const h16*)(a.ws + WS_XS), (const h16*)(a.ws + WS_WR), 6 * MP, 4608, 1024}; OrderG S; S.init(G, c);
        EpiG E{(h16*)(a.ws + WS_RKVZ), (h16*)(a.ws + WS_LH)};
        pg8::gemm_phase<EpiG, OrderG>(lds, g, S, E); SEAM(7); }
    if (IN(8)) { __syncthreads();
        pg8::Gemm g{(const h16*)(a.ws + WS_LH), (const h16*)(a.ws + WS_WL2), MP, 2048, 256}; pg8::StaticOrder S; S.init(MP, 2048, G, c);
        EpiH16 E{(h16*)(a.ws + WS_LOUT), 2048};
        pg8::gemm_phase<EpiH16, pg8::StaticOrder>(lds, g, S, E); SEAM(8); }
    if (IN(9)) { phase_rwkv_prep(a); SEAM(9); }
    if (IN(10)) { __syncthreads(); phase_rwkv_scan(a, ldsf); SEAM(10); }
    if (IN(11)) { phase_rwkv_gate(a); SEAM(11); }
    if (IN(12)) { __syncthreads();
        pg8::Gemm g{(const h16*)(a.ws + WS_YG), (const h16*)(a.ws + WS_WO), MP, 1024, 1024}; pg8::StaticOrder S; S.init(MP, 1024, G, c);
        EpiResB E{(const float*)(a.ws + WS_X1), (float*)(a.ws + WS_X2)};
        pg8::gemm_phase<EpiResB, pg8::StaticOrder>(lds, g, S, E); SEAM(12); }
    if (IN(13)) { phase_final(a); }
#undef IN
#undef SEAM
}

extern "C" void kernel_launch(void* const* d_in, const int* in_sizes, int n_in, void* d_out, int out_size, void* d_ws, size_t ws_size, hipStream_t stream) {
    static int grid = 0;
    if (grid == 0) {
        if (n_in != 29 || ws_size < WS_END) { fprintf(stderr, "kernel_launch: unexpected n_in %d or ws_size %zu (< %zu)\n", n_in, ws_size, (size_t)WS_END); grid = -1; return; }
        int dev = 0, cus = 0, per_cu = 0;
        hipGetDevice(&dev); hipDeviceGetAttribute(&cus, hipDeviceAttributeMultiprocessorCount, dev);
        if (hipFuncSetAttribute((const void*)mk_fwd, hipFuncAttributeMaxDynamicSharedMemorySize, LDS_BYTES) != hipSuccess) { fprintf(stderr, "kernel_launch: hipFuncSetAttribute failed\n"); }
        if (hipOccupancyMaxActiveBlocksPerMultiprocessor(&per_cu, (const void*)mk_fwd, NTHREADS, LDS_BYTES) != hipSuccess || per_cu < 1) { fprintf(stderr, "kernel_launch: occupancy query gave %d\n", per_cu); per_cu = 1; }
        (void)hipGetLastError();
        grid = cus * 1;
        if (grid <= 0) grid = 256;
    }
    if (grid < 0) return;
    Args a; memset(&a, 0, sizeof(a));
    for (int i = 0; i < 29; ++i) a.in[i] = (const float*)d_in[i];
    a.out = (float*)d_out; a.ws = (unsigned char*)d_ws;
#if MK_COOP
    a.ph_lo = 0; a.ph_hi = NPHASE;
    void* args[] = {&a};
    hipError_t e = hipLaunchCooperativeKernel((const void*)mk_fwd, dim3(grid), dim3(NTHREADS), args, LDS_BYTES, stream);
    if (e != hipSuccess) fprintf(stderr, "cooperative launch failed: %s (grid %d)\n", hipGetErrorString(e), grid);
#else
    for (int p = 0; p < NPHASE; ++p) { a.ph_lo = p; a.ph_hi = p + 1; hipLaunchKernelGGL(mk_fwd, dim3(grid), dim3(NTHREADS), LDS_BYTES, stream, a); }
#endif
}
```

```cpp
#include <hip/hip_runtime.h>
#include <hip/hip_cooperative_groups.h>
#include <cstdio>
#include <cstring>
namespace cg = cooperative_groups;

#ifndef MK_COOP
#define MK_COOP 1
#endif

typedef _Float16 h16;
typedef _Float16 h16x8 __attribute__((ext_vector_type(8)));
typedef _Float16 h16x4 __attribute__((ext_vector_type(4)));
typedef _Float16 h16x2 __attribute__((ext_vector_type(2)));
typedef float f32x4 __attribute__((ext_vector_type(4)));
typedef float f32x2 __attribute__((ext_vector_type(2)));

namespace pg8 {
#define PG8_LAS __attribute__((address_space(3)))
constexpr int BM = 256, BK = 64, HALF = 128, HTB = HALF * BK * 2, STAGE_BYTES = 8 * HTB, NXCD = 8, WGM = 8;
__host__ __device__ __forceinline__ int lds_byte(int r, int c) { const int st = (r >> 4) * 2 + (c >> 5), rr = r & 15, cc = c & 31, ob = rr * 64 + cc * 2; return st * 1024 + (ob ^ (((ob >> 9) & 1) << 5)); }
__host__ __device__ __forceinline__ void stage_rc(int b, int& R, int& C) { const int st = b / 1024, sb = b % 1024, swz = sb ^ (((sb >> 9) & 1) << 5); R = (st >> 1) * 16 + swz / 64; C = (st & 1) * 32 + (swz % 64) / 2; }
__host__ __device__ __forceinline__ int perm32(int rho) { const int n = rho >> 4, i = rho & 15; return 8 * (i >> 2) + 4 * n + (i & 3); }
struct Unit { int pm, pn; };
struct Gemm { const h16* A; const h16* Bt; int M, N, K; };
struct StaticOrder {
    int nM, nN, nwg, G, c;
    __host__ __device__ void init(int M, int N, int G_, int c_) { nM = M / BM; nN = N / BM; nwg = nM * nN; G = G_; c = c_; }
    __host__ __device__ bool next(int i, Unit& u) const {
        const long L = (long)i * G + c; if (L >= nwg) return false;
        int wgid = (int)L; { const int q = nwg / NXCD, r = nwg % NXCD, xcd = wgid % NXCD, off = wgid / NXCD; wgid = (xcd < r ? xcd * (q + 1) : r * (q + 1) + (xcd - r) * q) + off; }
        const int nig = WGM * nN, gid = wgid / nig, fm = gid * WGM, gsz = (nM - fm) < WGM ? (nM - fm) : WGM;
        u.pm = fm + ((wgid % nig) % gsz); u.pn = (wgid % nig) / gsz; return true;
    }
};

template <class Epi, class Sched>
__device__ __forceinline__ void gemm_phase(PG8_LAS unsigned char* lds, const Gemm g, const Sched& S, const Epi& E) {
    const int tid = threadIdx.x, wid = __builtin_amdgcn_readfirstlane(tid >> 6), lane = tid & 63, wr = wid >> 2, wc = wid & 3, fr = lane & 15, fq = lane >> 4;
    const int K = g.K, nt = K / BK;
    unsigned voffA[2], voffB[2];
#pragma unroll
    for (int i = 0; i < 2; ++i) { int R, C; stage_rc(tid * 16 + i * 8192, R, C); const int Rb = Epi::PERM ? ((R & ~31) + perm32(R & 31)) : R;
        voffA[i] = (unsigned)(R * K + C) * 2u; voffB[i] = (unsigned)(Rb * K + C) * 2u; }
    const size_t kstep = (size_t)(BK * 2);
    const size_t hstep = (size_t)HALF * K * 2;
    const size_t tstep = 2 * hstep;
    const unsigned ldsw = (unsigned)wid * 1024u;
    const int aoff = lds_byte(wr * 64 + fr, fq * 8), boff = lds_byte(wc * 32 + fr, fq * 8);
#define PG8_SA(b, h) (((b) * 2 + (h)) * HTB)
#define PG8_SB(b, h) ((4 + (b) * 2 + (h)) * HTB)
#define PG8_STAGE(bufoff, gbase, voff) do { _Pragma("unroll") for (int _i = 0; _i < 2; ++_i) \
        __builtin_amdgcn_global_load_lds((const unsigned*)((const char*)(gbase) + (voff)[_i]), (PG8_LAS unsigned*)(lds + (bufoff) + ldsw + _i * 8192), 16, 0, 0); } while (0)
#define PG8_LDA(dst, b, h) do { _Pragma("unroll") for (int m = 0; m < 4; ++m) _Pragma("unroll") for (int k = 0; k < 2; ++k) dst[m][k] = *(const PG8_LAS h16x8*)(lds + PG8_SA(b, h) + aoff + m * 2048 + k * 1024); } while (0)
#define PG8_LDB(dst, b, h) do { _Pragma("unroll") for (int n = 0; n < 2; ++n) _Pragma("unroll") for (int k = 0; k < 2; ++k) dst[n][k] = *(const PG8_LAS h16x8*)(lds + PG8_SB(b, h) + boff + n * 2048 + k * 1024); } while (0)
#define PG8_MMA(ai, bj, At, Bt) do { __builtin_amdgcn_s_setprio(1); _Pragma("unroll") for (int m = 0; m < 4; ++m) _Pragma("unroll") for (int n = 0; n < 2; ++n) _Pragma("unroll") for (int k = 0; k < 2; ++k) \
        acc[ai][bj][m][n] = __builtin_amdgcn_mfma_f32_16x16x32_f16(Bt[n][k], At[m][k], acc[ai][bj][m][n], 0, 0, 0); __builtin_amdgcn_s_setprio(0); } while (0)
#define PG8_WAIT_V(n) asm volatile("s_waitcnt vmcnt(" #n ")" ::: "memory")
#define PG8_WAIT_L(n) asm volatile("s_waitcnt lgkmcnt(" #n ")" ::: "memory")
#define PG8_BAR __builtin_amdgcn_s_barrier()
#define PG8_SCHED __builtin_amdgcn_sched_barrier(0)
    Unit cur, nxt; int ui = 0;
    if (!S.next(0, cur)) return;
    f32x4 acc[2][2][4][2];
#pragma unroll
    for (int a = 0; a < 2; ++a)
#pragma unroll
        for (int b = 0; b < 2; ++b)
#pragma unroll
            for (int m = 0; m < 4; ++m)
#pragma unroll
                for (int n = 0; n < 2; ++n) acc[a][b][m][n] = (f32x4){0.f, 0.f, 0.f, 0.f};
    h16x8 At[4][2], B0[2][2], B1[2][2];
    const char* cA = (const char*)g.A + (size_t)cur.pm * tstep; const char* cB = (const char*)g.Bt + (size_t)cur.pn * tstep;
    PG8_STAGE(PG8_SB(0, 0), cB, voffB); PG8_STAGE(PG8_SA(0, 0), cA, voffA); PG8_STAGE(PG8_SB(0, 1), cB + hstep, voffB); PG8_STAGE(PG8_SA(0, 1), cA + hstep, voffA);
    if (wr == 1) PG8_BAR;
    PG8_WAIT_V(4); PG8_BAR;
    PG8_STAGE(PG8_SB(1, 0), cB + kstep, voffB); PG8_STAGE(PG8_SA(1, 0), cA + kstep, voffA); PG8_STAGE(PG8_SB(1, 1), cB + hstep + kstep, voffB);
    PG8_WAIT_V(6); PG8_BAR;
    for (;;) {
        const bool has_next = S.next(ui + 1, nxt);
        const char* nA = has_next ? (const char*)g.A + (size_t)nxt.pm * tstep : cA; const char* nB = has_next ? (const char*)g.Bt + (size_t)nxt.pn * tstep : cB;
        for (int t = 0; t < nt; t += 2) {
            const bool last = (t == nt - 2);
            const char* a1 = cA + (size_t)(t + 1) * kstep;
            const char* a2 = last ? nA : cA + (size_t)(t + 2) * kstep; const char* b2 = last ? nB : cB + (size_t)(t + 2) * kstep;
            const char* a3 = a2 + kstep; const char* b3 = b2 + kstep;
            PG8_LDB(B0, 0, 0); PG8_SCHED; PG8_LDA(At, 0, 0); PG8_STAGE(PG8_SA(1, 1), a1 + hstep, voffA);
            PG8_WAIT_L(8); PG8_BAR; PG8_WAIT_L(0); PG8_MMA(0, 0, At, B0); PG8_BAR; PG8_SCHED;
            PG8_LDB(B1, 0, 1); PG8_STAGE(PG8_SB(0, 0), b2, voffB);
            PG8_BAR; PG8_WAIT_L(0); PG8_MMA(0, 1, At, B1); PG8_BAR;
            PG8_LDA(At, 0, 1); PG8_STAGE(PG8_SA(0, 0), a2, voffA);
            PG8_BAR; PG8_WAIT_L(0); PG8_MMA(1, 0, At, B0); PG8_BAR; PG8_SCHED;
            PG8_STAGE(PG8_SB(0, 1), b2 + hstep, voffB);
            PG8_WAIT_V(6); PG8_BAR; PG8_MMA(1, 1, At, B1); PG8_BAR;
            PG8_LDB(B0, 1, 0); PG8_SCHED; PG8_LDA(At, 1, 0); PG8_STAGE(PG8_SA(0, 1), a2 + hstep, voffA);
            PG8_WAIT_L(8); PG8_BAR; PG8_WAIT_L(0); PG8_MMA(0, 0, At, B0); PG8_BAR; PG8_SCHED;
            PG8_LDB(B1, 1, 1); PG8_STAGE(PG8_SB(1, 0), b3, voffB);
            PG8_BAR; PG8_WAIT_L(0); PG8_MMA(0, 1, At, B1); PG8_BAR;
            PG8_LDA(At, 1, 1); PG8_STAGE(PG8_SA(1, 0), a3, voffA);
            PG8_BAR; PG8_WAIT_L(0); PG8_MMA(1, 0, At, B0); PG8_BAR; PG8_SCHED;
            PG8_STAGE(PG8_SB(1, 1), b3 + hstep, voffB);
            PG8_WAIT_V(6); PG8_BAR; PG8_MMA(1, 1, At, B1); PG8_BAR;
        }
        E(acc, cur, wr, wc, fr, fq);
        if (!has_next) break;
#pragma unroll
        for (int a = 0; a < 2; ++a)
#pragma unroll
            for (int b = 0; b < 2; ++b)
#pragma unroll
                for (int m = 0; m < 4; ++m)
#pragma unroll
                    for (int n = 0; n < 2; ++n) acc[a][b][m][n] = (f32x4){0.f, 0.f, 0.f, 0.f};
        cur = nxt; cA = nA; cB = nB; ++ui;
    }
    PG8_WAIT_V(0);
    if (wr == 0) PG8_BAR;
    PG8_BAR;
#undef PG8_SA
#undef PG8_SB
#undef PG8_STAGE
#undef PG8_LDA
#undef PG8_LDB
#undef PG8_MMA
#undef PG8_WAIT_V
#undef PG8_WAIT_L
#undef PG8_BAR
#undef PG8_SCHED
}
}

constexpr int DM = 1024, TP = 2064, NPR = 8 * TP  , NR = NPR + 1024  , MP = 17664  , MT = 69;
constexpr int NTHREADS = 512, LDS_BYTES = pg8::STAGE_BYTES;
constexpr size_t UB = (size_t)MP * 1024 * 2;
constexpr size_t WS_WIN = 0;
constexpr size_t WS_WOUT = WS_WIN + (size_t)6400 * 1024 * 2;
constexpr size_t WS_WR = WS_WOUT + (size_t)1024 * 2048 * 2;
constexpr size_t WS_WL2 = WS_WR + (size_t)4608 * 1024 * 2;
constexpr size_t WS_WO = WS_WL2 + (size_t)2048 * 256 * 2;
constexpr size_t WS_WEND = WS_WO + (size_t)1024 * 1024 * 2;
static_assert(WS_WEND <= UB, "weights fit one unit");
constexpr size_t WS_X1 = 1 * UB;
constexpr size_t WS_QKVPRE = 3 * UB;
constexpr size_t WS_OBUF = 3 * UB;
constexpr size_t WS_XS = 3 * UB;
constexpr size_t WS_LOUT = 3 * UB;
constexpr size_t WS_X2 = 3 * UB;
constexpr size_t WS_YBUF = 3 * UB;
constexpr size_t WS_DB = 5 * UB;
constexpr size_t WS_KKB = 7 * UB;
constexpr size_t WS_BBB = 8 * UB;
constexpr size_t WS_Z = 7 * UB;
constexpr size_t WS_YG = 13 * UB;
constexpr size_t WS_QKV = 9 * UB;
constexpr size_t WS_OG = 9 * UB;
constexpr size_t WS_RKVZ = 9 * UB;
constexpr size_t WS_XN0 = 13 * UB;
constexpr size_t WS_BA = 14 * UB;
constexpr size_t WS_GB = WS_BA + (size_t)MP * 32 * 4;
constexpr size_t WS_LH = WS_GB + (size_t)MP * 32 * 4;
constexpr size_t WS_RK = WS_LH + (size_t)MP * 256 * 2;
constexpr size_t WS_END = WS_RK + (size_t)MP * 16 * 4;
constexpr size_t O_YP = 0, O_YS = 16777216, O_PG = 17825792, O_PGC = 19922944, O_PR = 20021248, O_PRS = 20545536, O_SG = 20553728, O_SGC = 54108160, O_SR = 55681024, O_SRS = 64069632;

struct TJob { const float* src; h16* dst; int srcK, srcN, dst_ld, row0, nrows, col0, ncols, tile0; };
struct Args {
    const float* in[29];
    float* out; unsigned char* ws;
    int ph_lo, ph_hi;
};
constexpr int NTILES_PREP = 3648;
enum { I_XP = 0, I_XS, I_SG, I_SGC, I_SR, I_SRS, I_META, I_NW, I_FNW, I_WIN, I_CW, I_ALOG, I_DTB, I_GNW, I_WOUT, I_MU, I_WRKVZ, I_W0, I_W1, I_W2, I_A0, I_A1, I_A2, I_KK, I_KA, I_RK, I_LNW, I_LNB, I_WO };

__device__ __forceinline__ float wave_sum(float v) {
#pragma unroll
    for (int o = 32; o > 0; o >>= 1) v += __shfl_xor(v, o);
    return v;
}
__device__ __forceinline__ float sigmoidf_(float x) { return 1.0f / (1.0f + expf(-x)); }
__device__ __forceinline__ float siluf_(float x) { return x / (1.0f + expf(-x)); }
__device__ __forceinline__ float softplusf_(float x) { return x > 20.0f ? x : log1pf(expf(x)); }
__device__ __forceinline__ void row_bt(int r, int& b, int& t, bool& samp) {
    if (r < NPR) { b = r / TP; t = r - b * TP; samp = false; } else { const int q = r - NPR; b = q >> 3; t = q & 7; samp = true; }
}
__device__ __forceinline__ const float* xrow(const Args& a, int r) {
    if (r < NPR) { const int b = r / TP, t = r - b * TP; return t < 16 ? a.in[I_META] + (size_t)t * DM : a.in[I_XP] + ((size_t)b * 2048 + (t - 16)) * DM; }
    return a.in[I_XS] + (size_t)(r - NPR) * DM;
}
__device__ __forceinline__ h16x8 pack8(const f32x4 v0, const f32x4 v1) {
    h16x8 w; w[0] = (h16)v0[0]; w[1] = (h16)v0[1]; w[2] = (h16)v0[2]; w[3] = (h16)v0[3]; w[4] = (h16)v1[0]; w[5] = (h16)v1[1]; w[6] = (h16)v1[2]; w[7] = (h16)v1[3]; return w;
}

__device__ __forceinline__ void phase_prep(const Args& a, float* ldsf) {
    const int tid = threadIdx.x, lane = tid & 63, wid = tid >> 6;
    for (int tile = blockIdx.x; tile < NTILES_PREP; tile += gridDim.x) {
        TJob jb;
        { h16* Win = (h16*)(a.ws + WS_WIN); h16* Wout = (h16*)(a.ws + WS_WOUT); h16* Wr = (h16*)(a.ws + WS_WR); h16* Wl2 = (h16*)(a.ws + WS_WL2); h16* Wo = (h16*)(a.ws + WS_WO);
          if (tile < 1600)      jb = TJob{a.in[I_WIN], Win, 1024, 6176, 1024, 0, 6400, 0, 1024, 0};
          else if (tile < 2112) jb = TJob{a.in[I_WOUT], Wout, 2048, 1024, 2048, 0, 1024, 0, 2048, 1600};
          else if (tile < 3136) { const int s = (tile - 2112) >> 8; jb = TJob{a.in[I_WRKVZ] + (size_t)s * 1024 * 1024, Wr, 1024, 1024, 1024, s * 1024, 1024, 0, 1024, 2112 + s * 256}; }
          else if (tile < 3200) jb = TJob{a.in[I_W1], Wr, 1024, 64, 1024, 4096, 256, 0, 1024, 3136};
          else if (tile < 3264) jb = TJob{a.in[I_A1], Wr, 1024, 64, 1024, 4352, 256, 0, 1024, 3200};
          else if (tile < 3328) jb = TJob{a.in[I_W2], Wl2, 64, 1024, 256, 0, 1024, 0, 256, 3264};
          else if (tile < 3392) jb = TJob{a.in[I_A2], Wl2, 64, 1024, 256, 1024, 1024, 64, 256, 3328};
          else                  jb = TJob{a.in[I_WO], Wo, 1024, 1024, 1024, 0, 1024, 0, 1024, 3392}; }
        const int lt = tile - jb.tile0, nck = jb.ncols >> 6, tn = lt / nck, tk = lt - tn * nck;
        __syncthreads();
#pragma unroll
        for (int e = 0; e < 8; ++e) {
            const int idx = e * 512 + tid, kk = idx >> 6, nn = idx & 63;
            const int ks = tk * 64 + kk - jb.col0, ns = tn * 64 + nn;
            float v = 0.f;
            if (ks >= 0 && ks < jb.srcK && ns < jb.srcN) v = jb.src[(size_t)ks * jb.srcN + ns];
            ldsf[kk * 65 + nn] = v;
        }
        __syncthreads();
#pragma unroll
        for (int e = 0; e < 8; ++e) {
            const int idx = e * 512 + tid, nn = idx >> 6, kk = idx & 63;
            jb.dst[(size_t)(jb.row0 + tn * 64 + nn) * jb.dst_ld + tk * 64 + kk] = (h16)ldsf[kk * 65 + nn];
        }
    }
    h16* xn0 = (h16*)(a.ws + WS_XN0);
    const float* nw = a.in[I_NW];
    for (int row = blockIdx.x * 8 + wid; row < MP; row += gridDim.x * 8) {
        h16* op = xn0 + (size_t)row * DM;
        if (row >= NR) {
#pragma unroll
            for (int i = 0; i < 4; ++i) *(h16x4*)(op + i * 256 + lane * 4) = (h16x4){(h16)0.f, (h16)0.f, (h16)0.f, (h16)0.f};
            continue;
        }
        const float* xp = xrow(a, row);
        f32x4 v[4]; float ss = 0.f;
#pragma unroll
        for (int i = 0; i < 4; ++i) { v[i] = *(const f32x4*)(xp + i * 256 + lane * 4); ss += v[i][0] * v[i][0] + v[i][1] * v[i][1] + v[i][2] * v[i][2] + v[i][3] * v[i][3]; }
        ss = wave_sum(ss);
        const float sc = rsqrtf(ss * (1.0f / 1024.0f) + 1e-6f);
#pragma unroll
        for (int i = 0; i < 4; ++i) { const f32x4 w = *(const f32x4*)(nw + i * 256 + lane * 4); h16x4 o;
#pragma unroll
            for (int j = 0; j < 4; ++j) o[j] = (h16)(v[i][j] * sc * w[j]);
            *(h16x4*)(op + i * 256 + lane * 4) = o; }
    }
}

struct EpiProj {
    static constexpr bool PERM = true;
    h16* qkv; h16* z; float* ba;
    __device__ __forceinline__ void operator()(const f32x4 (&acc)[2][2][4][2], const pg8::Unit& u, int wr, int wc, int fr, int fq) const {
        const int row0 = u.pm * 256 + wr * 64 + fr;
        if (u.pn < 24) {
            h16* base = u.pn < 16 ? qkv : z; const int ld = u.pn < 16 ? 4096 : 2048; const int col0 = (u.pn < 16 ? u.pn : u.pn - 16) * 256 + wc * 32 + 8 * fq;
#pragma unroll
            for (int ai = 0; ai < 2; ++ai)
#pragma unroll
                for (int m = 0; m < 4; ++m) { h16* rowp = base + (size_t)(row0 + ai * 128 + m * 16) * ld + col0;
#pragma unroll
                    for (int bj = 0; bj < 2; ++bj) *(h16x8*)(rowp + bj * 128) = pack8(acc[ai][bj][m][0], acc[ai][bj][m][1]); }
        } else if (wc == 0) {
#pragma unroll
            for (int ai = 0; ai < 2; ++ai)
#pragma unroll
                for (int m = 0; m < 4; ++m) { float* rowp = ba + (size_t)(row0 + ai * 128 + m * 16) * 32 + 8 * fq;
                    *(f32x4*)rowp = acc[ai][0][m][0]; *(f32x4*)(rowp + 4) = acc[ai][0][m][1]; }
        }
    }
};
struct EpiH16 {
    static constexpr bool PERM = true;
    h16* O; int ld;
    __device__ __forceinline__ void operator()(const f32x4 (&acc)[2][2][4][2], const pg8::Unit& u, int wr, int wc, int fr, int fq) const {
        const int row0 = u.pm * 256 + wr * 64 + fr, col0 = u.pn * 256 + wc * 32 + 8 * fq;
#pragma unroll
        for (int ai = 0; ai < 2; ++ai)
#pragma unroll
            for (int m = 0; m < 4; ++m) { h16* rowp = O + (size_t)(row0 + ai * 128 + m * 16) * ld + col0;
#pragma unroll
                for (int bj = 0; bj < 2; ++bj) *(h16x8*)(rowp + bj * 128) = pack8(acc[ai][bj][m][0], acc[ai][bj][m][1]); }
    }
};
struct EpiResX {
    static constexpr bool PERM = false;
    const float* meta; const float* xpr; const float* xsm; float* O;
    __device__ __forceinline__ void operator()(const f32x4 (&acc)[2][2][4][2], const pg8::Unit& u, int wr, int wc, int fr, int fq) const {
        const int row0 = u.pm * 256 + wr * 64 + fr, col0 = u.pn * 256 + wc * 32 + 4 * fq;
#pragma unroll
        for (int ai = 0; ai < 2; ++ai)
#pragma unroll
            for (int m = 0; m < 4; ++m) { const int row = row0 + ai * 128 + m * 16; if (row >= NR) continue;
                const float* xp;
                if (row < NPR) { const int b = row / TP, t = row - b * TP; xp = t < 16 ? meta + (size_t)t * DM : xpr + ((size_t)b * 2048 + (t - 16)) * DM; } else xp = xsm + (size_t)(row - NPR) * DM;
                xp += col0; float* rowp = O + (size_t)row * DM + col0;
#pragma unroll
                for (int bj = 0; bj < 2; ++bj)
#pragma unroll
                    for (int n = 0; n < 2; ++n) *(f32x4*)(rowp + bj * 128 + n * 16) = *(const f32x4*)(xp + bj * 128 + n * 16) + acc[ai][bj][m][n]; }
    }
};
struct EpiResB {
    static constexpr bool PERM = false;
    const float* base; float* O;
    __device__ __forceinline__ void operator()(const f32x4 (&acc)[2][2][4][2], const pg8::Unit& u, int wr, int wc, int fr, int fq) const {
        const int row0 = u.pm * 256 + wr * 64 + fr, col0 = u.pn * 256 + wc * 32 + 4 * fq;
#pragma unroll
        for (int ai = 0; ai < 2; ++ai)
#pragma unroll
            for (int m = 0; m < 4; ++m) { const int row = row0 + ai * 128 + m * 16; if (row >= NR) continue;
                const float* xp = base + (size_t)row * DM + col0; float* rowp = O + (size_t)row * DM + col0;
#pragma unroll
                for (int bj = 0; bj < 2; ++bj)
#pragma unroll
                    for (int n = 0; n < 2; ++n) *(f32x4*)(rowp + bj * 128 + n * 16) = *(const f32x4*)(xp + bj * 128 + n * 16) + acc[ai][bj][m][n]; }
    }
};
struct EpiG {
    static constexpr bool PERM = true;
    h16* rkvz; h16* lh;
    __device__ __forceinline__ void operator()(const f32x4 (&acc)[2][2][4][2], const pg8::Unit& u, int wr, int wc, int fr, int fq) const {
        const int s = u.pm / MT, i = u.pm - s * MT, row0 = i * 256 + wr * 64 + fr;
        if (s < 4) {
            h16* base = rkvz + (size_t)s * MP * 1024; const int col0 = (u.pn - 4 * s) * 256 + wc * 32 + 8 * fq;
#pragma unroll
            for (int ai = 0; ai < 2; ++ai)
#pragma unroll
                for (int m = 0; m < 4; ++m) { h16* rowp = base + (size_t)(row0 + ai * 128 + m * 16) * 1024 + col0;
#pragma unroll
                    for (int bj = 0; bj < 2; ++bj) *(h16x8*)(rowp + bj * 128) = pack8(acc[ai][bj][m][0], acc[ai][bj][m][1]); }
        } else if (wc < 2) {
            const int cb = (s == 4 ? 0 : 64) + wc * 32 + 8 * fq;
#pragma unroll
            for (int ai = 0; ai < 2; ++ai)
#pragma unroll
                for (int m = 0; m < 4; ++m) { h16* rowp = lh + (size_t)(row0 + ai * 128 + m * 16) * 256;
                    f32x4 v0 = acc[ai][0][m][0], v1 = acc[ai][0][m][1];
                    if (s == 4) {
#pragma unroll
                        for (int j = 0; j < 4; ++j) { v0[j] = tanhf(v0[j]); v1[j] = tanhf(v1[j]); } }
                    *(h16x8*)(rowp + cb) = pack8(v0, v1);
                    *(h16x8*)(rowp + 128 + cb) = pack8((f32x4){0.f, 0.f, 0.f, 0.f}, (f32x4){0.f, 0.f, 0.f, 0.f}); }
        }
    }
};
struct OrderG {
    pg8::StaticOrder so; int G, c;
    __device__ void init(int G_, int c_) { so.init(4 * MT * 256, 1024, G_, c_); G = G_; c = c_; }
    __device__ bool next(int i, pg8::Unit& u) const {
        long L = (long)i * G + c;
        if (L < 4 * MT * 4) { pg8::Unit v; so.next(i, v); u.pm = v.pm; u.pn = (v.pm / MT) * 4 + v.pn; return true; }
        L -= 4 * MT * 4; if (L >= 2 * MT) return false;
        const int s = 4 + (int)(L / MT), ii = (int)(L % MT); u.pm = s * MT + ii; u.pn = 12 + s; return true;
    }
};

__device__ __forceinline__ void phase_conv(const Args& a) {
    const int lane = threadIdx.x & 63, wid = threadIdx.x >> 6;
    const h16* pre = (const h16*)(a.ws + WS_QKVPRE); h16* qkv = (h16*)(a.ws + WS_QKV);
    const float* ba = (const float*)(a.ws + WS_BA); float* gb = (float*)(a.ws + WS_GB);
    const float* cwp = a.in[I_CW]; const float* cst = a.in[I_SGC];
    for (int row = blockIdx.x * 8 + wid; row < NR; row += gridDim.x * 8) {
        int b, t; bool samp; row_bt(row, b, t, samp);
        for (int seg = 0; seg < 8; ++seg) {
            const int c0 = seg * 512 + lane * 8;
            float y[8], ut[8];
#pragma unroll
            for (int j = 0; j < 8; ++j) { y[j] = 0.f; ut[j] = 0.f; }
            f32x4 w[8];
#pragma unroll
            for (int j = 0; j < 8; ++j) w[j] = *(const f32x4*)(cwp + (size_t)(c0 + j) * 4);
#pragma unroll
            for (int jj = 0; jj < 4; ++jj) {
                const int idx = t + jj;
                float x[8];
                if (idx >= 3) { const h16x8 hv = *(const h16x8*)(pre + (size_t)(row - 3 + jj) * 4096 + c0);
#pragma unroll
                    for (int j = 0; j < 8; ++j) x[j] = (float)hv[j]; }
                else if (samp) { const float* bp = cst + ((size_t)b * 3 + idx) * 4096 + c0; const f32x4 p0 = *(const f32x4*)bp, p1 = *(const f32x4*)(bp + 4);
#pragma unroll
                    for (int j = 0; j < 4; ++j) { x[j] = p0[j]; x[4 + j] = p1[j]; } }
                else {
#pragma unroll
                    for (int j = 0; j < 8; ++j) x[j] = 0.f; }
#pragma unroll
                for (int j = 0; j < 8; ++j) y[j] += x[j] * w[j][jj];
                if (jj == 3) {
#pragma unroll
                    for (int j = 0; j < 8; ++j) ut[j] = x[j]; }
            }
            float ss = 0.f;
#pragma unroll
            for (int j = 0; j < 8; ++j) { y[j] = siluf_(y[j]); ss += y[j] * y[j]; }
            float sc = 1.0f;
            if (seg < 4) {
                ss += __shfl_xor(ss, 1); ss += __shfl_xor(ss, 2); ss += __shfl_xor(ss, 4); ss += __shfl_xor(ss, 8);
                sc = rsqrtf(ss + 1e-6f) * (seg < 2 ? 0.08838834764831845f : 1.0f);
            }
            h16x8 o;
#pragma unroll
            for (int j = 0; j < 8; ++j) o[j] = (h16)(y[j] * sc);
            *(h16x8*)(qkv + (size_t)row * 4096 + c0) = o;
            float* cso = nullptr;
            if (!samp && t >= TP - 3) cso = a.out + O_PGC + ((size_t)b * 3 + (t - (TP - 3))) * 4096 + c0;
            if (samp && t >= 5) cso = a.out + O_SGC + ((size_t)b * 3 + (t - 5)) * 4096 + c0;
            if (cso) { *(f32x4*)cso = (f32x4){ut[0], ut[1], ut[2], ut[3]}; *(f32x4*)(cso + 4) = (f32x4){ut[4], ut[5], ut[6], ut[7]}; }
        }
        if (lane < 16) {
            const float bv = ba[(size_t)row * 32 + lane], av = ba[(size_t)row * 32 + 16 + lane];
            gb[(size_t)row * 32 + lane] = sigmoidf_(bv);
            gb[(size_t)row * 32 + 16 + lane] = -expf(a.in[I_ALOG][lane]) * softplusf_(av + a.in[I_DTB][lane]);
        }
    }
}

#define DPP_ADD(x, ctrl) ((x) + __builtin_bit_cast(float, __builtin_amdgcn_update_dpp(0, __builtin_bit_cast(int, (x)), (ctrl), 0xF, 0xF, true)))
__device__ __forceinline__ float red8(float x) { x = DPP_ADD(x, 0xB1); x = DPP_ADD(x, 0x4E); x = DPP_ADD(x, 0x141); return x; }
__device__ __forceinline__ float red16(float x) { x = DPP_ADD(x, 0xB1); x = DPP_ADD(x, 0x4E); x = DPP_ADD(x, 0x141); x = DPP_ADD(x, 0x140); return x; }
__device__ __forceinline__ void phase_gdn_scan(const Args& a, float* ldsf) {
    const int tid = threadIdx.x;
    const int vl = tid >> 3, kq = tid & 7;
    const h16* qkv = (const h16*)(a.ws + WS_QKV); const float* gb = (const float*)(a.ws + WS_GB); float* obuf = (float*)(a.ws + WS_OBUF);
    const int stt = tid >> 6, sp = tid & 63;
    for (int it = blockIdx.x; it < 256 + 4096; it += gridDim.x) {
        const bool samp = it >= 256; const int q = samp ? it - 256 : it;
        const int seq = q >> 1, vhalf = q & 1, b = seq >> 4, hv = seq & 15, hq = hv >> 1;
        const int T = samp ? 8 : TP, row0 = samp ? NPR + b * 8 : b * TP;
        const int v = vhalf * 64 + vl;
        float S[16];
        if (samp) { const float* spp = a.in[I_SG] + ((size_t)(b * 16 + hv) * 128 + kq * 16) * 128 + v;
#pragma unroll
            for (int i = 0; i < 16; ++i) S[i] = spp[(size_t)i * 128]; }
        else {
#pragma unroll
            for (int i = 0; i < 16; ++i) S[i] = 0.f; }
        h16x4 pqk; h16 pv; float pg = 0.f, pb = 0.f;
        { const h16* rp = qkv + (size_t)(row0 + stt) * 4096;
          pqk = *(const h16x4*)(rp + (sp < 32 ? hq * 128 + sp * 4 : 1024 + hq * 128 + (sp - 32) * 4)); pv = rp[2048 + hv * 128 + vhalf * 64 + sp];
          if (tid < 8) { pb = gb[(size_t)(row0 + tid) * 32 + hv]; pg = gb[(size_t)(row0 + tid) * 32 + 16 + hv]; } }
        __syncthreads();
        int cur = 0;
        for (int t0 = 0; t0 < T; t0 += 8) {
            float* Lb = ldsf + cur * 2576;
            *(f32x4*)(Lb + (sp < 32 ? 0 : 1024) + stt * 128 + (sp & 31) * 4) = (f32x4){(float)pqk[0], (float)pqk[1], (float)pqk[2], (float)pqk[3]};
            Lb[2048 + stt * 64 + sp] = (float)pv;
            if (tid < 8) { Lb[2560 + tid] = expf(pg); Lb[2568 + tid] = pb; }
            __syncthreads();
            if (t0 + 8 < T) { const h16* rp = qkv + (size_t)(row0 + t0 + 8 + stt) * 4096;
                pqk = *(const h16x4*)(rp + (sp < 32 ? hq * 128 + sp * 4 : 1024 + hq * 128 + (sp - 32) * 4)); pv = rp[2048 + hv * 128 + vhalf * 64 + sp];
                if (tid < 8) { pb = gb[(size_t)(row0 + t0 + 8 + tid) * 32 + hv]; pg = gb[(size_t)(row0 + t0 + 8 + tid) * 32 + 16 + hv]; } }
#pragma unroll 2
            for (int tt = 0; tt < 8; ++tt) {
                const float al = Lb[2560 + tt], be = Lb[2568 + tt], vv = Lb[2048 + tt * 64 + vl];
                const f32x4* kp = (const f32x4*)(Lb + 1024 + tt * 128 + kq * 16); const f32x4* qp = (const f32x4*)(Lb + tt * 128 + kq * 16);
                float kr[16];
                float dot = 0.f;
#pragma unroll
                for (int i = 0; i < 4; ++i) { const f32x4 kv = kp[i]; kr[4 * i] = kv[0]; kr[4 * i + 1] = kv[1]; kr[4 * i + 2] = kv[2]; kr[4 * i + 3] = kv[3]; }
#pragma unroll
                for (int i = 0; i < 16; ++i) dot += kr[i] * S[i];
                dot = red8(dot);
                const float c = be * (vv - al * dot);
                float od = 0.f;
#pragma unroll
                for (int i = 0; i < 4; ++i) { const f32x4 qv = qp[i];
#pragma unroll
                    for (int j = 0; j < 4; ++j) { const float s = al * S[4 * i + j] + kr[4 * i + j] * c; S[4 * i + j] = s; od += qv[j] * s; } }
                od = red8(od);
                if (kq == 0) obuf[(size_t)(row0 + t0 + tt) * 2048 + hv * 128 + v] = od;
            }
            cur ^= 1;
        }
        float* so = a.out + (samp ? O_SG : O_PG) + ((size_t)(b * 16 + hv) * 128 + kq * 16) * 128 + v;
#pragma unroll
        for (int i = 0; i < 16; ++i) so[(size_t)i * 128] = S[i];
    }
}

__device__ __forceinline__ void phase_gdn_gate(const Args& a) {
    const int lane = threadIdx.x & 63, wid = threadIdx.x >> 6;
    const float* obuf = (const float*)(a.ws + WS_OBUF); const h16* z = (const h16*)(a.ws + WS_Z); h16* og = (h16*)(a.ws + WS_OG);
    const f32x2 gw = *(const f32x2*)(a.in[I_GNW] + lane * 2);
    for (int row = blockIdx.x * 8 + wid; row < NR; row += gridDim.x * 8) {
        for (int h = 0; h < 16; ++h) {
            const f32x2 o = *(const f32x2*)(obuf + (size_t)row * 2048 + h * 128 + lane * 2);
            const h16x2 zz = *(const h16x2*)(z + (size_t)row * 2048 + h * 128 + lane * 2);
            const float ss = wave_sum(o[0] * o[0] + o[1] * o[1]);
            const float sc = rsqrtf(ss * (1.0f / 128.0f) + 1e-6f);
            h16x2 r; r[0] = (h16)(o[0] * sc * gw[0] * siluf_((float)zz[0])); r[1] = (h16)(o[1] * sc * gw[1] * siluf_((float)zz[1]));
            *(h16x2*)(og + (size_t)row * 2048 + h * 128 + lane * 2) = r;
        }
    }
}

__device__ __forceinline__ void phase_shift(const Args& a) {
    const int lane = threadIdx.x & 63, wid = threadIdx.x >> 6;
    const float* x1 = (const float*)(a.ws + WS_X1); h16* xs = (h16*)(a.ws + WS_XS);
    const float* nw = a.in[I_NW] + DM; const float* mu = a.in[I_MU];
    for (int row = blockIdx.x * 8 + wid; row < NR; row += gridDim.x * 8) {
        int b, t; bool samp; row_bt(row, b, t, samp);
        f32x4 xn[4], xp[4];
        { const float* p = x1 + (size_t)row * DM; float ss = 0.f;
#pragma unroll
          for (int i = 0; i < 4; ++i) { xn[i] = *(const f32x4*)(p + i * 256 + lane * 4); ss += xn[i][0] * xn[i][0] + xn[i][1] * xn[i][1] + xn[i][2] * xn[i][2] + xn[i][3] * xn[i][3]; }
          ss = wave_sum(ss); const float sc = rsqrtf(ss * (1.0f / 1024.0f) + 1e-6f);
#pragma unroll
          for (int i = 0; i < 4; ++i) xn[i] = xn[i] * sc * *(const f32x4*)(nw + i * 256 + lane * 4); }
        if (t > 0) { const float* p = x1 + (size_t)(row - 1) * DM; float ss = 0.f;
#pragma unroll
          for (int i = 0; i < 4; ++i) { xp[i] = *(const f32x4*)(p + i * 256 + lane * 4); ss += xp[i][0] * xp[i][0] + xp[i][1] * xp[i][1] + xp[i][2] * xp[i][2] + xp[i][3] * xp[i][3]; }
          ss = wave_sum(ss); const float sc = rsqrtf(ss * (1.0f / 1024.0f) + 1e-6f);
#pragma unroll
          for (int i = 0; i < 4; ++i) xp[i] = xp[i] * sc * *(const f32x4*)(nw + i * 256 + lane * 4); }
        else if (samp) {
#pragma unroll
          for (int i = 0; i < 4; ++i) xp[i] = *(const f32x4*)(a.in[I_SRS] + (size_t)b * DM + i * 256 + lane * 4); }
        else {
#pragma unroll
          for (int i = 0; i < 4; ++i) xp[i] = (f32x4){0.f, 0.f, 0.f, 0.f}; }
        for (int s = 0; s < 6; ++s) {
#pragma unroll
            for (int i = 0; i < 4; ++i) { const f32x4 m = *(const f32x4*)(mu + (size_t)s * DM + i * 256 + lane * 4); const f32x4 r = xn[i] + (xp[i] - xn[i]) * m;
                h16x4 o; o[0] = (h16)r[0]; o[1] = (h16)r[1]; o[2] = (h16)r[2]; o[3] = (h16)r[3];
                *(h16x4*)(xs + ((size_t)s * MP + row) * DM + i * 256 + lane * 4) = o; }
        }
        float* so = nullptr;
        if (!samp && t == TP - 1) so = a.out + O_PRS + (size_t)b * DM;
        if (samp && t == 7) so = a.out + O_SRS + (size_t)b * DM;
        if (so) {
#pragma unroll
            for (int i = 0; i < 4; ++i) *(f32x4*)(so + i * 256 + lane * 4) = xn[i]; }
    }
}

__device__ __forceinline__ void phase_rwkv_prep(const Args& a) {
    const int lane = threadIdx.x & 63, wid = threadIdx.x >> 6;
    h16* rkvz = (h16*)(a.ws + WS_RKVZ); const h16* lo = (const h16*)(a.ws + WS_LOUT);
    float* dbuf = (float*)(a.ws + WS_DB); h16* kkb = (h16*)(a.ws + WS_KKB); h16* bbb = (h16*)(a.ws + WS_BBB); float* rkb = (float*)(a.ws + WS_RK);
    for (int row = blockIdx.x * 8 + wid; row < NR; row += gridDim.x * 8) {
#pragma unroll 4
        for (int h = 0; h < 16; ++h) {
            const int c = h * 64 + lane;
            const float r = (float)rkvz[(size_t)row * 1024 + c], k = (float)rkvz[((size_t)MP + row) * 1024 + c];
            const float wl = (float)lo[(size_t)row * 2048 + c], al = (float)lo[(size_t)row * 2048 + 1024 + c];
            const float w = -softplusf_(-(a.in[I_W0][c] + wl)) - 0.5f;
            const float d = expf(-expf(w));
            const float aa = sigmoidf_(a.in[I_A0][c] + al);
            const float kkv = k * a.in[I_KK][c];
            const float ss = wave_sum(kkv * kkv);
            const float kk = kkv * rsqrtf(ss + 1e-6f);
            const float k2 = k * (1.0f + (aa - 1.0f) * a.in[I_KA][c]);
            const float rk = wave_sum(r * k2 * a.in[I_RK][c]);
            if (lane == 0) rkb[(size_t)row * 16 + h] = rk;
            rkvz[((size_t)MP + row) * 1024 + c] = (h16)k2;
            dbuf[(size_t)row * 1024 + c] = d; kkb[(size_t)row * 1024 + c] = (h16)kk; bbb[(size_t)row * 1024 + c] = (h16)(kk * aa);
        }
    }
}

__device__ __forceinline__ void phase_rwkv_scan(const Args& a, float* ldsf) {
    const int tid = threadIdx.x, lane = tid & 63, wid = tid >> 6;
    const int rl = lane >> 4, kq = lane & 15;
    const h16* rkvz = (const h16*)(a.ws + WS_RKVZ); const float* dbuf = (const float*)(a.ws + WS_DB);
    const h16* kkb = (const h16*)(a.ws + WS_KKB); const h16* bbb = (const h16*)(a.ws + WS_BBB);
    float* ybuf = (float*)(a.ws + WS_YBUF);
    const int stt = tid >> 6, sch = tid & 63;
    for (int it = blockIdx.x; it < 256 + 4096; it += gridDim.x) {
        const bool samp = it >= 256; const int q = samp ? it - 256 : it;
        const int seq = q >> 1, half = q & 1, b = seq >> 4, h = seq & 15;
        const int T = samp ? 8 : TP, row0 = samp ? NPR + b * 8 : b * TP;
        const int v = half * 32 + wid * 4 + rl;
        f32x4 S;
        if (samp) S = *(const f32x4*)(a.in[I_SR] + ((size_t)(b * 16 + h) * 64 + v) * 64 + kq * 4);
        else S = (f32x4){0.f, 0.f, 0.f, 0.f};
        float pr, pk, pd, pkk, pb, pv;
        { const size_t e = (size_t)(row0 + stt) * 1024 + h * 64 + sch;
          pr = (float)rkvz[e]; pk = (float)rkvz[(size_t)MP * 1024 + e]; pv = (float)rkvz[(size_t)2 * MP * 1024 + e]; pd = dbuf[e]; pkk = (float)kkb[e]; pb = (float)bbb[e]; }
        __syncthreads();
        int cur = 0;
        for (int t0 = 0; t0 < T; t0 += 8) {
            float* Lb = ldsf + cur * 3072;
            Lb[stt * 64 + sch] = pr; Lb[512 + stt * 64 + sch] = pk; Lb[1024 + stt * 64 + sch] = pd; Lb[1536 + stt * 64 + sch] = pkk; Lb[2048 + stt * 64 + sch] = pb; Lb[2560 + stt * 64 + sch] = pv;
            __syncthreads();
            if (t0 + 8 < T) { const size_t e = (size_t)(row0 + t0 + 8 + stt) * 1024 + h * 64 + sch;
                pr = (float)rkvz[e]; pk = (float)rkvz[(size_t)MP * 1024 + e]; pv = (float)rkvz[(size_t)2 * MP * 1024 + e]; pd = dbuf[e]; pkk = (float)kkb[e]; pb = (float)bbb[e]; }
#pragma unroll
            for (int tt = 0; tt < 8; ++tt) {
                const f32x4 kk4 = *(const f32x4*)(Lb + 1536 + tt * 64 + kq * 4), d4 = *(const f32x4*)(Lb + 1024 + tt * 64 + kq * 4), b4 = *(const f32x4*)(Lb + 2048 + tt * 64 + kq * 4);
                const f32x4 k4 = *(const f32x4*)(Lb + 512 + tt * 64 + kq * 4), r4 = *(const f32x4*)(Lb + tt * 64 + kq * 4);
                const float vv = Lb[2560 + tt * 64 + v];
                float sa = S[0] * kk4[0] + S[1] * kk4[1] + S[2] * kk4[2] + S[3] * kk4[3];
                sa = red16(sa);
                const float nsa = -sa;
                S = S * d4 + nsa * b4 + vv * k4;
                float y = S[0] * r4[0] + S[1] * r4[1] + S[2] * r4[2] + S[3] * r4[3];
                y = red16(y);
                if (kq == 0) ybuf[(size_t)(row0 + t0 + tt) * 1024 + h * 64 + v] = y;
            }
            cur ^= 1;
        }
        *(f32x4*)(a.out + (samp ? O_SR : O_PR) + ((size_t)(b * 16 + h) * 64 + v) * 64 + kq * 4) = S;
    }
}

__device__ __forceinline__ void phase_rwkv_gate(const Args& a) {
    const int lane = threadIdx.x & 63, wid = threadIdx.x >> 6;
    const float* ybuf = (const float*)(a.ws + WS_YBUF); const float* rkb = (const float*)(a.ws + WS_RK);
    const h16* rkvz = (const h16*)(a.ws + WS_RKVZ); h16* yg = (h16*)(a.ws + WS_YG);
    for (int row = blockIdx.x * 8 + wid; row < NR; row += gridDim.x * 8) {
        for (int h = 0; h < 16; ++h) {
            const int c = h * 64 + lane;
            const float y = ybuf[(size_t)row * 1024 + c];
            const float mean = wave_sum(y) * (1.0f / 64.0f);
            const float dy = y - mean;
            const float var = wave_sum(dy * dy) * (1.0f / 64.0f);
            float yn = dy * rsqrtf(var + 64e-5f) * a.in[I_LNW][c] + a.in[I_LNB][c];
            const float vv = (float)rkvz[((size_t)2 * MP + row) * 1024 + c], zz = (float)rkvz[((size_t)3 * MP + row) * 1024 + c];
            yn += rkb[(size_t)row * 16 + h] * vv;
            yg[(size_t)row * 1024 + c] = (h16)(yn * siluf_(zz));
        }
    }
}

__device__ __forceinline__ void phase_final(const Args& a) {
    const int lane = threadIdx.x & 63, wid = threadIdx.x >> 6;
    const float* x2 = (const float*)(a.ws + WS_X2); const float* nw = a.in[I_FNW];
    for (int row = blockIdx.x * 8 + wid; row < NR; row += gridDim.x * 8) {
        int b, t; bool samp; row_bt(row, b, t, samp);
        if (!samp && t < 16) continue;
        float* op = samp ? a.out + O_YS + (size_t)(row - NPR) * DM : a.out + O_YP + ((size_t)b * 2048 + (t - 16)) * DM;
        const float* p = x2 + (size_t)row * DM; f32x4 v[4]; float ss = 0.f;
#pragma unroll
        for (int i = 0; i < 4; ++i) { v[i] = *(const f32x4*)(p + i * 256 + lane * 4); ss += v[i][0] * v[i][0] + v[i][1] * v[i][1] + v[i][2] * v[i][2] + v[i][3] * v[i][3]; }
        ss = wave_sum(ss); const float sc = rsqrtf(ss * (1.0f / 1024.0f) + 1e-6f);
#pragma unroll
        for (int i = 0; i < 4; ++i) *(f32x4*)(op + i * 256 + lane * 4) = v[i] * sc * *(const f32x4*)(nw + i * 256 + lane * 4);
    }
}

constexpr int NPHASE = 14;
__global__ void __launch_bounds__(NTHREADS, 2) mk_fwd(Args a) {
    extern __shared__ __attribute__((aligned(16))) unsigned char smem[];
    PG8_LAS unsigned char* lds = (PG8_LAS unsigned char*)smem;
    float* ldsf = (float*)smem;
    const int G = gridDim.x, c = blockIdx.x;
#if MK_COOP
    cg::grid_group grid = cg::this_grid();
#define SEAM(p) do { if ((p) + 1 < a.ph_hi) grid.sync(); } while (0)
#else
#define SEAM(p) do { } while (0)
#endif
#define IN(p) (a.ph_lo <= (p) && (p) < a.ph_hi)
    if (IN(0)) { phase_prep(a, ldsf); SEAM(0); }
    if (IN(1)) { __syncthreads();
        pg8::Gemm g{(const h16*)(a.ws + WS_XN0), (const h16*)(a.ws + WS_WIN), MP, 6400, 1024}; pg8::StaticOrder S; S.init(MP, 6400, G, c);
        EpiProj E{(h16*)(a.ws + WS_QKVPRE), (h16*)(a.ws + WS_Z), (float*)(a.ws + WS_BA)};
        pg8::gemm_phase<EpiProj, pg8::StaticOrder>(lds, g, S, E); SEAM(1); }
    if (IN(2)) { phase_conv(a); SEAM(2); }
    if (IN(3)) { __syncthreads(); phase_gdn_scan(a, ldsf); SEAM(3); }
    if (IN(4)) { phase_gdn_gate(a); SEAM(4); }
    if (IN(5)) { __syncthreads();
        pg8::Gemm g{(const h16*)(a.ws + WS_OG), (const h16*)(a.ws + WS_WOUT), MP, 1024, 2048}; pg8::StaticOrder S; S.init(MP, 1024, G, c);
        EpiResX E{a.in[I_META], a.in[I_XP], a.in[I_XS], (float*)(a.ws + WS_X1)};
        pg8::gemm_phase<EpiResX, pg8::StaticOrder>(lds, g, S, E); SEAM(5); }
    if (IN(6)) { phase_shift(a); SEAM(6); }
    if (IN(7)) { __syncthreads();
        pg8::Gemm g{(const h16*)(a.ws + WS_XS), (const h16*)(a.ws + WS_WR), 6 * MP, 4608, 1024}; OrderG S; S.init(G, c);
        EpiG E{(h16*)(a.ws + WS_RKVZ), (h16*)(a.ws + WS_LH)};
        pg8::gemm_phase<EpiG, OrderG>(lds, g, S, E); SEAM(7); }
    if (IN(8)) { __syncthreads();
        pg8::Gemm g{(const h16*)(a.ws + WS_LH), (const h16*)(a.ws + WS_WL2), MP, 2048, 256}; pg8::StaticOrder S; S.init(MP, 2048, G, c);
        EpiH16 E{(h16*)(a.ws + WS_LOUT), 2048};
        pg8::gemm_phase<EpiH16, pg8::StaticOrder>(lds, g, S, E); SEAM(8); }
    if (IN(9)) { phase_rwkv_prep(a); SEAM(9); }
    if (IN(10)) { __syncthreads(); phase_rwkv_scan(a, ldsf); SEAM(10); }
    if (IN(11)) { phase_rwkv_gate(a); SEAM(11); }
    if (IN(12)) { __syncthreads();
        pg8::Gemm g{(const h16*)(a.ws + WS_YG), (const h16*)(a.ws + WS_WO), MP, 1024, 1024}; pg8::StaticOrder S; S.init(MP, 1024, G, c);
        EpiResB E{(const float*)(a.ws + WS_X1), (float*)(a.ws + WS_X2)};
        pg8::gemm_phase<EpiResB, pg8::StaticOrder>(lds, g, S, E); SEAM(12); }
    if (IN(13)) { phase_final(a); }
#undef IN
#undef SEAM
}

extern "C" void kernel_launch(void* const* d_in, const int* in_sizes, int n_in, void* d_out, int out_size, void* d_ws, size_t ws_size, hipStream_t stream) {
    static int grid = 0;
    if (grid == 0) {
        if (n_in != 29 || ws_size < WS_END) { fprintf(stderr, "kernel_launch: unexpected n_in %d or ws_size %zu (< %zu)\n", n_in, ws_size, (size_t)WS_END); grid = -1; return; }
        int dev = 0, cus = 0, per_cu = 0;
        hipGetDevice(&dev); hipDeviceGetAttribute(&cus, hipDeviceAttributeMultiprocessorCount, dev);
        if (hipFuncSetAttribute((const void*)mk_fwd, hipFuncAttributeMaxDynamicSharedMemorySize, LDS_BYTES) != hipSuccess) { fprintf(stderr, "kernel_launch: hipFuncSetAttribute failed\n"); }
        if (hipOccupancyMaxActiveBlocksPerMultiprocessor(&per_cu, (const void*)mk_fwd, NTHREADS, LDS_BYTES) != hipSuccess || per_cu < 1) { fprintf(stderr, "kernel_launch: occupancy query gave %d\n", per_cu); per_cu = 1; }
        (void)hipGetLastError();
        grid = cus * 1;
        if (grid <= 0) grid = 256;
    }
    if (grid < 0) return;
    Args a; memset(&a, 0, sizeof(a));
    for (int i = 0; i < 29; ++i) a.in[i] = (const float*)d_in[i];
    a.out = (float*)d_out; a.ws = (unsigned char*)d_ws;
#if MK_COOP
    a.ph_lo = 0; a.ph_hi = NPHASE;
    void* args[] = {&a};
    hipError_t e = hipLaunchCooperativeKernel((const void*)mk_fwd, dim3(grid), dim3(NTHREADS), args, LDS_BYTES, stream);
    if (e != hipSuccess) fprintf(stderr, "cooperative launch failed: %s (grid %d)\n", hipGetErrorString(e), grid);
#else
    for (int p = 0; p < NPHASE; ++p) { a.ph_lo = p; a.ph_hi = p + 1; hipLaunchKernelGGL(mk_fwd, dim3(grid), dim3(NTHREADS), LDS_BYTES, stream, a); }
#endif
}
```

```cpp
#include <hip/hip_runtime.h>
#include <hip/hip_cooperative_groups.h>
#include <cstdio>
#include <cstring>
namespace cg = cooperative_groups;

#ifndef MK_COOP
#define MK_COOP 1
#endif

typedef _Float16 h16;
typedef _Float16 h16x8 __attribute__((ext_vector_type(8)));
typedef _Float16 h16x4 __attribute__((ext_vector_type(4)));
typedef _Float16 h16x2 __attribute__((ext_vector_type(2)));
typedef float f32x4 __attribute__((ext_vector_type(4)));
typedef float f32x2 __attribute__((ext_vector_type(2)));

namespace pg8 {
#define PG8_LAS __attribute__((address_space(3)))
constexpr int BM = 256, BK = 64, HALF = 128, HTB = HALF * BK * 2, STAGE_BYTES = 8 * HTB, NXCD = 8, WGM = 8;
__host__ __device__ __forceinline__ int lds_byte(int r, int c) { const int st = (r >> 4) * 2 + (c >> 5), rr = r & 15, cc = c & 31, ob = rr * 64 + cc * 2; return st * 1024 + (ob ^ (((ob >> 9) & 1) << 5)); }
__host__ __device__ __forceinline__ void stage_rc(int b, int& R, int& C) { const int st = b / 1024, sb = b % 1024, swz = sb ^ (((sb >> 9) & 1) << 5); R = (st >> 1) * 16 + swz / 64; C = (st & 1) * 32 + (swz % 64) / 2; }
__host__ __device__ __forceinline__ int perm32(int rho) { const int n = rho >> 4, i = rho & 15; return 8 * (i >> 2) + 4 * n + (i & 3); }
struct Unit { int pm, pn; };
struct Gemm { const h16* A; const h16* Bt; int M, N, K; };
struct StaticOrder {
    int nM, nN, nwg, G, c;
    __host__ __device__ void init(int M, int N, int G_, int c_) { nM = M / BM; nN = N / BM; nwg = nM * nN; G = G_; c = c_; }
    __host__ __device__ bool next(int i, Unit& u) const {
        const long L = (long)i * G + c; if (L >= nwg) return false;
        int wgid = (int)L; { const int q = nwg / NXCD, r = nwg % NXCD, xcd = wgid % NXCD, off = wgid / NXCD; wgid = (xcd < r ? xcd * (q + 1) : r * (q + 1) + (xcd - r) * q) + off; }
        const int nig = WGM * nN, gid = wgid / nig, fm = gid * WGM, gsz = (nM - fm) < WGM ? (nM - fm) : WGM;
        u.pm = fm + ((wgid % nig) % gsz); u.pn = (wgid % nig) / gsz; return true;
    }
};

template <class Epi, class Sched>
__device__ __forceinline__ void gemm_phase(PG8_LAS unsigned char* lds, const Gemm g, const Sched& S, const Epi& E) {
    const int tid = threadIdx.x, wid = __builtin_amdgcn_readfirstlane(tid >> 6), lane = tid & 63, wr = wid >> 2, wc = wid & 3, fr = lane & 15, fq = lane >> 4;
    const int K = g.K, nt = K / BK;
    unsigned voffA[2], voffB[2];
#pragma unroll
    for (int i = 0; i < 2; ++i) { int R, C; stage_rc(tid * 16 + i * 8192, R, C); const int Rb = Epi::PERM ? ((R & ~31) + perm32(R & 31)) : R;
        voffA[i] = (unsigned)(R * K + C) * 2u; voffB[i] = (unsigned)(Rb * K + C) * 2u; }
    const size_t kstep = (size_t)(BK * 2);
    const size_t hstep = (size_t)HALF * K * 2;
    const size_t tstep = 2 * hstep;
    const unsigned ldsw = (unsigned)wid * 1024u;
    const int aoff = lds_byte(wr * 64 + fr, fq * 8), boff = lds_byte(wc * 32 + fr, fq * 8);
#define PG8_SA(b, h) (((b) * 2 + (h)) * HTB)
#define PG8_SB(b, h) ((4 + (b) * 2 + (h)) * HTB)
#define PG8_STAGE(bufoff, gbase, voff) do { _Pragma("unroll") for (int _i = 0; _i < 2; ++_i) \
        __builtin_amdgcn_global_load_lds((const unsigned*)((const char*)(gbase) + (voff)[_i]), (PG8_LAS unsigned*)(lds + (bufoff) + ldsw + _i * 8192), 16, 0, 0); } while (0)
#define PG8_LDA(dst, b, h) do { _Pragma("unroll") for (int m = 0; m < 4; ++m) _Pragma("unroll") for (int k = 0; k < 2; ++k) dst[m][k] = *(const PG8_LAS h16x8*)(lds + PG8_SA(b, h) + aoff + m * 2048 + k * 1024); } while (0)
#define PG8_LDB(dst, b, h) do { _Pragma("unroll") for (int n = 0; n < 2; ++n) _Pragma("unroll") for (int k = 0; k < 2; ++k) dst[n][k] = *(const PG8_LAS h16x8*)(lds + PG8_SB(b, h) + boff + n * 2048 + k * 1024); } while (0)
#define PG8_MMA(ai, bj, At, Bt) do { __builtin_amdgcn_s_setprio(1); _Pragma("unroll") for (int m = 0; m < 4; ++m) _Pragma("unroll") for (int n = 0; n < 2; ++n) _Pragma("unroll") for (int k = 0; k < 2; ++k) \
        acc[ai][bj][m][n] = __builtin_amdgcn_mfma_f32_16x16x32_f16(Bt[n][k], At[m][k], acc[ai][bj][m][n], 0, 0, 0); __builtin_amdgcn_s_setprio(0); } while (0)
#define PG8_WAIT_V(n) asm volatile("s_waitcnt vmcnt(" #n ")" ::: "memory")
#define PG8_WAIT_L(n) asm volatile("s_waitcnt lgkmcnt(" #n ")" ::: "memory")
#define PG8_BAR __builtin_amdgcn_s_barrier()
#define PG8_SCHED __builtin_amdgcn_sched_barrier(0)
    Unit cur, nxt; int ui = 0;
    if (!S.next(0, cur)) return;
    f32x4 acc[2][2][4][2];
#pragma unroll
    for (int a = 0; a < 2; ++a)
#pragma unroll
        for (int b = 0; b < 2; ++b)
#pragma unroll
            for (int m = 0; m < 4; ++m)
#pragma unroll
                for (int n = 0; n < 2; ++n) acc[a][b][m][n] = (f32x4){0.f, 0.f, 0.f, 0.f};
    h16x8 At[4][2], B0[2][2], B1[2][2];
    const char* cA = (const char*)g.A + (size_t)cur.pm * tstep; const char* cB = (const char*)g.Bt + (size_t)cur.pn * tstep;
    PG8_STAGE(PG8_SB(0, 0), cB, voffB); PG8_STAGE(PG8_SA(0, 0), cA, voffA); PG8_STAGE(PG8_SB(0, 1), cB + hstep, voffB); PG8_STAGE(PG8_SA(0, 1), cA + hstep, voffA);
    if (wr == 1) PG8_BAR;
    PG8_WAIT_V(4); PG8_BAR;
    PG8_STAGE(PG8_SB(1, 0), cB + kstep, voffB); PG8_STAGE(PG8_SA(1, 0), cA + kstep, voffA); PG8_STAGE(PG8_SB(1, 1), cB + hstep + kstep, voffB);
    PG8_WAIT_V(6); PG8_BAR;
    for (;;) {
        const bool has_next = S.next(ui + 1, nxt);
        const char* nA = has_next ? (const char*)g.A + (size_t)nxt.pm * tstep : cA; const char* nB = has_next ? (const char*)g.Bt + (size_t)nxt.pn * tstep : cB;
        for (int t = 0; t < nt; t += 2) {
            const bool last = (t == nt - 2);
            const char* a1 = cA + (size_t)(t + 1) * kstep;
            const char* a2 = last ? nA : cA + (size_t)(t + 2) * kstep; const char* b2 = last ? nB : cB + (size_t)(t + 2) * kstep;
            const char* a3 = a2 + kstep; const char* b3 = b2 + kstep;
            PG8_LDB(B0, 0, 0); PG8_SCHED; PG8_LDA(At, 0, 0); PG8_STAGE(PG8_SA(1, 1), a1 + hstep, voffA);
            PG8_WAIT_L(8); PG8_BAR; PG8_WAIT_L(0); PG8_MMA(0, 0, At, B0); PG8_BAR; PG8_SCHED;
            PG8_LDB(B1, 0, 1); PG8_STAGE(PG8_SB(0, 0), b2, voffB);
            PG8_BAR; PG8_WAIT_L(0); PG8_MMA(0, 1, At, B1); PG8_BAR;
            PG8_LDA(At, 0, 1); PG8_STAGE(PG8_SA(0, 0), a2, voffA);
            PG8_BAR; PG8_WAIT_L(0); PG8_MMA(1, 0, At, B0); PG8_BAR; PG8_SCHED;
            PG8_STAGE(PG8_SB(0, 1), b2 + hstep, voffB);
            PG8_WAIT_V(6); PG8_BAR; PG8_MMA(1, 1, At, B1); PG8_BAR;
            PG8_LDB(B0, 1, 0); PG8_SCHED; PG8_LDA(At, 1, 0); PG8_STAGE(PG8_SA(0, 1), a2 + hstep, voffA);
            PG8_WAIT_L(8); PG8_BAR; PG8_WAIT_L(0); PG8_MMA(0, 0, At, B0); PG8_BAR; PG8_SCHED;
            PG8_LDB(B1, 1, 1); PG8_STAGE(PG8_SB(1, 0), b3, voffB);
            PG8_BAR; PG8_WAIT_L(0); PG8_MMA(0, 1, At, B1); PG8_BAR;
            PG8_LDA(At, 1, 1); PG8_STAGE(PG8_SA(1, 0), a3, voffA);
            PG8_BAR; PG8_WAIT_L(0); PG8_MMA(1, 0, At, B0); PG8_BAR; PG8_SCHED;
            PG8_STAGE(PG8_SB(1, 1), b3 + hstep, voffB);
            PG8_WAIT_V(6); PG8_BAR; PG8_MMA(1, 1, At, B1); PG8_BAR;
        }
        E(acc, cur, wr, wc, fr, fq);
        if (!has_next) break;
#pragma unroll
        for (int a = 0; a < 2; ++a)
#pragma unroll
            for (int b = 0; b < 2; ++b)
#pragma unroll
                for (int m = 0; m < 4; ++m)
#pragma unroll
                    for (int n = 0; n < 2; ++n) acc[a][b][m][n] = (f32x4){0.f, 0.f, 0.f, 0.f};
        cur = nxt; cA = nA; cB = nB; ++ui;
    }
    PG8_WAIT_V(0);
    if (wr == 0) PG8_BAR;
    PG8_BAR;
#undef PG8_SA
#undef PG8_SB
#undef PG8_STAGE
#undef PG8_LDA
#undef PG8_LDB
#undef PG8_MMA
#undef PG8_WAIT_V
#undef PG8_WAIT_L
#undef PG8_BAR
#undef PG8_SCHED
}
}

constexpr int DM = 1024, TP = 2064, NPR = 8 * TP  , NR = NPR + 1024  , MP = 17664  , MT = 69;
constexpr int NTHREADS = 512, LDS_BYTES = pg8::STAGE_BYTES;
constexpr size_t UB = (size_t)MP * 1024 * 2;
constexpr size_t WS_WIN = 0;
constexpr size_t WS_WOUT = WS_WIN + (size_t)6400 * 1024 * 2;
constexpr size_t WS_WR = WS_WOUT + (size_t)1024 * 2048 * 2;
constexpr size_t WS_WL2 = WS_WR + (size_t)4608 * 1024 * 2;
constexpr size_t WS_WO = WS_WL2 + (size_t)2048 * 256 * 2;
constexpr size_t WS_WEND = WS_WO + (size_t)1024 * 1024 * 2;
static_assert(WS_WEND <= UB, "weights fit one unit");
constexpr size_t WS_X1 = 1 * UB;
constexpr size_t WS_QKVPRE = 3 * UB;
constexpr size_t WS_OBUF = 3 * UB;
constexpr size_t WS_XS = 3 * UB;
constexpr size_t WS_LOUT = 3 * UB;
constexpr size_t WS_X2 = 3 * UB;
constexpr size_t WS_YBUF = 3 * UB;
constexpr size_t WS_DB = 5 * UB;
constexpr size_t WS_KKB = 7 * UB;
constexpr size_t WS_BBB = 8 * UB;
constexpr size_t WS_Z = 7 * UB;
constexpr size_t WS_YG = 13 * UB;
constexpr size_t WS_QKV = 9 * UB;
constexpr size_t WS_OG = 9 * UB;
constexpr size_t WS_RKVZ = 9 * UB;
constexpr size_t WS_XN0 = 13 * UB;
constexpr size_t WS_BA = 14 * UB;
constexpr size_t WS_GB = WS_BA + (size_t)MP * 32 * 4;
constexpr size_t WS_LH = WS_GB + (size_t)MP * 32 * 4;
constexpr size_t WS_RK = WS_LH + (size_t)MP * 256 * 2;
constexpr size_t WS_END = WS_RK + (size_t)MP * 16 * 4;
constexpr size_t O_YP = 0, O_YS = 16777216, O_PG = 17825792, O_PGC = 19922944, O_PR = 20021248, O_PRS = 20545536, O_SG = 20553728, O_SGC = 54108160, O_SR = 55681024, O_SRS = 64069632;

struct TJob { const float* src; h16* dst; int srcK, srcN, dst_ld, row0, nrows, col0, ncols, tile0; };
struct Args {
    const float* in[29];
    float* out; unsigned char* ws;
    int ph_lo, ph_hi;
};
constexpr int NTILES_PREP = 3648;
enum { I_XP = 0, I_XS, I_SG, I_SGC, I_SR, I_SRS, I_META, I_NW, I_FNW, I_WIN, I_CW, I_ALOG, I_DTB, I_GNW, I_WOUT, I_MU, I_WRKVZ, I_W0, I_W1, I_W2, I_A0, I_A1, I_A2, I_KK, I_KA, I_RK, I_LNW, I_LNB, I_WO };

__device__ __forceinline__ float wave_sum(float v) {
#pragma unroll
    for (int o = 32; o > 0; o >>= 1) v += __shfl_xor(v, o);
    return v;
}
#define DPP_ADD(x, ctrl) ((x) + __builtin_bit_cast(float, __builtin_amdgcn_update_dpp(0, __builtin_bit_cast(int, (x)), (ctrl), 0xF, 0xF, true)))
__device__ __forceinline__ float red8(float x) { x = DPP_ADD(x, 0xB1); x = DPP_ADD(x, 0x4E); x = DPP_ADD(x, 0x141); return x; }
__device__ __forceinline__ float red16(float x) { x = DPP_ADD(x, 0xB1); x = DPP_ADD(x, 0x4E); x = DPP_ADD(x, 0x141); x = DPP_ADD(x, 0x140); return x; }
__device__ __forceinline__ float wsum(float x) { x = red16(x); x += __shfl_xor(x, 16); x += __shfl_xor(x, 32); return x; }
__device__ __forceinline__ float sq4(const f32x4 v) { return v[0] * v[0] + v[1] * v[1] + v[2] * v[2] + v[3] * v[3]; }
__device__ __forceinline__ float sigmoidf_(float x) { return 1.0f / (1.0f + expf(-x)); }
__device__ __forceinline__ float siluf_(float x) { return x / (1.0f + expf(-x)); }
__device__ __forceinline__ float softplusf_(float x) { return x > 20.0f ? x : log1pf(expf(x)); }
__device__ __forceinline__ void row_bt(int r, int& b, int& t, bool& samp) {
    if (r < NPR) { b = r / TP; t = r - b * TP; samp = false; } else { const int q = r - NPR; b = q >> 3; t = q & 7; samp = true; }
}
__device__ __forceinline__ const float* xrow(const Args& a, int r) {
    if (r < NPR) { const int b = r / TP, t = r - b * TP; return t < 16 ? a.in[I_META] + (size_t)t * DM : a.in[I_XP] + ((size_t)b * 2048 + (t - 16)) * DM; }
    return a.in[I_XS] + (size_t)(r - NPR) * DM;
}
__device__ __forceinline__ h16x8 pack8(const f32x4 v0, const f32x4 v1) {
    h16x8 w; w[0] = (h16)v0[0]; w[1] = (h16)v0[1]; w[2] = (h16)v0[2]; w[3] = (h16)v0[3]; w[4] = (h16)v1[0]; w[5] = (h16)v1[1]; w[6] = (h16)v1[2]; w[7] = (h16)v1[3]; return w;
}

__device__ __forceinline__ void phase_prep(const Args& a, float* ldsf) {
    const int tid = threadIdx.x, lane = tid & 63, wid = tid >> 6;
    for (int tile = blockIdx.x; tile < NTILES_PREP; tile += gridDim.x) {
        TJob jb;
        { h16* Win = (h16*)(a.ws + WS_WIN); h16* Wout = (h16*)(a.ws + WS_WOUT); h16* Wr = (h16*)(a.ws + WS_WR); h16* Wl2 = (h16*)(a.ws + WS_WL2); h16* Wo = (h16*)(a.ws + WS_WO);
          if (tile < 1600)      jb = TJob{a.in[I_WIN], Win, 1024, 6176, 1024, 0, 6400, 0, 1024, 0};
          else if (tile < 2112) jb = TJob{a.in[I_WOUT], Wout, 2048, 1024, 2048, 0, 1024, 0, 2048, 1600};
          else if (tile < 3136) { const int s = (tile - 2112) >> 8; jb = TJob{a.in[I_WRKVZ] + (size_t)s * 1024 * 1024, Wr, 1024, 1024, 1024, s * 1024, 1024, 0, 1024, 2112 + s * 256}; }
          else if (tile < 3200) jb = TJob{a.in[I_W1], Wr, 1024, 64, 1024, 4096, 256, 0, 1024, 3136};
          else if (tile < 3264) jb = TJob{a.in[I_A1], Wr, 1024, 64, 1024, 4352, 256, 0, 1024, 3200};
          else if (tile < 3328) jb = TJob{a.in[I_W2], Wl2, 64, 1024, 256, 0, 1024, 0, 256, 3264};
          else if (tile < 3392) jb = TJob{a.in[I_A2], Wl2, 64, 1024, 256, 1024, 1024, 64, 256, 3328};
          else                  jb = TJob{a.in[I_WO], Wo, 1024, 1024, 1024, 0, 1024, 0, 1024, 3392}; }
        const int lt = tile - jb.tile0, nck = jb.ncols >> 6, tn = lt / nck, tk = lt - tn * nck;
        __syncthreads();
#pragma unroll
        for (int e = 0; e < 8; ++e) {
            const int idx = e * 512 + tid, kk = idx >> 6, nn = idx & 63;
            const int ks = tk * 64 + kk - jb.col0, ns = tn * 64 + nn;
            float v = 0.f;
            if (ks >= 0 && ks < jb.srcK && ns < jb.srcN) v = jb.src[(size_t)ks * jb.srcN + ns];
            ldsf[kk * 65 + nn] = v;
        }
        __syncthreads();
#pragma unroll
        for (int e = 0; e < 8; ++e) {
            const int idx = e * 512 + tid, nn = idx >> 6, kk = idx & 63;
            jb.dst[(size_t)(jb.row0 + tn * 64 + nn) * jb.dst_ld + tk * 64 + kk] = (h16)ldsf[kk * 65 + nn];
        }
    }
    h16* xn0 = (h16*)(a.ws + WS_XN0);
    const float* nw = a.in[I_NW];
    for (int row = blockIdx.x * 8 + wid; row < MP; row += gridDim.x * 8) {
        h16* op = xn0 + (size_t)row * DM;
        if (row >= NR) {
#pragma unroll
            for (int i = 0; i < 4; ++i) *(h16x4*)(op + i * 256 + lane * 4) = (h16x4){(h16)0.f, (h16)0.f, (h16)0.f, (h16)0.f};
            continue;
        }
        const float* xp = xrow(a, row);
        f32x4 v[4]; float ss = 0.f;
#pragma unroll
        for (int i = 0; i < 4; ++i) { v[i] = *(const f32x4*)(xp + i * 256 + lane * 4); ss += v[i][0] * v[i][0] + v[i][1] * v[i][1] + v[i][2] * v[i][2] + v[i][3] * v[i][3]; }
        ss = wave_sum(ss);
        const float sc = rsqrtf(ss * (1.0f / 1024.0f) + 1e-6f);
#pragma unroll
        for (int i = 0; i < 4; ++i) { const f32x4 w = *(const f32x4*)(nw + i * 256 + lane * 4); h16x4 o;
#pragma unroll
            for (int j = 0; j < 4; ++j) o[j] = (h16)(v[i][j] * sc * w[j]);
            *(h16x4*)(op + i * 256 + lane * 4) = o; }
    }
}

struct EpiProj {
    static constexpr bool PERM = true;
    h16* qkv; h16* z; float* ba;
    __device__ __forceinline__ void operator()(const f32x4 (&acc)[2][2][4][2], const pg8::Unit& u, int wr, int wc, int fr, int fq) const {
        const int row0 = u.pm * 256 + wr * 64 + fr;
        if (u.pn < 24) {
            h16* base = u.pn < 16 ? qkv : z; const int ld = u.pn < 16 ? 4096 : 2048; const int col0 = (u.pn < 16 ? u.pn : u.pn - 16) * 256 + wc * 32 + 8 * fq;
#pragma unroll
            for (int ai = 0; ai < 2; ++ai)
#pragma unroll
                for (int m = 0; m < 4; ++m) { h16* rowp = base + (size_t)(row0 + ai * 128 + m * 16) * ld + col0;
#pragma unroll
                    for (int bj = 0; bj < 2; ++bj) *(h16x8*)(rowp + bj * 128) = pack8(acc[ai][bj][m][0], acc[ai][bj][m][1]); }
        } else if (wc == 0) {
#pragma unroll
            for (int ai = 0; ai < 2; ++ai)
#pragma unroll
                for (int m = 0; m < 4; ++m) { float* rowp = ba + (size_t)(row0 + ai * 128 + m * 16) * 32 + 8 * fq;
                    *(f32x4*)rowp = acc[ai][0][m][0]; *(f32x4*)(rowp + 4) = acc[ai][0][m][1]; }
        }
    }
};
struct EpiH16 {
    static constexpr bool PERM = true;
    h16* O; int ld;
    __device__ __forceinline__ void operator()(const f32x4 (&acc)[2][2][4][2], const pg8::Unit& u, int wr, int wc, int fr, int fq) const {
        const int row0 = u.pm * 256 + wr * 64 + fr, col0 = u.pn * 256 + wc * 32 + 8 * fq;
#pragma unroll
        for (int ai = 0; ai < 2; ++ai)
#pragma unroll
            for (int m = 0; m < 4; ++m) { h16* rowp = O + (size_t)(row0 + ai * 128 + m * 16) * ld + col0;
#pragma unroll
                for (int bj = 0; bj < 2; ++bj) *(h16x8*)(rowp + bj * 128) = pack8(acc[ai][bj][m][0], acc[ai][bj][m][1]); }
    }
};
struct EpiResX {
    static constexpr bool PERM = false;
    const float* meta; const float* xpr; const float* xsm; float* O;
    __device__ __forceinline__ void operator()(const f32x4 (&acc)[2][2][4][2], const pg8::Unit& u, int wr, int wc, int fr, int fq) const {
        const int row0 = u.pm * 256 + wr * 64 + fr, col0 = u.pn * 256 + wc * 32 + 4 * fq;
#pragma unroll
        for (int ai = 0; ai < 2; ++ai)
#pragma unroll
            for (int m = 0; m < 4; ++m) { const int row = row0 + ai * 128 + m * 16; if (row >= NR) continue;
                const float* xp;
                if (row < NPR) { const int b = row / TP, t = row - b * TP; xp = t < 16 ? meta + (size_t)t * DM : xpr + ((size_t)b * 2048 + (t - 16)) * DM; } else xp = xsm + (size_t)(row - NPR) * DM;
                xp += col0; float* rowp = O + (size_t)row * DM + col0;
#pragma unroll
                for (int bj = 0; bj < 2; ++bj)
#pragma unroll
                    for (int n = 0; n < 2; ++n) *(f32x4*)(rowp + bj * 128 + n * 16) = *(const f32x4*)(xp + bj * 128 + n * 16) + acc[ai][bj][m][n]; }
    }
};
struct EpiResB {
    static constexpr bool PERM = false;
    const float* base; float* O;
    __device__ __forceinline__ void operator()(const f32x4 (&acc)[2][2][4][2], const pg8::Unit& u, int wr, int wc, int fr, int fq) const {
        const int row0 = u.pm * 256 + wr * 64 + fr, col0 = u.pn * 256 + wc * 32 + 4 * fq;
#pragma unroll
        for (int ai = 0; ai < 2; ++ai)
#pragma unroll
            for (int m = 0; m < 4; ++m) { const int row = row0 + ai * 128 + m * 16; if (row >= NR) continue;
                const float* xp = base + (size_t)row * DM + col0; float* rowp = O + (size_t)row * DM + col0;
#pragma unroll
                for (int bj = 0; bj < 2; ++bj)
#pragma unroll
                    for (int n = 0; n < 2; ++n) *(f32x4*)(rowp + bj * 128 + n * 16) = *(const f32x4*)(xp + bj * 128 + n * 16) + acc[ai][bj][m][n]; }
    }
};
struct EpiG {
    static constexpr bool PERM = true;
    h16* rkvz; h16* lh;
    __device__ __forceinline__ void operator()(const f32x4 (&acc)[2][2][4][2], const pg8::Unit& u, int wr, int wc, int fr, int fq) const {
        const int s = u.pm / MT, i = u.pm - s * MT, row0 = i * 256 + wr * 64 + fr;
        if (s < 4) {
            h16* base = rkvz + (size_t)s * MP * 1024; const int col0 = (u.pn - 4 * s) * 256 + wc * 32 + 8 * fq;
#pragma unroll
            for (int ai = 0; ai < 2; ++ai)
#pragma unroll
                for (int m = 0; m < 4; ++m) { h16* rowp = base + (size_t)(row0 + ai * 128 + m * 16) * 1024 + col0;
#pragma unroll
                    for (int bj = 0; bj < 2; ++bj) *(h16x8*)(rowp + bj * 128) = pack8(acc[ai][bj][m][0], acc[ai][bj][m][1]); }
        } else if (wc < 2) {
            const int cb = (s == 4 ? 0 : 64) + wc * 32 + 8 * fq;
#pragma unroll
            for (int ai = 0; ai < 2; ++ai)
#pragma unroll
                for (int m = 0; m < 4; ++m) { h16* rowp = lh + (size_t)(row0 + ai * 128 + m * 16) * 256;
                    f32x4 v0 = acc[ai][0][m][0], v1 = acc[ai][0][m][1];
                    if (s == 4) {
#pragma unroll
                        for (int j = 0; j < 4; ++j) { v0[j] = tanhf(v0[j]); v1[j] = tanhf(v1[j]); } }
                    *(h16x8*)(rowp + cb) = pack8(v0, v1);
                    *(h16x8*)(rowp + 128 + cb) = pack8((f32x4){0.f, 0.f, 0.f, 0.f}, (f32x4){0.f, 0.f, 0.f, 0.f}); }
        }
    }
};
struct OrderG {
    pg8::StaticOrder so; int G, c;
    __device__ void init(int G_, int c_) { so.init(4 * MT * 256, 1024, G_, c_); G = G_; c = c_; }
    __device__ bool next(int i, pg8::Unit& u) const {
        long L = (long)i * G + c;
        if (L < 4 * MT * 4) { pg8::Unit v; so.next(i, v); u.pm = v.pm; u.pn = (v.pm / MT) * 4 + v.pn; return true; }
        L -= 4 * MT * 4; if (L >= 2 * MT) return false;
        const int s = 4 + (int)(L / MT), ii = (int)(L % MT); u.pm = s * MT + ii; u.pn = 12 + s; return true;
    }
};

__device__ __forceinline__ void phase_conv(const Args& a, float* ldsf) {
    const int tid = threadIdx.x, lane = tid & 63, wid = tid >> 6;
    const h16* pre = (const h16*)(a.ws + WS_QKVPRE); h16* qkv = (h16*)(a.ws + WS_QKV);
    const float* ba = (const float*)(a.ws + WS_BA); float* gb = (float*)(a.ws + WS_GB);
    const float* cst = a.in[I_SGC];
    for (int i = tid; i < 4096; i += NTHREADS) { const f32x4 w = *(const f32x4*)(a.in[I_CW] + (size_t)i * 4); ldsf[i] = w[0]; ldsf[4096 + i] = w[1]; ldsf[8192 + i] = w[2]; ldsf[12288 + i] = w[3]; }
    __syncthreads();
    for (int row = blockIdx.x * 8 + wid; row < NR; row += gridDim.x * 8) {
        int b, t; bool samp; row_bt(row, b, t, samp);
        for (int half = 0; half < 2; ++half) {
            h16x8 x[4][4];
#pragma unroll
            for (int sg = 0; sg < 4; ++sg) {
                const int c0 = (half * 4 + sg) * 512 + lane * 8;
#pragma unroll
                for (int jj = 0; jj < 4; ++jj) {
                    const int idx = t + jj;
                    if (idx >= 3) x[sg][jj] = *(const h16x8*)(pre + (size_t)(row - 3 + jj) * 4096 + c0);
                    else if (samp) { const float* bp = cst + ((size_t)b * 3 + idx) * 4096 + c0; const f32x4 p0 = *(const f32x4*)bp, p1 = *(const f32x4*)(bp + 4); x[sg][jj] = pack8(p0, p1); }
                    else x[sg][jj] = pack8((f32x4){0.f, 0.f, 0.f, 0.f}, (f32x4){0.f, 0.f, 0.f, 0.f});
                }
            }
#pragma unroll
            for (int sg = 0; sg < 4; ++sg) {
                const int seg = half * 4 + sg, c0 = seg * 512 + lane * 8;
                float y[8];
#pragma unroll
                for (int j = 0; j < 8; ++j) y[j] = 0.f;
#pragma unroll
                for (int jj = 0; jj < 4; ++jj) { const f32x4 w0 = *(const f32x4*)(ldsf + jj * 4096 + c0), w1 = *(const f32x4*)(ldsf + jj * 4096 + c0 + 4);
#pragma unroll
                    for (int j = 0; j < 4; ++j) { y[j] += (float)x[sg][jj][j] * w0[j]; y[4 + j] += (float)x[sg][jj][4 + j] * w1[j]; } }
                float ss = 0.f;
#pragma unroll
                for (int j = 0; j < 8; ++j) { y[j] = siluf_(y[j]); ss += y[j] * y[j]; }
                float sc = 1.0f;
                if (seg < 4) { ss = red16(ss); sc = rsqrtf(ss + 1e-6f) * (seg < 2 ? 0.08838834764831845f : 1.0f); }
                h16x8 o;
#pragma unroll
                for (int j = 0; j < 8; ++j) o[j] = (h16)(y[j] * sc);
                *(h16x8*)(qkv + (size_t)row * 4096 + c0) = o;
                float* cso = nullptr;
                if (!samp && t >= TP - 3) cso = a.out + O_PGC + ((size_t)b * 3 + (t - (TP - 3))) * 4096 + c0;
                if (samp && t >= 5) cso = a.out + O_SGC + ((size_t)b * 3 + (t - 5)) * 4096 + c0;
                if (cso) { const h16x8 u = x[sg][3]; *(f32x4*)cso = (f32x4){(float)u[0], (float)u[1], (float)u[2], (float)u[3]}; *(f32x4*)(cso + 4) = (f32x4){(float)u[4], (float)u[5], (float)u[6], (float)u[7]}; }
            }
        }
        if (lane < 16) {
            const float bv = ba[(size_t)row * 32 + lane], av = ba[(size_t)row * 32 + 16 + lane];
            gb[(size_t)row * 32 + lane] = sigmoidf_(bv);
            gb[(size_t)row * 32 + 16 + lane] = -expf(a.in[I_ALOG][lane]) * softplusf_(av + a.in[I_DTB][lane]);
        }
    }
}

__device__ __forceinline__ void phase_gdn_scan(const Args& a, float* ldsf) {
    const int tid = threadIdx.x;
    const int vl = tid >> 3, kq = tid & 7;
    const h16* qkv = (const h16*)(a.ws + WS_QKV); const float* gb = (const float*)(a.ws + WS_GB); float* obuf = (float*)(a.ws + WS_OBUF);
    const int stt = tid >> 6, sp = tid & 63;
    for (int it = blockIdx.x; it < 256 + 4096; it += gridDim.x) {
        const bool samp = it >= 256; const int q = samp ? it - 256 : it;
        const int seq = q >> 1, vhalf = q & 1, b = seq >> 4, hv = seq & 15, hq = hv >> 1;
        const int T = samp ? 8 : TP, row0 = samp ? NPR + b * 8 : b * TP;
        const int v = vhalf * 64 + vl;
        float S[16];
        if (samp) { const float* spp = a.in[I_SG] + ((size_t)(b * 16 + hv) * 128 + kq * 16) * 128 + v;
#pragma unroll
            for (int i = 0; i < 16; ++i) S[i] = spp[(size_t)i * 128]; }
        else {
#pragma unroll
            for (int i = 0; i < 16; ++i) S[i] = 0.f; }
        h16x4 pqk; h16 pv; float pg = 0.f, pb = 0.f;
        { const h16* rp = qkv + (size_t)(row0 + stt) * 4096;
          pqk = *(const h16x4*)(rp + (sp < 32 ? hq * 128 + sp * 4 : 1024 + hq * 128 + (sp - 32) * 4)); pv = rp[2048 + hv * 128 + vhalf * 64 + sp];
          if (tid < 8) { pb = gb[(size_t)(row0 + tid) * 32 + hv]; pg = gb[(size_t)(row0 + tid) * 32 + 16 + hv]; } }
        __syncthreads();
        int cur = 0;
        for (int t0 = 0; t0 < T; t0 += 8) {
            float* Lb = ldsf + cur * 2576;
            *(f32x4*)(Lb + (sp < 32 ? 0 : 1024) + stt * 128 + (sp & 31) * 4) = (f32x4){(float)pqk[0], (float)pqk[1], (float)pqk[2], (float)pqk[3]};
            Lb[2048 + stt * 64 + sp] = (float)pv;
            if (tid < 8) { Lb[2560 + tid] = expf(pg); Lb[2568 + tid] = pb; }
            __syncthreads();
            if (t0 + 8 < T) { const h16* rp = qkv + (size_t)(row0 + t0 + 8 + stt) * 4096;
                pqk = *(const h16x4*)(rp + (sp < 32 ? hq * 128 + sp * 4 : 1024 + hq * 128 + (sp - 32) * 4)); pv = rp[2048 + hv * 128 + vhalf * 64 + sp];
                if (tid < 8) { pb = gb[(size_t)(row0 + t0 + 8 + tid) * 32 + hv]; pg = gb[(size_t)(row0 + t0 + 8 + tid) * 32 + 16 + hv]; } }
#pragma unroll 2
            for (int tt = 0; tt < 8; ++tt) {
                const float al = Lb[2560 + tt], be = Lb[2568 + tt], vv = Lb[2048 + tt * 64 + vl];
                const f32x4* kp = (const f32x4*)(Lb + 1024 + tt * 128 + kq * 16); const f32x4* qp = (const f32x4*)(Lb + tt * 128 + kq * 16);
                float kr[16];
                float dot = 0.f;
#pragma unroll
                for (int i = 0; i < 4; ++i) { const f32x4 kv = kp[i]; kr[4 * i] = kv[0]; kr[4 * i + 1] = kv[1]; kr[4 * i + 2] = kv[2]; kr[4 * i + 3] = kv[3]; }
#pragma unroll
                for (int i = 0; i < 16; ++i) dot += kr[i] * S[i];
                dot = red8(dot);
                const float c = be * (vv - al * dot);
                float od = 0.f;
#pragma unroll
                for (int i = 0; i < 4; ++i) { const f32x4 qv = qp[i];
#pragma unroll
                    for (int j = 0; j < 4; ++j) { const float s = al * S[4 * i + j] + kr[4 * i + j] * c; S[4 * i + j] = s; od += qv[j] * s; } }
                od = red8(od);
                if (kq == 0) obuf[(size_t)(row0 + t0 + tt) * 2048 + hv * 128 + v] = od;
            }
            cur ^= 1;
        }
        float* so = a.out + (samp ? O_SG : O_PG) + ((size_t)(b * 16 + hv) * 128 + kq * 16) * 128 + v;
#pragma unroll
        for (int i = 0; i < 16; ++i) so[(size_t)i * 128] = S[i];
    }
}

__device__ __forceinline__ void phase_gdn_gate(const Args& a) {
    const int lane = threadIdx.x & 63, wid = threadIdx.x >> 6;
    const float* obuf = (const float*)(a.ws + WS_OBUF); const h16* z = (const h16*)(a.ws + WS_Z); h16* og = (h16*)(a.ws + WS_OG);
    const f32x4 gw0 = *(const f32x4*)(a.in[I_GNW] + (lane & 15) * 8), gw1 = *(const f32x4*)(a.in[I_GNW] + (lane & 15) * 8 + 4);
    for (int row = blockIdx.x * 8 + wid; row < NR; row += gridDim.x * 8) {
        f32x4 o0[4], o1[4]; h16x8 zz[4];
#pragma unroll
        for (int j = 0; j < 4; ++j) { const size_t e = (size_t)row * 2048 + j * 512 + lane * 8; o0[j] = *(const f32x4*)(obuf + e); o1[j] = *(const f32x4*)(obuf + e + 4); zz[j] = *(const h16x8*)(z + e); }
#pragma unroll
        for (int j = 0; j < 4; ++j) {
            const float ss = red16(sq4(o0[j]) + sq4(o1[j]));
            const float sc = rsqrtf(ss * (1.0f / 128.0f) + 1e-6f);
            h16x8 r;
#pragma unroll
            for (int i = 0; i < 4; ++i) { r[i] = (h16)(o0[j][i] * sc * gw0[i] * siluf_((float)zz[j][i])); r[4 + i] = (h16)(o1[j][i] * sc * gw1[i] * siluf_((float)zz[j][4 + i])); }
            *(h16x8*)(og + (size_t)row * 2048 + j * 512 + lane * 8) = r;
        }
    }
}

__device__ __forceinline__ void phase_shift(const Args& a) {
    const int lane = threadIdx.x & 63, wid = threadIdx.x >> 6;
    const float* x1 = (const float*)(a.ws + WS_X1); h16* xs = (h16*)(a.ws + WS_XS);
    const float* nw = a.in[I_NW] + DM; const float* mu = a.in[I_MU];
    for (int pr = blockIdx.x * 8 + wid; pr < NR / 2; pr += gridDim.x * 8) {
        const int row = pr * 2;
        int b, t; bool samp; row_bt(row, b, t, samp);
        f32x4 xa[4], xb[4], xp[4];
#pragma unroll
        for (int i = 0; i < 4; ++i) { xa[i] = *(const f32x4*)(x1 + (size_t)row * DM + i * 256 + lane * 4); xb[i] = *(const f32x4*)(x1 + (size_t)(row + 1) * DM + i * 256 + lane * 4); }
        if (t > 0) {
#pragma unroll
            for (int i = 0; i < 4; ++i) xp[i] = *(const f32x4*)(x1 + (size_t)(row - 1) * DM + i * 256 + lane * 4); }
        else if (samp) {
#pragma unroll
            for (int i = 0; i < 4; ++i) xp[i] = *(const f32x4*)(a.in[I_SRS] + (size_t)b * DM + i * 256 + lane * 4); }
        else {
#pragma unroll
            for (int i = 0; i < 4; ++i) xp[i] = (f32x4){0.f, 0.f, 0.f, 0.f}; }
        float sa = 0.f, sb = 0.f, sp = 0.f;
#pragma unroll
        for (int i = 0; i < 4; ++i) { sa += sq4(xa[i]); sb += sq4(xb[i]); sp += sq4(xp[i]); }
        sa = wsum(sa); sb = wsum(sb);
        const float ca = rsqrtf(sa * (1.0f / 1024.0f) + 1e-6f), cb = rsqrtf(sb * (1.0f / 1024.0f) + 1e-6f);
        float cp = 1.0f;
        if (t > 0) { sp = wsum(sp); cp = rsqrtf(sp * (1.0f / 1024.0f) + 1e-6f); }
#pragma unroll
        for (int i = 0; i < 4; ++i) { const f32x4 w = *(const f32x4*)(nw + i * 256 + lane * 4); xa[i] = xa[i] * ca * w; xb[i] = xb[i] * cb * w; if (t > 0) xp[i] = xp[i] * cp * w; }
        for (int s = 0; s < 6; ++s) {
#pragma unroll
            for (int i = 0; i < 4; ++i) { const f32x4 m = *(const f32x4*)(mu + (size_t)s * DM + i * 256 + lane * 4);
                const f32x4 r0 = xa[i] + (xp[i] - xa[i]) * m, r1 = xb[i] + (xa[i] - xb[i]) * m;
                h16x4 o0, o1; o0[0] = (h16)r0[0]; o0[1] = (h16)r0[1]; o0[2] = (h16)r0[2]; o0[3] = (h16)r0[3]; o1[0] = (h16)r1[0]; o1[1] = (h16)r1[1]; o1[2] = (h16)r1[2]; o1[3] = (h16)r1[3];
                *(h16x4*)(xs + ((size_t)s * MP + row) * DM + i * 256 + lane * 4) = o0; *(h16x4*)(xs + ((size_t)s * MP + row + 1) * DM + i * 256 + lane * 4) = o1; }
        }
        float* so = nullptr;
        if (!samp && t == TP - 2) so = a.out + O_PRS + (size_t)b * DM;
        if (samp && t == 6) so = a.out + O_SRS + (size_t)b * DM;
        if (so) {
#pragma unroll
            for (int i = 0; i < 4; ++i) *(f32x4*)(so + i * 256 + lane * 4) = xb[i]; }
    }
}

__device__ __forceinline__ void phase_rwkv_prep(const Args& a) {
    const int lane = threadIdx.x & 63, wid = threadIdx.x >> 6;
    h16* rkvz = (h16*)(a.ws + WS_RKVZ); const h16* lo = (const h16*)(a.ws + WS_LOUT);
    float* dbuf = (float*)(a.ws + WS_DB); h16* kkb = (h16*)(a.ws + WS_KKB); h16* bbb = (h16*)(a.ws + WS_BBB); float* rkb = (float*)(a.ws + WS_RK);
    float pw0[2][8], pa0[2][8], pkk[2][8], pka[2][8], prk[2][8];
#pragma unroll
    for (int j = 0; j < 2; ++j)
#pragma unroll
        for (int i = 0; i < 8; ++i) { const int c = j * 512 + lane * 8 + i; pw0[j][i] = a.in[I_W0][c]; pa0[j][i] = a.in[I_A0][c]; pkk[j][i] = a.in[I_KK][c]; pka[j][i] = a.in[I_KA][c]; prk[j][i] = a.in[I_RK][c]; }
    for (int row = blockIdx.x * 8 + wid; row < NR; row += gridDim.x * 8) {
        h16x8 r[2], k[2], wl[2], al[2];
#pragma unroll
        for (int j = 0; j < 2; ++j) { const size_t e = (size_t)row * 1024 + j * 512 + lane * 8; const size_t e2 = (size_t)row * 2048 + j * 512 + lane * 8;
            r[j] = *(const h16x8*)(rkvz + e); k[j] = *(const h16x8*)(rkvz + (size_t)MP * 1024 + e); wl[j] = *(const h16x8*)(lo + e2); al[j] = *(const h16x8*)(lo + e2 + 1024); }
#pragma unroll
        for (int j = 0; j < 2; ++j) {
            float kkv[8], aa[8], dd[8]; h16x8 k2o; float ss = 0.f, rk = 0.f;
#pragma unroll
            for (int i = 0; i < 8; ++i) {
                const float w = -softplusf_(-(pw0[j][i] + (float)wl[j][i])) - 0.5f;
                dd[i] = expf(-expf(w));
                aa[i] = sigmoidf_(pa0[j][i] + (float)al[j][i]);
                const float kf = (float)k[j][i];
                kkv[i] = kf * pkk[j][i]; ss += kkv[i] * kkv[i];
                const float k2 = kf * (1.0f + (aa[i] - 1.0f) * pka[j][i]);
                rk += (float)r[j][i] * k2 * prk[j][i];
                k2o[i] = (h16)k2;
            }
            ss = red8(ss); rk = red8(rk);
            const float inv = rsqrtf(ss + 1e-6f);
            h16x8 kko, bbo;
#pragma unroll
            for (int i = 0; i < 8; ++i) { const float kk = kkv[i] * inv; kko[i] = (h16)kk; bbo[i] = (h16)(kk * aa[i]); }
            const size_t e = (size_t)row * 1024 + j * 512 + lane * 8;
            *(h16x8*)(rkvz + (size_t)MP * 1024 + e) = k2o; *(h16x8*)(kkb + e) = kko; *(h16x8*)(bbb + e) = bbo;
            *(f32x4*)(dbuf + e) = (f32x4){dd[0], dd[1], dd[2], dd[3]}; *(f32x4*)(dbuf + e + 4) = (f32x4){dd[4], dd[5], dd[6], dd[7]};
            if ((lane & 7) == 0) rkb[(size_t)row * 16 + j * 8 + (lane >> 3)] = rk;
        }
    }
}

__device__ __forceinline__ void phase_rwkv_scan(const Args& a, float* ldsf) {
    const int tid = threadIdx.x, lane = tid & 63, wid = tid >> 6;
    const int rl = lane >> 4, kq = lane & 15;
    const h16* rkvz = (const h16*)(a.ws + WS_RKVZ); const float* dbuf = (const float*)(a.ws + WS_DB);
    const h16* kkb = (const h16*)(a.ws + WS_KKB); const h16* bbb = (const h16*)(a.ws + WS_BBB);
    float* ybuf = (float*)(a.ws + WS_YBUF);
    const int stt = tid >> 6, sch = tid & 63;
    for (int it = blockIdx.x; it < 256 + 4096; it += gridDim.x) {
        const bool samp = it >= 256; const int q = samp ? it - 256 : it;
        const int seq = q >> 1, half = q & 1, b = seq >> 4, h = seq & 15;
        const int T = samp ? 8 : TP, row0 = samp ? NPR + b * 8 : b * TP;
        const int v = half * 32 + wid * 4 + rl;
        f32x4 S;
        if (samp) S = *(const f32x4*)(a.in[I_SR] + ((size_t)(b * 16 + h) * 64 + v) * 64 + kq * 4);
        else S = (f32x4){0.f, 0.f, 0.f, 0.f};
        float pr, pk, pd, pkk, pb, pv;
        { const size_t e = (size_t)(row0 + stt) * 1024 + h * 64 + sch;
          pr = (float)rkvz[e]; pk = (float)rkvz[(size_t)MP * 1024 + e]; pv = (float)rkvz[(size_t)2 * MP * 1024 + e]; pd = dbuf[e]; pkk = (float)kkb[e]; pb = (float)bbb[e]; }
        __syncthreads();
        int cur = 0;
        for (int t0 = 0; t0 < T; t0 += 8) {
            float* Lb = ldsf + cur * 3072;
            Lb[stt * 64 + sch] = pr; Lb[512 + stt * 64 + sch] = pk; Lb[1024 + stt * 64 + sch] = pd; Lb[1536 + stt * 64 + sch] = pkk; Lb[2048 + stt * 64 + sch] = pb; Lb[2560 + stt * 64 + sch] = pv;
            __syncthreads();
            if (t0 + 8 < T) { const size_t e = (size_t)(row0 + t0 + 8 + stt) * 1024 + h * 64 + sch;
                pr = (float)rkvz[e]; pk = (float)rkvz[(size_t)MP * 1024 + e]; pv = (float)rkvz[(size_t)2 * MP * 1024 + e]; pd = dbuf[e]; pkk = (float)kkb[e]; pb = (float)bbb[e]; }
#pragma unroll
            for (int tt = 0; tt < 8; ++tt) {
                const f32x4 kk4 = *(const f32x4*)(Lb + 1536 + tt * 64 + kq * 4), d4 = *(const f32x4*)(Lb + 1024 + tt * 64 + kq * 4), b4 = *(const f32x4*)(Lb + 2048 + tt * 64 + kq * 4);
                const f32x4 k4 = *(const f32x4*)(Lb + 512 + tt * 64 + kq * 4), r4 = *(const f32x4*)(Lb + tt * 64 + kq * 4);
                const float vv = Lb[2560 + tt * 64 + v];
                float sa = S[0] * kk4[0] + S[1] * kk4[1] + S[2] * kk4[2] + S[3] * kk4[3];
                sa = red16(sa);
                const float nsa = -sa;
                S = S * d4 + nsa * b4 + vv * k4;
                float y = S[0] * r4[0] + S[1] * r4[1] + S[2] * r4[2] + S[3] * r4[3];
                y = red16(y);
                if (kq == 0) ybuf[(size_t)(row0 + t0 + tt) * 1024 + h * 64 + v] = y;
            }
            cur ^= 1;
        }
        *(f32x4*)(a.out + (samp ? O_SR : O_PR) + ((size_t)(b * 16 + h) * 64 + v) * 64 + kq * 4) = S;
    }
}

__device__ __forceinline__ void phase_rwkv_gate(const Args& a) {
    const int lane = threadIdx.x & 63, wid = threadIdx.x >> 6;
    const float* ybuf = (const float*)(a.ws + WS_YBUF); const float* rkb = (const float*)(a.ws + WS_RK);
    const h16* rkvz = (const h16*)(a.ws + WS_RKVZ); h16* yg = (h16*)(a.ws + WS_YG);
    float lw[2][8], lb[2][8];
#pragma unroll
    for (int j = 0; j < 2; ++j)
#pragma unroll
        for (int i = 0; i < 8; ++i) { const int c = j * 512 + lane * 8 + i; lw[j][i] = a.in[I_LNW][c]; lb[j][i] = a.in[I_LNB][c]; }
    for (int row = blockIdx.x * 8 + wid; row < NR; row += gridDim.x * 8) {
        f32x4 y0[2], y1[2]; h16x8 vv[2], zz[2]; float rk[2];
#pragma unroll
        for (int j = 0; j < 2; ++j) { const size_t e = (size_t)row * 1024 + j * 512 + lane * 8;
            y0[j] = *(const f32x4*)(ybuf + e); y1[j] = *(const f32x4*)(ybuf + e + 4); vv[j] = *(const h16x8*)(rkvz + (size_t)2 * MP * 1024 + e); zz[j] = *(const h16x8*)(rkvz + (size_t)3 * MP * 1024 + e);
            rk[j] = rkb[(size_t)row * 16 + j * 8 + (lane >> 3)]; }
#pragma unroll
        for (int j = 0; j < 2; ++j) {
            float y[8] = {y0[j][0], y0[j][1], y0[j][2], y0[j][3], y1[j][0], y1[j][1], y1[j][2], y1[j][3]};
            float sm = 0.f;
#pragma unroll
            for (int i = 0; i < 8; ++i) sm += y[i];
            const float mean = red8(sm) * (1.0f / 64.0f);
            float sv = 0.f;
#pragma unroll
            for (int i = 0; i < 8; ++i) { y[i] -= mean; sv += y[i] * y[i]; }
            const float rs = rsqrtf(red8(sv) * (1.0f / 64.0f) + 64e-5f);
            h16x8 o;
#pragma unroll
            for (int i = 0; i < 8; ++i) { const float yn = y[i] * rs * lw[j][i] + lb[j][i] + rk[j] * (float)vv[j][i]; o[i] = (h16)(yn * siluf_((float)zz[j][i])); }
            *(h16x8*)(yg + (size_t)row * 1024 + j * 512 + lane * 8) = o;
        }
    }
}

__device__ __forceinline__ void phase_final(const Args& a) {
    const int lane = threadIdx.x & 63, wid = threadIdx.x >> 6;
    const float* x2 = (const float*)(a.ws + WS_X2); const float* nw = a.in[I_FNW];
    for (int pr = blockIdx.x * 8 + wid; pr < NR / 2; pr += gridDim.x * 8) {
        const int row = pr * 2;
        int b, t; bool samp; row_bt(row, b, t, samp);
        if (!samp && t < 16) continue;
        float* op = samp ? a.out + O_YS + (size_t)(row - NPR) * DM : a.out + O_YP + ((size_t)b * 2048 + (t - 16)) * DM;
        const float* p = x2 + (size_t)row * DM; f32x4 v[4], u[4]; float ss = 0.f, su = 0.f;
#pragma unroll
        for (int i = 0; i < 4; ++i) { v[i] = *(const f32x4*)(p + i * 256 + lane * 4); u[i] = *(const f32x4*)(p + DM + i * 256 + lane * 4); }
#pragma unroll
        for (int i = 0; i < 4; ++i) { ss += sq4(v[i]); su += sq4(u[i]); }
        ss = wsum(ss); su = wsum(su);
        const float sc = rsqrtf(ss * (1.0f / 1024.0f) + 1e-6f), scu = rsqrtf(su * (1.0f / 1024.0f) + 1e-6f);
#pragma unroll
        for (int i = 0; i < 4; ++i) { const f32x4 w = *(const f32x4*)(nw + i * 256 + lane * 4); *(f32x4*)(op + i * 256 + lane * 4) = v[i] * sc * w; *(f32x4*)(op + DM + i * 256 + lane * 4) = u[i] * scu * w; }
    }
}

constexpr int NPHASE = 14;
__global__ void __launch_bounds__(NTHREADS, 2) mk_fwd(Args a) {
    extern __shared__ __attribute__((aligned(16))) unsigned char smem[];
    PG8_LAS unsigned char* lds = (PG8_LAS unsigned char*)smem;
    float* ldsf = (float*)smem;
    const int G = gridDim.x, c = blockIdx.x;
#if MK_COOP
    cg::grid_group grid = cg::this_grid();
#define SEAM(p) do { if ((p) + 1 < a.ph_hi) grid.sync(); } while (0)
#else
#define SEAM(p) do { } while (0)
#endif
#define IN(p) (a.ph_lo <= (p) && (p) < a.ph_hi)
    if (IN(0)) { phase_prep(a, ldsf); SEAM(0); }
    if (IN(1)) { __syncthreads();
        pg8::Gemm g{(const h16*)(a.ws + WS_XN0), (const h16*)(a.ws + WS_WIN), MP, 6400, 1024}; pg8::StaticOrder S; S.init(MP, 6400, G, c);
        EpiProj E{(h16*)(a.ws + WS_QKVPRE), (h16*)(a.ws + WS_Z), (float*)(a.ws + WS_BA)};
        pg8::gemm_phase<EpiProj, pg8::StaticOrder>(lds, g, S, E); SEAM(1); }
    if (IN(2)) { __syncthreads(); phase_conv(a, ldsf); SEAM(2); }
    if (IN(3)) { __syncthreads(); phase_gdn_scan(a, ldsf); SEAM(3); }
    if (IN(4)) { phase_gdn_gate(a); SEAM(4); }
    if (IN(5)) { __syncthreads();
        pg8::Gemm g{(const h16*)(a.ws + WS_OG), (const h16*)(a.ws + WS_WOUT), MP, 1024, 2048}; pg8::StaticOrder S; S.init(MP, 1024, G, c);
        EpiResX E{a.in[I_META], a.in[I_XP], a.in[I_XS], (float*)(a.ws + WS_X1)};
        pg8::gemm_phase<EpiResX, pg8::StaticOrder>(lds, g, S, E); SEAM(5); }
    if (IN(6)) { phase_shift(a); SEAM(6); }
    if (IN(7)) { __syncthreads();
        pg8::Gemm g{(const h16*)(a.ws + WS_XS), (const h16*)(a.ws + WS_WR), 6 * MP, 4608, 1024}; OrderG S; S.init(G, c);
        EpiG E{(h16*)(a.ws + WS_RKVZ), (h16*)(a.ws + WS_LH)};
        pg8::gemm_phase<EpiG, OrderG>(lds, g, S, E); SEAM(7); }
    if (IN(8)) { __syncthreads();
        pg8::Gemm g{(const h16*)(a.ws + WS_LH), (const h16*)(a.ws + WS_WL2), MP, 2048, 256}; pg8::StaticOrder S; S.init(MP, 2048, G, c);
        EpiH16 E{(h16*)(a.ws + WS_LOUT), 2048};
        pg8::gemm_phase<EpiH16, pg8::StaticOrder>(lds, g, S, E); SEAM(8); }
    if (IN(9)) { phase_rwkv_prep(a); SEAM(9); }
    if (IN(10)) { __syncthreads(); phase_rwkv_scan(a, ldsf); SEAM(10); }
    if (IN(11)) { phase_rwkv_gate(a); SEAM(11); }
    if (IN(12)) { __syncthreads();
        pg8::Gemm g{(const h16*)(a.ws + WS_YG), (const h16*)(a.ws + WS_WO), MP, 1024, 1024}; pg8::StaticOrder S; S.init(MP, 1024, G, c);
        EpiResB E{(const float*)(a.ws + WS_X1), (float*)(a.ws + WS_X2)};
        pg8::gemm_phase<EpiResB, pg8::StaticOrder>(lds, g, S, E); SEAM(12); }
    if (IN(13)) { phase_final(a); }
#undef IN
#undef SEAM
}

extern "C" void kernel_launch(void* const* d_in, const int* in_sizes, int n_in, void* d_out, int out_size, void* d_ws, size_t ws_size, hipStream_t stream) {
    static int grid = 0;
    if (grid == 0) {
        if (n_in != 29 || ws_size < WS_END) { fprintf(stderr, "kernel_launch: unexpected n_in %d or ws_size %zu (< %zu)\n", n_in, ws_size, (size_t)WS_END); grid = -1; return; }
        int dev = 0, cus = 0, per_cu = 0;
        hipGetDevice(&dev); hipDeviceGetAttribute(&cus, hipDeviceAttributeMultiprocessorCount, dev);
        if (hipFuncSetAttribute((const void*)mk_fwd, hipFuncAttributeMaxDynamicSharedMemorySize, LDS_BYTES) != hipSuccess) { fprintf(stderr, "kernel_launch: hipFuncSetAttribute failed\n"); }
        if (hipOccupancyMaxActiveBlocksPerMultiprocessor(&per_cu, (const void*)mk_fwd, NTHREADS, LDS_BYTES) != hipSuccess || per_cu < 1) { fprintf(stderr, "kernel_launch: occupancy query gave %d\n", per_cu); per_cu = 1; }
        (void)hipGetLastError();
        grid = cus * 1;
        if (grid <= 0) grid = 256;
    }
    if (grid < 0) return;
    Args a; memset(&a, 0, sizeof(a));
    for (int i = 0; i < 29; ++i) a.in[i] = (const float*)d_in[i];
    a.out = (float*)d_out; a.ws = (unsigned char*)d_ws;
#if MK_COOP
    a.ph_lo = 0; a.ph_hi = NPHASE;
    void* args[] = {&a};
    hipError_t e = hipLaunchCooperativeKernel((const void*)mk_fwd, dim3(grid), dim3(NTHREADS), args, LDS_BYTES, stream);
    if (e != hipSuccess) fprintf(stderr, "cooperative launch failed: %s (grid %d)\n", hipGetErrorString(e), grid);
#else
    for (int p = 0; p < NPHASE; ++p) { a.ph_lo = p; a.ph_hi = p + 1; hipLaunchKernelGGL(mk_fwd, dim3(grid), dim3(NTHREADS), LDS_BYTES, stream, a); }
#endif
}
```

```cpp
#include <hip/hip_runtime.h>
#include <hip/hip_cooperative_groups.h>
#include <cstdio>
#include <cstring>
namespace cg = cooperative_groups;

#ifndef MK_COOP
#define MK_COOP 1
#endif

typedef _Float16 h16;
typedef _Float16 h16x8 __attribute__((ext_vector_type(8)));
typedef _Float16 h16x4 __attribute__((ext_vector_type(4)));
typedef _Float16 h16x2 __attribute__((ext_vector_type(2)));
typedef float f32x4 __attribute__((ext_vector_type(4)));
typedef float f32x2 __attribute__((ext_vector_type(2)));

namespace pg8 {
#define PG8_LAS __attribute__((address_space(3)))
constexpr int BM = 256, BK = 64, HALF = 128, HTB = HALF * BK * 2, STAGE_BYTES = 8 * HTB, NXCD = 8, WGM = 8;
__host__ __device__ __forceinline__ int lds_byte(int r, int c) { const int st = (r >> 4) * 2 + (c >> 5), rr = r & 15, cc = c & 31, ob = rr * 64 + cc * 2; return st * 1024 + (ob ^ (((ob >> 9) & 1) << 5)); }
__host__ __device__ __forceinline__ void stage_rc(int b, int& R, int& C) { const int st = b / 1024, sb = b % 1024, swz = sb ^ (((sb >> 9) & 1) << 5); R = (st >> 1) * 16 + swz / 64; C = (st & 1) * 32 + (swz % 64) / 2; }
__host__ __device__ __forceinline__ int perm32(int rho) { const int n = rho >> 4, i = rho & 15; return 8 * (i >> 2) + 4 * n + (i & 3); }
struct Unit { int pm, pn; };
struct Gemm { const h16* A; const h16* Bt; int M, N, K; };
struct StaticOrder {
    int nM, nN, nwg, G, c;
    __host__ __device__ void init(int M, int N, int G_, int c_) { nM = M / BM; nN = N / BM; nwg = nM * nN; G = G_; c = c_; }
    __host__ __device__ bool next(int i, Unit& u) const {
        const long L = (long)i * G + c; if (L >= nwg) return false;
        int wgid = (int)L; { const int q = nwg / NXCD, r = nwg % NXCD, xcd = wgid % NXCD, off = wgid / NXCD; wgid = (xcd < r ? xcd * (q + 1) : r * (q + 1) + (xcd - r) * q) + off; }
        const int nig = WGM * nN, gid = wgid / nig, fm = gid * WGM, gsz = (nM - fm) < WGM ? (nM - fm) : WGM;
        u.pm = fm + ((wgid % nig) % gsz); u.pn = (wgid % nig) / gsz; return true;
    }
};

template <class Epi, class Sched>
__device__ __forceinline__ void gemm_phase(PG8_LAS unsigned char* lds, const Gemm g, const Sched& S, const Epi& E) {
    const int tid = threadIdx.x, wid = __builtin_amdgcn_readfirstlane(tid >> 6), lane = tid & 63, wr = wid >> 2, wc = wid & 3, fr = lane & 15, fq = lane >> 4;
    const int K = g.K, nt = K / BK;
    unsigned voffA[2], voffB[2];
#pragma unroll
    for (int i = 0; i < 2; ++i) { int R, C; stage_rc(tid * 16 + i * 8192, R, C); const int Rb = Epi::PERM ? ((R & ~31) + perm32(R & 31)) : R;
        voffA[i] = (unsigned)(R * K + C) * 2u; voffB[i] = (unsigned)(Rb * K + C) * 2u; }
    const size_t kstep = (size_t)(BK * 2);
    const size_t hstep = (size_t)HALF * K * 2;
    const size_t tstep = 2 * hstep;
    const unsigned ldsw = (unsigned)wid * 1024u;
    const int aoff = lds_byte(wr * 64 + fr, fq * 8), boff = lds_byte(wc * 32 + fr, fq * 8);
#define PG8_SA(b, h) (((b) * 2 + (h)) * HTB)
#define PG8_SB(b, h) ((4 + (b) * 2 + (h)) * HTB)
#define PG8_STAGE(bufoff, gbase, voff) do { _Pragma("unroll") for (int _i = 0; _i < 2; ++_i) \
        __builtin_amdgcn_global_load_lds((const unsigned*)((const char*)(gbase) + (voff)[_i]), (PG8_LAS unsigned*)(lds + (bufoff) + ldsw + _i * 8192), 16, 0, 0); } while (0)
#define PG8_LDA(dst, b, h) do { _Pragma("unroll") for (int m = 0; m < 4; ++m) _Pragma("unroll") for (int k = 0; k < 2; ++k) dst[m][k] = *(const PG8_LAS h16x8*)(lds + PG8_SA(b, h) + aoff + m * 2048 + k * 1024); } while (0)
#define PG8_LDB(dst, b, h) do { _Pragma("unroll") for (int n = 0; n < 2; ++n) _Pragma("unroll") for (int k = 0; k < 2; ++k) dst[n][k] = *(const PG8_LAS h16x8*)(lds + PG8_SB(b, h) + boff + n * 2048 + k * 1024); } while (0)
#define PG8_MMA(ai, bj, At, Bt) do { __builtin_amdgcn_s_setprio(1); _Pragma("unroll") for (int m = 0; m < 4; ++m) _Pragma("unroll") for (int n = 0; n < 2; ++n) _Pragma("unroll") for (int k = 0; k < 2; ++k) \
        acc[ai][bj][m][n] = __builtin_amdgcn_mfma_f32_16x16x32_f16(Bt[n][k], At[m][k], acc[ai][bj][m][n], 0, 0, 0); __builtin_amdgcn_s_setprio(0); } while (0)
#define PG8_WAIT_V(n) asm volatile("s_waitcnt vmcnt(" #n ")" ::: "memory")
#define PG8_WAIT_L(n) asm volatile("s_waitcnt lgkmcnt(" #n ")" ::: "memory")
#define PG8_BAR __builtin_amdgcn_s_barrier()
#define PG8_SCHED __builtin_amdgcn_sched_barrier(0)
    Unit cur, nxt; int ui = 0;
    if (!S.next(0, cur)) return;
    f32x4 acc[2][2][4][2];
#pragma unroll
    for (int a = 0; a < 2; ++a)
#pragma unroll
        for (int b = 0; b < 2; ++b)
#pragma unroll
            for (int m = 0; m < 4; ++m)
#pragma unroll
                for (int n = 0; n < 2; ++n) acc[a][b][m][n] = (f32x4){0.f, 0.f, 0.f, 0.f};
    h16x8 At[4][2], B0[2][2], B1[2][2];
    const char* cA = (const char*)g.A + (size_t)cur.pm * tstep; const char* cB = (const char*)g.Bt + (size_t)cur.pn * tstep;
    PG8_STAGE(PG8_SB(0, 0), cB, voffB); PG8_STAGE(PG8_SA(0, 0), cA, voffA); PG8_STAGE(PG8_SB(0, 1), cB + hstep, voffB); PG8_STAGE(PG8_SA(0, 1), cA + hstep, voffA);
    if (wr == 1) PG8_BAR;
    PG8_WAIT_V(4); PG8_BAR;
    PG8_STAGE(PG8_SB(1, 0), cB + kstep, voffB); PG8_STAGE(PG8_SA(1, 0), cA + kstep, voffA); PG8_STAGE(PG8_SB(1, 1), cB + hstep + kstep, voffB);
    PG8_WAIT_V(6); PG8_BAR;
    for (;;) {
        const bool has_next = S.next(ui + 1, nxt);
        const char* nA = has_next ? (const char*)g.A + (size_t)nxt.pm * tstep : cA; const char* nB = has_next ? (const char*)g.Bt + (size_t)nxt.pn * tstep : cB;
        for (int t = 0; t < nt; t += 2) {
            const bool last = (t == nt - 2);
            const char* a1 = cA + (size_t)(t + 1) * kstep;
            const char* a2 = last ? nA : cA + (size_t)(t + 2) * kstep; const char* b2 = last ? nB : cB + (size_t)(t + 2) * kstep;
            const char* a3 = a2 + kstep; const char* b3 = b2 + kstep;
            PG8_LDB(B0, 0, 0); PG8_SCHED; PG8_LDA(At, 0, 0); PG8_STAGE(PG8_SA(1, 1), a1 + hstep, voffA);
            PG8_WAIT_L(8); PG8_BAR; PG8_WAIT_L(0); PG8_MMA(0, 0, At, B0); PG8_BAR; PG8_SCHED;
            PG8_LDB(B1, 0, 1); PG8_STAGE(PG8_SB(0, 0), b2, voffB);
            PG8_BAR; PG8_WAIT_L(0); PG8_MMA(0, 1, At, B1); PG8_BAR;
            PG8_LDA(At, 0, 1); PG8_STAGE(PG8_SA(0, 0), a2, voffA);
            PG8_BAR; PG8_WAIT_L(0); PG8_MMA(1, 0, At, B0); PG8_BAR; PG8_SCHED;
            PG8_STAGE(PG8_SB(0, 1), b2 + hstep, voffB);
            PG8_WAIT_V(6); PG8_BAR; PG8_MMA(1, 1, At, B1); PG8_BAR;
            PG8_LDB(B0, 1, 0); PG8_SCHED; PG8_LDA(At, 1, 0); PG8_STAGE(PG8_SA(0, 1), a2 + hstep, voffA);
            PG8_WAIT_L(8); PG8_BAR; PG8_WAIT_L(0); PG8_MMA(0, 0, At, B0); PG8_BAR; PG8_SCHED;
            PG8_LDB(B1, 1, 1); PG8_STAGE(PG8_SB(1, 0), b3, voffB);
            PG8_BAR; PG8_WAIT_L(0); PG8_MMA(0, 1, At, B1); PG8_BAR;
            PG8_LDA(At, 1, 1); PG8_STAGE(PG8_SA(1, 0), a3, voffA);
            PG8_BAR; PG8_WAIT_L(0); PG8_MMA(1, 0, At, B0); PG8_BAR; PG8_SCHED;
            PG8_STAGE(PG8_SB(1, 1), b3 + hstep, voffB);
            PG8_WAIT_V(6); PG8_BAR; PG8_MMA(1, 1, At, B1); PG8_BAR;
        }
        E(acc, cur, wr, wc, fr, fq);
        if (!has_next) break;
#pragma unroll
        for (int a = 0; a < 2; ++a)
#pragma unroll
            for (int b = 0; b < 2; ++b)
#pragma unroll
                for (int m = 0; m < 4; ++m)
#pragma unroll
                    for (int n = 0; n < 2; ++n) acc[a][b][m][n] = (f32x4){0.f, 0.f, 0.f, 0.f};
        cur = nxt; cA = nA; cB = nB; ++ui;
    }
    PG8_WAIT_V(0);
    if (wr == 0) PG8_BAR;
    PG8_BAR;
#undef PG8_SA
#undef PG8_SB
#undef PG8_STAGE
#undef PG8_LDA
#undef PG8_LDB
#undef PG8_MMA
#undef PG8_WAIT_V
#undef PG8_WAIT_L
#undef PG8_BAR
#undef PG8_SCHED
}
}

constexpr int DM = 1024, TP = 2064, NPR = 8 * TP  , NR = NPR + 1024  , MP = 17664  , MT = 69;
constexpr int NTHREADS = 512, LDS_BYTES = pg8::STAGE_BYTES;
constexpr size_t UB = (size_t)MP * 1024 * 2;
constexpr size_t WS_WIN = 0;
constexpr size_t WS_WOUT = WS_WIN + (size_t)6400 * 1024 * 2;
constexpr size_t WS_WR = WS_WOUT + (size_t)1024 * 2048 * 2;
constexpr size_t WS_WL2 = WS_WR + (size_t)4608 * 1024 * 2;
constexpr size_t WS_WO = WS_WL2 + (size_t)2048 * 256 * 2;
constexpr size_t WS_WEND = WS_WO + (size_t)1024 * 1024 * 2;
static_assert(WS_WEND <= UB, "weights fit one unit");
constexpr size_t WS_X1 = 1 * UB;
constexpr size_t WS_QKVPRE = 3 * UB;
constexpr size_t WS_OBUF = 3 * UB;
constexpr size_t WS_UT = 1 * UB;
constexpr size_t WS_WW = 5 * UB;
constexpr size_t WS_AQ = 13 * UB;
constexpr size_t WS_XS = 3 * UB;
constexpr size_t WS_LOUT = 3 * UB;
constexpr size_t WS_X2 = 3 * UB;
constexpr size_t WS_YBUF = 3 * UB;
constexpr size_t WS_DB = 5 * UB;
constexpr size_t WS_KKB = 7 * UB;
constexpr size_t WS_BBB = 8 * UB;
constexpr size_t WS_Z = 7 * UB;
constexpr size_t WS_K2 = 13 * UB;
constexpr size_t WS_YG = 13 * UB;
constexpr size_t WS_QKV = 9 * UB;
constexpr size_t WS_OG = 9 * UB;
constexpr size_t WS_RKVZ = 9 * UB;
constexpr size_t WS_XN0 = 13 * UB;
constexpr size_t WS_BA = 14 * UB;
constexpr size_t WS_GB = WS_BA + (size_t)MP * 32 * 4;
constexpr size_t WS_LH = WS_GB + (size_t)MP * 32 * 4;
constexpr size_t WS_RK = WS_LH + (size_t)MP * 256 * 2;
constexpr size_t WS_GC = WS_RK + (size_t)MP * 16 * 4;
constexpr size_t WS_BAR = WS_GC + (size_t)4224 * 64 * 4;
constexpr size_t WS_END = WS_BAR + 16384;
constexpr int NCH = 33, NITEM = 128 * NCH;
constexpr size_t O_YP = 0, O_YS = 16777216, O_PG = 17825792, O_PGC = 19922944, O_PR = 20021248, O_PRS = 20545536, O_SG = 20553728, O_SGC = 54108160, O_SR = 55681024, O_SRS = 64069632;

struct TJob { const float* src; h16* dst; int srcK, srcN, dst_ld, row0, nrows, col0, ncols, tile0; };
struct Args {
    const float* in[29];
    float* out; unsigned char* ws;
    int ph_lo, ph_hi;
};
constexpr int NTILES_PREP = 3648;
enum { I_XP = 0, I_XS, I_SG, I_SGC, I_SR, I_SRS, I_META, I_NW, I_FNW, I_WIN, I_CW, I_ALOG, I_DTB, I_GNW, I_WOUT, I_MU, I_WRKVZ, I_W0, I_W1, I_W2, I_A0, I_A1, I_A2, I_KK, I_KA, I_RK, I_LNW, I_LNB, I_WO };

__device__ __forceinline__ float wave_sum(float v) {
#pragma unroll
    for (int o = 32; o > 0; o >>= 1) v += __shfl_xor(v, o);
    return v;
}
#define DPP_ADD(x, ctrl) ((x) + __builtin_bit_cast(float, __builtin_amdgcn_update_dpp(0, __builtin_bit_cast(int, (x)), (ctrl), 0xF, 0xF, true)))
__device__ __forceinline__ float red8(float x) { x = DPP_ADD(x, 0xB1); x = DPP_ADD(x, 0x4E); x = DPP_ADD(x, 0x141); return x; }
__device__ __forceinline__ float red16(float x) { x = DPP_ADD(x, 0xB1); x = DPP_ADD(x, 0x4E); x = DPP_ADD(x, 0x141); x = DPP_ADD(x, 0x140); return x; }
__device__ __forceinline__ float wsum(float x) { x = red16(x); x += __shfl_xor(x, 16); x += __shfl_xor(x, 32); return x; }
__device__ __forceinline__ float sq4(const f32x4 v) { return v[0] * v[0] + v[1] * v[1] + v[2] * v[2] + v[3] * v[3]; }
__device__ __forceinline__ float sigmoidf_(float x) { return 1.0f / (1.0f + expf(-x)); }
__device__ __forceinline__ float siluf_(float x) { return x / (1.0f + expf(-x)); }
__device__ __forceinline__ float softplusf_(float x) { return x > 20.0f ? x : log1pf(expf(x)); }
__device__ __forceinline__ void row_bt(int r, int& b, int& t, bool& samp) {
    if (r < NPR) { b = r / TP; t = r - b * TP; samp = false; } else { const int q = r - NPR; b = q >> 3; t = q & 7; samp = true; }
}
__device__ __forceinline__ const float* xrow(const Args& a, int r) {
    if (r < NPR) { const int b = r / TP, t = r - b * TP; return t < 16 ? a.in[I_META] + (size_t)t * DM : a.in[I_XP] + ((size_t)b * 2048 + (t - 16)) * DM; }
    return a.in[I_XS] + (size_t)(r - NPR) * DM;
}
__device__ __forceinline__ h16x8 pack8(const f32x4 v0, const f32x4 v1) {
    h16x8 w; w[0] = (h16)v0[0]; w[1] = (h16)v0[1]; w[2] = (h16)v0[2]; w[3] = (h16)v0[3]; w[4] = (h16)v1[0]; w[5] = (h16)v1[1]; w[6] = (h16)v1[2]; w[7] = (h16)v1[3]; return w;
}


#define XB_TMO      128
#define XB_XCNT(j)  (256  + 64 * (j))
#define XB_XSUB(j)  (1280 + 64 * (j))
#define XB_XGEN(j)  (2304 + 64 * (j))
#define XB_TOP      3328
#define XB_TOPGEN   3392
#define XCD_BAR_WORDS 3456
#define XB_SPIN_CAP (1u << 20)
__device__ __forceinline__ unsigned xb_ld(unsigned* p)              { return __hip_atomic_load(p, __ATOMIC_RELAXED, __HIP_MEMORY_SCOPE_AGENT); }
__device__ __forceinline__ unsigned xb_add(unsigned* p, unsigned v) { return __hip_atomic_fetch_add(p, v, __ATOMIC_RELAXED, __HIP_MEMORY_SCOPE_AGENT); }
__device__ __forceinline__ unsigned xb_xcc_id() { return (unsigned)__builtin_amdgcn_s_getreg((3 << 11) | 20) & 0xFu; }
#define XB_SPIN(cond, bar) do { unsigned _sp = 0; while (cond) { __builtin_amdgcn_s_sleep(1); \
    if ((++_sp & 255u) == 0u) { if (xb_ld(&(bar)[XB_TMO])) break; if (_sp > XB_SPIN_CAP) { atomicAdd(&(bar)[XB_TMO], 1u); break; } } } } while (0)
struct XcdBarrier { unsigned* bar; unsigned x; volatile PG8_LAS unsigned* st; };
__device__ __forceinline__ XcdBarrier xcd_barrier_post(unsigned* bar, volatile PG8_LAS unsigned* st) {
    XcdBarrier b; b.bar = bar; b.x = xb_xcc_id(); b.st = st;
    if (threadIdx.x == 0) (void)xb_add(&bar[XB_XCNT(b.x)], 1u);
    return b;
}
__device__ __forceinline__ void xcd_barrier_complete(unsigned* bar, unsigned x, unsigned& nloc, unsigned& nx) {
    const unsigned G = gridDim.x * gridDim.y * gridDim.z;
    unsigned sum, cnt, mine, sp = 0u;
    for (;;) {
        sum = 0u; cnt = 0u; mine = 0u;
#pragma unroll
        for (unsigned j = 0; j < 16; ++j) { const unsigned c = xb_ld(&bar[XB_XCNT(j)]); sum += c; cnt += (c > 0u) ? 1u : 0u; mine = (j == x) ? c : mine; }
        if (sum == G) break;
        __builtin_amdgcn_s_sleep(1);
        if ((++sp & 255u) == 0u) { if (xb_ld(&bar[XB_TMO])) break; if (sp > XB_SPIN_CAP) { atomicAdd(&bar[XB_TMO], 1u); break; } }
    }
    nloc = mine > 0u ? mine : 1u; nx = cnt > 0u ? cnt : 1u;
}
__device__ __forceinline__ void xcd_barrier(const XcdBarrier& b) {
    asm volatile("s_waitcnt vmcnt(0)" ::: "memory");
    __syncthreads();
    if (threadIdx.x == 0) {
        unsigned* bar = b.bar;
        __builtin_amdgcn_s_waitcnt(0);
        unsigned nloc = b.st[0], nx = b.st[1];
        if (nloc == 0u) { xcd_barrier_complete(bar, b.x, nloc, nx); b.st[0] = nloc; b.st[1] = nx; }
        const unsigned old = xb_add(&bar[XB_XSUB(b.x)], 1u);
        const unsigned gen = old / nloc;
        if (old + 1u == (gen + 1u) * nloc) {
            __builtin_amdgcn_fence(__ATOMIC_RELEASE, "agent");
            asm volatile("s_waitcnt vmcnt(0)" ::: "memory");
            const unsigned og = xb_add(&bar[XB_TOP], 1u);
            const unsigned tg = og / nx;
            if (og + 1u == (tg + 1u) * nx) xb_add(&bar[XB_TOPGEN], 1u);
            else XB_SPIN(xb_ld(&bar[XB_TOPGEN]) == tg, bar);
            __builtin_amdgcn_fence(__ATOMIC_ACQUIRE, "agent");
            xb_add(&bar[XB_XGEN(b.x)], 1u);
            asm volatile("s_waitcnt vmcnt(0)" ::: "memory");
        } else {
            XB_SPIN(xb_ld(&bar[XB_XGEN(b.x)]) == gen, bar);
            __builtin_amdgcn_fence(__ATOMIC_ACQUIRE, "agent");
            asm volatile("s_waitcnt vmcnt(0)" ::: "memory");
        }
    }
    __syncthreads();
}

__device__ __forceinline__ void phase_prep(const Args& a, float* ldsf) {
    const int tid = threadIdx.x, lane = tid & 63, wid = tid >> 6;
    for (int tile = blockIdx.x; tile < NTILES_PREP; tile += gridDim.x) {
        TJob jb;
        { h16* Win = (h16*)(a.ws + WS_WIN); h16* Wout = (h16*)(a.ws + WS_WOUT); h16* Wr = (h16*)(a.ws + WS_WR); h16* Wl2 = (h16*)(a.ws + WS_WL2); h16* Wo = (h16*)(a.ws + WS_WO);
          if (tile < 1600)      jb = TJob{a.in[I_WIN], Win, 1024, 6176, 1024, 0, 6400, 0, 1024, 0};
          else if (tile < 2112) jb = TJob{a.in[I_WOUT], Wout, 2048, 1024, 2048, 0, 1024, 0, 2048, 1600};
          else if (tile < 3136) { const int s = (tile - 2112) >> 8; jb = TJob{a.in[I_WRKVZ] + (size_t)s * 1024 * 1024, Wr, 1024, 1024, 1024, s * 1024, 1024, 0, 1024, 2112 + s * 256}; }
          else if (tile < 3200) jb = TJob{a.in[I_W1], Wr, 1024, 64, 1024, 4096, 256, 0, 1024, 3136};
          else if (tile < 3264) jb = TJob{a.in[I_A1], Wr, 1024, 64, 1024, 4352, 256, 0, 1024, 3200};
          else if (tile < 3328) jb = TJob{a.in[I_W2], Wl2, 64, 1024, 256, 0, 1024, 0, 256, 3264};
          else if (tile < 3392) jb = TJob{a.in[I_A2], Wl2, 64, 1024, 256, 1024, 1024, 64, 256, 3328};
          else                  jb = TJob{a.in[I_WO], Wo, 1024, 1024, 1024, 0, 1024, 0, 1024, 3392}; }
        const int lt = tile - jb.tile0, nck = jb.ncols >> 6, tn = lt / nck, tk = lt - tn * nck;
        __syncthreads();
#pragma unroll
        for (int e = 0; e < 8; ++e) {
            const int idx = e * 512 + tid, kk = idx >> 6, nn = idx & 63;
            const int ks = tk * 64 + kk - jb.col0, ns = tn * 64 + nn;
            float v = 0.f;
            if (ks >= 0 && ks < jb.srcK && ns < jb.srcN) v = jb.src[(size_t)ks * jb.srcN + ns];
            ldsf[kk * 65 + nn] = v;
        }
        __syncthreads();
#pragma unroll
        for (int e = 0; e < 8; ++e) {
            const int idx = e * 512 + tid, nn = idx >> 6, kk = idx & 63;
            jb.dst[(size_t)(jb.row0 + tn * 64 + nn) * jb.dst_ld + tk * 64 + kk] = (h16)ldsf[kk * 65 + nn];
        }
    }
    h16* xn0 = (h16*)(a.ws + WS_XN0);
    const float* nw = a.in[I_NW];
    for (int row = blockIdx.x * 8 + wid; row < MP; row += gridDim.x * 8) {
        h16* op = xn0 + (size_t)row * DM;
        if (row >= NR) {
#pragma unroll
            for (int i = 0; i < 4; ++i) *(h16x4*)(op + i * 256 + lane * 4) = (h16x4){(h16)0.f, (h16)0.f, (h16)0.f, (h16)0.f};
            continue;
        }
        const float* xp = xrow(a, row);
        f32x4 v[4]; float ss = 0.f;
#pragma unroll
        for (int i = 0; i < 4; ++i) { v[i] = *(const f32x4*)(xp + i * 256 + lane * 4); ss += v[i][0] * v[i][0] + v[i][1] * v[i][1] + v[i][2] * v[i][2] + v[i][3] * v[i][3]; }
        ss = wave_sum(ss);
        const float sc = rsqrtf(ss * (1.0f / 1024.0f) + 1e-6f);
#pragma unroll
        for (int i = 0; i < 4; ++i) { const f32x4 w = *(const f32x4*)(nw + i * 256 + lane * 4); h16x4 o;
#pragma unroll
            for (int j = 0; j < 4; ++j) o[j] = (h16)(v[i][j] * sc * w[j]);
            *(h16x4*)(op + i * 256 + lane * 4) = o; }
    }
}

struct EpiProj {
    static constexpr bool PERM = true;
    h16* qkv; h16* z; float* ba;
    __device__ __forceinline__ void operator()(const f32x4 (&acc)[2][2][4][2], const pg8::Unit& u, int wr, int wc, int fr, int fq) const {
        const int row0 = u.pm * 256 + wr * 64 + fr;
        if (u.pn < 24) {
            h16* base = u.pn < 16 ? qkv : z; const int ld = u.pn < 16 ? 4096 : 2048; const int col0 = (u.pn < 16 ? u.pn : u.pn - 16) * 256 + wc * 32 + 8 * fq;
#pragma unroll
            for (int ai = 0; ai < 2; ++ai)
#pragma unroll
                for (int m = 0; m < 4; ++m) { h16* rowp = base + (size_t)(row0 + ai * 128 + m * 16) * ld + col0;
#pragma unroll
                    for (int bj = 0; bj < 2; ++bj) *(h16x8*)(rowp + bj * 128) = pack8(acc[ai][bj][m][0], acc[ai][bj][m][1]); }
        } else if (wc == 0) {
#pragma unroll
            for (int ai = 0; ai < 2; ++ai)
#pragma unroll
                for (int m = 0; m < 4; ++m) { float* rowp = ba + (size_t)(row0 + ai * 128 + m * 16) * 32 + 8 * fq;
                    *(f32x4*)rowp = acc[ai][0][m][0]; *(f32x4*)(rowp + 4) = acc[ai][0][m][1]; }
        }
    }
};
struct EpiH16 {
    static constexpr bool PERM = true;
    h16* O; int ld;
    __device__ __forceinline__ void operator()(const f32x4 (&acc)[2][2][4][2], const pg8::Unit& u, int wr, int wc, int fr, int fq) const {
        const int row0 = u.pm * 256 + wr * 64 + fr, col0 = u.pn * 256 + wc * 32 + 8 * fq;
#pragma unroll
        for (int ai = 0; ai < 2; ++ai)
#pragma unroll
            for (int m = 0; m < 4; ++m) { h16* rowp = O + (size_t)(row0 + ai * 128 + m * 16) * ld + col0;
#pragma unroll
                for (int bj = 0; bj < 2; ++bj) *(h16x8*)(rowp + bj * 128) = pack8(acc[ai][bj][m][0], acc[ai][bj][m][1]); }
    }
};
struct EpiResX {
    static constexpr bool PERM = false;
    const float* meta; const float* xpr; const float* xsm; float* O;
    __device__ __forceinline__ void operator()(const f32x4 (&acc)[2][2][4][2], const pg8::Unit& u, int wr, int wc, int fr, int fq) const {
        const int row0 = u.pm * 256 + wr * 64 + fr, col0 = u.pn * 256 + wc * 32 + 4 * fq;
#pragma unroll
        for (int ai = 0; ai < 2; ++ai)
#pragma unroll
            for (int m = 0; m < 4; ++m) { const int row = row0 + ai * 128 + m * 16; if (row >= NR) continue;
                const float* xp;
                if (row < NPR) { const int b = row / TP, t = row - b * TP; xp = t < 16 ? meta + (size_t)t * DM : xpr + ((size_t)b * 2048 + (t - 16)) * DM; } else xp = xsm + (size_t)(row - NPR) * DM;
                xp += col0; float* rowp = O + (size_t)row * DM + col0;
#pragma unroll
                for (int bj = 0; bj < 2; ++bj)
#pragma unroll
                    for (int n = 0; n < 2; ++n) *(f32x4*)(rowp + bj * 128 + n * 16) = *(const f32x4*)(xp + bj * 128 + n * 16) + acc[ai][bj][m][n]; }
    }
};
struct EpiResB {
    static constexpr bool PERM = false;
    const float* base; float* O;
    __device__ __forceinline__ void operator()(const f32x4 (&acc)[2][2][4][2], const pg8::Unit& u, int wr, int wc, int fr, int fq) const {
        const int row0 = u.pm * 256 + wr * 64 + fr, col0 = u.pn * 256 + wc * 32 + 4 * fq;
#pragma unroll
        for (int ai = 0; ai < 2; ++ai)
#pragma unroll
            for (int m = 0; m < 4; ++m) { const int row = row0 + ai * 128 + m * 16; if (row >= NR) continue;
                const float* xp = base + (size_t)row * DM + col0; float* rowp = O + (size_t)row * DM + col0;
#pragma unroll
                for (int bj = 0; bj < 2; ++bj)
#pragma unroll
                    for (int n = 0; n < 2; ++n) *(f32x4*)(rowp + bj * 128 + n * 16) = *(const f32x4*)(xp + bj * 128 + n * 16) + acc[ai][bj][m][n]; }
    }
};
struct EpiG {
    static constexpr bool PERM = true;
    h16* rkvz; h16* lh;
    __device__ __forceinline__ void operator()(const f32x4 (&acc)[2][2][4][2], const pg8::Unit& u, int wr, int wc, int fr, int fq) const {
        const int s = u.pm / MT, i = u.pm - s * MT, row0 = i * 256 + wr * 64 + fr;
        if (s < 4) {
            h16* base = rkvz + (size_t)s * MP * 1024; const int col0 = (u.pn - 4 * s) * 256 + wc * 32 + 8 * fq;
#pragma unroll
            for (int ai = 0; ai < 2; ++ai)
#pragma unroll
                for (int m = 0; m < 4; ++m) { h16* rowp = base + (size_t)(row0 + ai * 128 + m * 16) * 1024 + col0;
#pragma unroll
                    for (int bj = 0; bj < 2; ++bj) *(h16x8*)(rowp + bj * 128) = pack8(acc[ai][bj][m][0], acc[ai][bj][m][1]); }
        } else if (wc < 2) {
            const int cb = (s == 4 ? 0 : 64) + wc * 32 + 8 * fq;
#pragma unroll
            for (int ai = 0; ai < 2; ++ai)
#pragma unroll
                for (int m = 0; m < 4; ++m) { h16* rowp = lh + (size_t)(row0 + ai * 128 + m * 16) * 256;
                    f32x4 v0 = acc[ai][0][m][0], v1 = acc[ai][0][m][1];
                    if (s == 4) {
#pragma unroll
                        for (int j = 0; j < 4; ++j) { v0[j] = tanhf(v0[j]); v1[j] = tanhf(v1[j]); } }
                    *(h16x8*)(rowp + cb) = pack8(v0, v1);
                    *(h16x8*)(rowp + 128 + cb) = pack8((f32x4){0.f, 0.f, 0.f, 0.f}, (f32x4){0.f, 0.f, 0.f, 0.f}); }
        }
    }
};
struct OrderG {
    pg8::StaticOrder so; int G, c;
    __device__ void init(int G_, int c_) { so.init(4 * MT * 256, 1024, G_, c_); G = G_; c = c_; }
    __device__ bool next(int i, pg8::Unit& u) const {
        long L = (long)i * G + c;
        if (L < 4 * MT * 4) { pg8::Unit v; so.next(i, v); u.pm = v.pm; u.pn = (v.pm / MT) * 4 + v.pn; return true; }
        L -= 4 * MT * 4; if (L >= 2 * MT) return false;
        const int s = 4 + (int)(L / MT), ii = (int)(L % MT); u.pm = s * MT + ii; u.pn = 12 + s; return true;
    }
};

__device__ __forceinline__ void phase_conv(const Args& a, float* ldsf) {
    const int tid = threadIdx.x, lane = tid & 63, wid = tid >> 6;
    const h16* pre = (const h16*)(a.ws + WS_QKVPRE); h16* qkv = (h16*)(a.ws + WS_QKV);
    const float* ba = (const float*)(a.ws + WS_BA); float* gb = (float*)(a.ws + WS_GB);
    const float* cst = a.in[I_SGC];
    for (int i = tid; i < 4096; i += NTHREADS) { const f32x4 w = *(const f32x4*)(a.in[I_CW] + (size_t)i * 4); ldsf[i] = w[0]; ldsf[4096 + i] = w[1]; ldsf[8192 + i] = w[2]; ldsf[12288 + i] = w[3]; }
    __syncthreads();
    for (int row = blockIdx.x * 8 + wid; row < NR; row += gridDim.x * 8) {
        int b, t; bool samp; row_bt(row, b, t, samp);
        for (int half = 0; half < 2; ++half) {
            h16x8 x[4][4];
#pragma unroll
            for (int sg = 0; sg < 4; ++sg) {
                const int c0 = (half * 4 + sg) * 512 + lane * 8;
#pragma unroll
                for (int jj = 0; jj < 4; ++jj) {
                    const int idx = t + jj;
                    if (idx >= 3) x[sg][jj] = *(const h16x8*)(pre + (size_t)(row - 3 + jj) * 4096 + c0);
                    else if (samp) { const float* bp = cst + ((size_t)b * 3 + idx) * 4096 + c0; const f32x4 p0 = *(const f32x4*)bp, p1 = *(const f32x4*)(bp + 4); x[sg][jj] = pack8(p0, p1); }
                    else x[sg][jj] = pack8((f32x4){0.f, 0.f, 0.f, 0.f}, (f32x4){0.f, 0.f, 0.f, 0.f});
                }
            }
#pragma unroll
            for (int sg = 0; sg < 4; ++sg) {
                const int seg = half * 4 + sg, c0 = seg * 512 + lane * 8;
                float y[8];
#pragma unroll
                for (int j = 0; j < 8; ++j) y[j] = 0.f;
#pragma unroll
                for (int jj = 0; jj < 4; ++jj) { const f32x4 w0 = *(const f32x4*)(ldsf + jj * 4096 + c0), w1 = *(const f32x4*)(ldsf + jj * 4096 + c0 + 4);
#pragma unroll
                    for (int j = 0; j < 4; ++j) { y[j] += (float)x[sg][jj][j] * w0[j]; y[4 + j] += (float)x[sg][jj][4 + j] * w1[j]; } }
                float ss = 0.f;
#pragma unroll
                for (int j = 0; j < 8; ++j) { y[j] = siluf_(y[j]); ss += y[j] * y[j]; }
                float sc = 1.0f;
                if (seg < 4) { ss = red16(ss); sc = rsqrtf(ss + 1e-6f) * (seg < 2 ? 0.08838834764831845f : 1.0f); }
                h16x8 o;
#pragma unroll
                for (int j = 0; j < 8; ++j) o[j] = (h16)(y[j] * sc);
                *(h16x8*)(qkv + (size_t)row * 4096 + c0) = o;
                float* cso = nullptr;
                if (!samp && t >= TP - 3) cso = a.out + O_PGC + ((size_t)b * 3 + (t - (TP - 3))) * 4096 + c0;
                if (samp && t >= 5) cso = a.out + O_SGC + ((size_t)b * 3 + (t - 5)) * 4096 + c0;
                if (cso) { const h16x8 u = x[sg][3]; *(f32x4*)cso = (f32x4){(float)u[0], (float)u[1], (float)u[2], (float)u[3]}; *(f32x4*)(cso + 4) = (f32x4){(float)u[4], (float)u[5], (float)u[6], (float)u[7]}; }
            }
        }
        if (lane < 16) {
            const float bv = ba[(size_t)row * 32 + lane], av = ba[(size_t)row * 32 + 16 + lane];
            gb[(size_t)row * 32 + lane] = sigmoidf_(bv);
            gb[(size_t)row * 32 + 16 + lane] = -expf(a.in[I_ALOG][lane]) * softplusf_(av + a.in[I_DTB][lane]);
        }
    }
}

__device__ __forceinline__ void phase_gdn_scan(const Args& a, float* ldsf) {
    const int tid = threadIdx.x;
    const int vl = tid >> 3, kq = tid & 7;
    const h16* qkv = (const h16*)(a.ws + WS_QKV); const float* gb = (const float*)(a.ws + WS_GB); h16* obuf = (h16*)(a.ws + WS_OBUF);
    const int stt = tid >> 6, sp = tid & 63;
    for (int it = 256 + blockIdx.x; it < 256 + 4096; it += gridDim.x) {
        const bool samp = it >= 256; const int q = samp ? it - 256 : it;
        const int seq = q >> 1, vhalf = q & 1, b = seq >> 4, hv = seq & 15, hq = hv >> 1;
        const int T = samp ? 8 : TP, row0 = samp ? NPR + b * 8 : b * TP;
        const int v = vhalf * 64 + vl;
        float S[16];
        if (samp) { const float* spp = a.in[I_SG] + ((size_t)(b * 16 + hv) * 128 + kq * 16) * 128 + v;
#pragma unroll
            for (int i = 0; i < 16; ++i) S[i] = spp[(size_t)i * 128]; }
        else {
#pragma unroll
            for (int i = 0; i < 16; ++i) S[i] = 0.f; }
        h16x4 pqk; h16 pv; float pg = 0.f, pb = 0.f;
        { const h16* rp = qkv + (size_t)(row0 + stt) * 4096;
          pqk = *(const h16x4*)(rp + (sp < 32 ? hq * 128 + sp * 4 : 1024 + hq * 128 + (sp - 32) * 4)); pv = rp[2048 + hv * 128 + vhalf * 64 + sp];
          if (tid < 8) { pb = gb[(size_t)(row0 + tid) * 32 + hv]; pg = gb[(size_t)(row0 + tid) * 32 + 16 + hv]; } }
        __syncthreads();
        int cur = 0;
        for (int t0 = 0; t0 < T; t0 += 8) {
            float* Lb = ldsf + cur * 2576;
            *(f32x4*)(Lb + (sp < 32 ? 0 : 1024) + stt * 128 + (sp & 31) * 4) = (f32x4){(float)pqk[0], (float)pqk[1], (float)pqk[2], (float)pqk[3]};
            Lb[2048 + stt * 64 + sp] = (float)pv;
            if (tid < 8) { Lb[2560 + tid] = expf(pg); Lb[2568 + tid] = pb; }
            __syncthreads();
            if (t0 + 8 < T) { const h16* rp = qkv + (size_t)(row0 + t0 + 8 + stt) * 4096;
                pqk = *(const h16x4*)(rp + (sp < 32 ? hq * 128 + sp * 4 : 1024 + hq * 128 + (sp - 32) * 4)); pv = rp[2048 + hv * 128 + vhalf * 64 + sp];
                if (tid < 8) { pb = gb[(size_t)(row0 + t0 + 8 + tid) * 32 + hv]; pg = gb[(size_t)(row0 + t0 + 8 + tid) * 32 + 16 + hv]; } }
#pragma unroll 2
            for (int tt = 0; tt < 8; ++tt) {
                const float al = Lb[2560 + tt], be = Lb[2568 + tt], vv = Lb[2048 + tt * 64 + vl];
                const f32x4* kp = (const f32x4*)(Lb + 1024 + tt * 128 + kq * 16); const f32x4* qp = (const f32x4*)(Lb + tt * 128 + kq * 16);
                float kr[16];
                float dot = 0.f;
#pragma unroll
                for (int i = 0; i < 4; ++i) { const f32x4 kv = kp[i]; kr[4 * i] = kv[0]; kr[4 * i + 1] = kv[1]; kr[4 * i + 2] = kv[2]; kr[4 * i + 3] = kv[3]; }
#pragma unroll
                for (int i = 0; i < 16; ++i) dot += kr[i] * S[i];
                dot = red8(dot);
                const float c = be * (vv - al * dot);
                float od = 0.f;
#pragma unroll
                for (int i = 0; i < 4; ++i) { const f32x4 qv = qp[i];
#pragma unroll
                    for (int j = 0; j < 4; ++j) { const float s = al * S[4 * i + j] + kr[4 * i + j] * c; S[4 * i + j] = s; od += qv[j] * s; } }
                od = red8(od);
                if (kq == 0) obuf[(size_t)(row0 + t0 + tt) * 2048 + hv * 128 + v] = (h16)od;
            }
            cur ^= 1;
        }
        float* so = a.out + (samp ? O_SG : O_PG) + ((size_t)(b * 16 + hv) * 128 + kq * 16) * 128 + v;
#pragma unroll
        for (int i = 0; i < 16; ++i) so[(size_t)i * 128] = S[i];
    }
}

__device__ __forceinline__ void phase_gdn_pre(const Args& a, float* ldsf) {
    const int tid = threadIdx.x, hb = tid >> 8, ht = tid & 255, hw = ht >> 6, l = tid & 63, lr = l & 15, lq = l >> 4;
    const h16* qkv = (const h16*)(a.ws + WS_QKV); const float* gb = (const float*)(a.ws + WS_GB);
    h16* UT = (h16*)(a.ws + WS_UT); h16* WW = (h16*)(a.ws + WS_WW); h16* AQ = (h16*)(a.ws + WS_AQ); float* GC = (float*)(a.ws + WS_GC);
    float* Am = ldsf + hb * 4352;
    float* gs = Am + 4096, *bs = Am + 4160, *gcs = Am + 4224;
    const int niter = (NITEM + gridDim.x * 2 - 1) / (gridDim.x * 2);
    for (int n = 0; n < niter; ++n) {
        const int itm = (n * gridDim.x + blockIdx.x) * 2 + hb;
        const bool valid = itm < NITEM;
        const int seq = valid ? itm / NCH : 0, c = valid ? itm - seq * NCH : 0, b = seq >> 4, hv = seq & 15, hq = hv >> 1;
        const int rowb = b * TP + 64 * c, nval = (TP - 64 * c) < 64 ? (TP - 64 * c) : 64;
        __syncthreads();
        if (valid && ht < 64) { const bool ok = ht < nval; gs[ht] = ok ? gb[(size_t)(rowb + ht) * 32 + 16 + hv] : 0.f; bs[ht] = ok ? gb[(size_t)(rowb + ht) * 32 + hv] : 0.f; }
        __syncthreads();
        if (valid && ht < 64) { float s = 0.f; for (int j = 0; j <= ht; ++j) s += gs[j]; gcs[ht] = s; GC[(size_t)itm * 64 + ht] = s; }
        __syncthreads();
        if (valid) {
            const int ib = hw;
            h16x8 ak[4], aq[4];
#pragma unroll
            for (int ks = 0; ks < 4; ++ks) { const h16* rp = qkv + (size_t)(rowb + 16 * ib + lr) * 4096 + hq * 128 + 32 * ks + 8 * lq; aq[ks] = *(const h16x8*)rp; ak[ks] = *(const h16x8*)(rp + 1024); }
            float gci[4], bei[4];
#pragma unroll
            for (int r = 0; r < 4; ++r) { gci[r] = gcs[16 * ib + 4 * lq + r]; bei[r] = bs[16 * ib + 4 * lq + r]; }
            for (int jb = 0; jb < 4; ++jb) {
                h16* aqp = AQ + (size_t)itm * 4096 + (size_t)(16 * ib + 4 * lq) * 64 + 16 * jb + lr;
                if (jb > ib) {
#pragma unroll
                    for (int r = 0; r < 4; ++r) aqp[r * 64] = (h16)0.f;
                    continue;
                }
                f32x4 ckk = (f32x4){0.f, 0.f, 0.f, 0.f}, cqk = (f32x4){0.f, 0.f, 0.f, 0.f};
#pragma unroll
                for (int ks = 0; ks < 4; ++ks) { const h16x8 bk = *(const h16x8*)(qkv + (size_t)(rowb + 16 * jb + lr) * 4096 + 1024 + hq * 128 + 32 * ks + 8 * lq);
                    ckk = __builtin_amdgcn_mfma_f32_16x16x32_f16(ak[ks], bk, ckk, 0, 0, 0); cqk = __builtin_amdgcn_mfma_f32_16x16x32_f16(aq[ks], bk, cqk, 0, 0, 0); }
                const int j = 16 * jb + lr; const float gcj = gcs[j];
#pragma unroll
                for (int r = 0; r < 4; ++r) { const int i = 16 * ib + 4 * lq + r; const float dec = expf(gci[r] - gcj);
                    Am[i * 64 + j] = (j < i) ? bei[r] * ckk[r] * dec : 0.f;
                    aqp[r * 64] = (h16)((j <= i) ? cqk[r] * dec : 0.f); }
            }
        }
        __syncthreads();
        if (valid) {
            float x[64];
            if (ht < 128) { const h16* vp = qkv + (size_t)rowb * 4096 + 2048 + hv * 128 + ht;
#pragma unroll
                for (int i = 0; i < 64; ++i) x[i] = (float)vp[(size_t)i * 4096] * bs[i]; }
            else { const h16* kp = qkv + (size_t)rowb * 4096 + 1024 + hq * 128 + (ht - 128);
#pragma unroll
                for (int i = 0; i < 64; ++i) x[i] = (float)kp[(size_t)i * 4096] * bs[i] * expf(gcs[i]); }
#pragma unroll
            for (int i = 1; i < 64; ++i) {
                float acc = x[i];
#pragma unroll
                for (int j4 = 0; j4 < (i + 3) / 4; ++j4) { const f32x4 av = *(const f32x4*)(Am + i * 64 + 4 * j4);
#pragma unroll
                    for (int jj = 0; jj < 4; ++jj) if (4 * j4 + jj < i) acc -= av[jj] * x[4 * j4 + jj]; }
                x[i] = acc;
            }
            if (ht < 128) { h16* up = UT + (size_t)itm * 8192 + (size_t)ht * 64;
#pragma unroll
                for (int i8 = 0; i8 < 8; ++i8) { h16x8 o;
#pragma unroll
                    for (int jj = 0; jj < 8; ++jj) o[jj] = (h16)x[8 * i8 + jj];
                    *(h16x8*)(up + 8 * i8) = o; } }
            else { h16* wp = WW + (size_t)itm * 8192 + (ht - 128);
#pragma unroll
                for (int i = 0; i < 64; ++i) wp[(size_t)i * 128] = (h16)x[i]; }
        }
    }
}

__device__ __forceinline__ void phase_gdn_chunk_scan(const Args& a, unsigned char* smem) {
    const int tid = threadIdx.x, wid = tid >> 6, l = tid & 63, lr = l & 15, lq = l >> 4;
    const int ib = wid & 3, vp = wid >> 2;
    const h16* qkv = (const h16*)(a.ws + WS_QKV);
    const h16* UT = (const h16*)(a.ws + WS_UT); const h16* WW = (const h16*)(a.ws + WS_WW); const h16* AQ = (const h16*)(a.ws + WS_AQ); const float* GC = (const float*)(a.ws + WS_GC);
    h16* obuf = (h16*)(a.ws + WS_OBUF);
    h16* ST = (h16*)smem;
    h16* vnT = ST + 64 * 136;
    h16* vsT = vnT + 64 * 72;
    h16* kT = vsT + 64 * 72;
    for (int it = blockIdx.x; it < 256; it += gridDim.x) {
        const int seq = it >> 1, vhalf = it & 1, b = seq >> 4, hv = seq & 15, hq = hv >> 1, v0 = vhalf * 64;
        __syncthreads();
        for (int e = tid; e < 64 * 136 / 8; e += NTHREADS) *(h16x8*)(ST + e * 8) = pack8((f32x4){0.f, 0.f, 0.f, 0.f}, (f32x4){0.f, 0.f, 0.f, 0.f});
        f32x4 Sacc[4];
#pragma unroll
        for (int vt = 0; vt < 4; ++vt) Sacc[vt] = (f32x4){0.f, 0.f, 0.f, 0.f};
        h16x8 wf[4], qf[4], af[2], ks0, ks1; h16x4 ut[2]; f32x4 gcr; float gl;
        const int si = tid >> 3, skg = tid & 7;
#define GDN_LOAD(c) do { const int itm_ = seq * NCH + (c); const int rowb_ = b * TP + 64 * (c); \
            _Pragma("unroll") for (int ks = 0; ks < 4; ++ks) { wf[ks] = *(const h16x8*)(WW + (size_t)itm_ * 8192 + (size_t)(16 * ib + lr) * 128 + 32 * ks + 8 * lq); \
                qf[ks] = *(const h16x8*)(qkv + (size_t)(rowb_ + 16 * ib + lr) * 4096 + hq * 128 + 32 * ks + 8 * lq); } \
            _Pragma("unroll") for (int k2 = 0; k2 < 2; ++k2) af[k2] = *(const h16x8*)(AQ + (size_t)itm_ * 4096 + (size_t)(16 * ib + lr) * 64 + 32 * k2 + 8 * lq); \
            _Pragma("unroll") for (int vt = 0; vt < 2; ++vt) ut[vt] = *(const h16x4*)(UT + (size_t)itm_ * 8192 + (size_t)(v0 + 16 * (2 * vp + vt) + lr) * 64 + 16 * ib + 4 * lq); \
            gcr = *(const f32x4*)(GC + (size_t)itm_ * 64 + 16 * ib + 4 * lq); gl = GC[(size_t)itm_ * 64 + 63]; \
            { const h16* kp_ = qkv + (size_t)(rowb_ + si) * 4096 + 1024 + hq * 128 + 16 * skg; ks0 = *(const h16x8*)kp_; ks1 = *(const h16x8*)(kp_ + 8); } } while (0)
        GDN_LOAD(0);
        for (int c = 0; c < NCH; ++c) {
            const int rowb = b * TP + 64 * c, nval = (TP - 64 * c) < 64 ? (TP - 64 * c) : 64;
            __syncthreads();
#pragma unroll
            for (int jj = 0; jj < 8; ++jj) { kT[(16 * skg + jj) * 72 + si] = ks0[jj]; kT[(16 * skg + 8 + jj) * 72 + si] = ks1[jj]; }
            f32x4 c1[2], c2[2];
#pragma unroll
            for (int vt = 0; vt < 2; ++vt) { c1[vt] = (f32x4){0.f, 0.f, 0.f, 0.f}; c2[vt] = (f32x4){0.f, 0.f, 0.f, 0.f}; }
#pragma unroll
            for (int vt = 0; vt < 2; ++vt)
#pragma unroll
                for (int ks = 0; ks < 4; ++ks) { const h16x8 bf = *(const h16x8*)(ST + (16 * (2 * vp + vt) + lr) * 136 + 32 * ks + 8 * lq);
                    c1[vt] = __builtin_amdgcn_mfma_f32_16x16x32_f16(wf[ks], bf, c1[vt], 0, 0, 0); c2[vt] = __builtin_amdgcn_mfma_f32_16x16x32_f16(qf[ks], bf, c2[vt], 0, 0, 0); }
            const float egl = expf(gl);
            f32x4 eg, es;
#pragma unroll
            for (int r = 0; r < 4; ++r) { eg[r] = expf(gcr[r]); es[r] = expf(gl - gcr[r]); }
#pragma unroll
            for (int vt = 0; vt < 2; ++vt) { h16x4 vn, vs;
#pragma unroll
                for (int r = 0; r < 4; ++r) { const float x = (float)ut[vt][r] - c1[vt][r]; vn[r] = (h16)x; vs[r] = (h16)(x * es[r]); }
                *(h16x4*)(vnT + (16 * (2 * vp + vt) + lr) * 72 + 16 * ib + 4 * lq) = vn; *(h16x4*)(vsT + (16 * (2 * vp + vt) + lr) * 72 + 16 * ib + 4 * lq) = vs; }
            const h16x8 afc0 = af[0], afc1 = af[1];
            __syncthreads();
            if (c + 1 < NCH) GDN_LOAD(c + 1);
#pragma unroll
            for (int vt = 0; vt < 2; ++vt) {
                f32x4 c3 = (f32x4){0.f, 0.f, 0.f, 0.f};
                c3 = __builtin_amdgcn_mfma_f32_16x16x32_f16(afc0, *(const h16x8*)(vnT + (16 * (2 * vp + vt) + lr) * 72 + 8 * lq), c3, 0, 0, 0);
                c3 = __builtin_amdgcn_mfma_f32_16x16x32_f16(afc1, *(const h16x8*)(vnT + (16 * (2 * vp + vt) + lr) * 72 + 32 + 8 * lq), c3, 0, 0, 0);
#pragma unroll
                for (int r = 0; r < 4; ++r) { const int i = 16 * ib + 4 * lq + r;
                    if (i < nval) obuf[(size_t)(rowb + i) * 2048 + hv * 128 + v0 + 16 * (2 * vp + vt) + lr] = (h16)(eg[r] * c2[vt][r] + c3[r]); }
            }
            const h16x8 ka0 = *(const h16x8*)(kT + (16 * wid + lr) * 72 + 8 * lq), ka1 = *(const h16x8*)(kT + (16 * wid + lr) * 72 + 32 + 8 * lq);
#pragma unroll
            for (int vt = 0; vt < 4; ++vt) {
                Sacc[vt] = Sacc[vt] * egl;
                Sacc[vt] = __builtin_amdgcn_mfma_f32_16x16x32_f16(ka0, *(const h16x8*)(vsT + (16 * vt + lr) * 72 + 8 * lq), Sacc[vt], 0, 0, 0);
                Sacc[vt] = __builtin_amdgcn_mfma_f32_16x16x32_f16(ka1, *(const h16x8*)(vsT + (16 * vt + lr) * 72 + 32 + 8 * lq), Sacc[vt], 0, 0, 0);
                h16x4 sh;
#pragma unroll
                for (int r = 0; r < 4; ++r) sh[r] = (h16)Sacc[vt][r];
                *(h16x4*)(ST + (16 * vt + lr) * 136 + 16 * wid + 4 * lq) = sh;
            }
        }
#undef GDN_LOAD
        float* so = a.out + O_PG + ((size_t)(b * 16 + hv) * 128 + 16 * wid + 4 * lq) * 128 + v0 + lr;
#pragma unroll
        for (int vt = 0; vt < 4; ++vt)
#pragma unroll
            for (int r = 0; r < 4; ++r) so[(size_t)r * 128 + 16 * vt] = Sacc[vt][r];
    }
}

__device__ __forceinline__ void phase_gdn_gate(const Args& a) {
    const int lane = threadIdx.x & 63, wid = threadIdx.x >> 6;
    const h16* obuf = (const h16*)(a.ws + WS_OBUF); const h16* z = (const h16*)(a.ws + WS_Z); h16* og = (h16*)(a.ws + WS_OG);
    const f32x4 gw0 = *(const f32x4*)(a.in[I_GNW] + (lane & 15) * 8), gw1 = *(const f32x4*)(a.in[I_GNW] + (lane & 15) * 8 + 4);
    for (int row = blockIdx.x * 8 + wid; row < NR; row += gridDim.x * 8) {
        f32x4 o0[4], o1[4]; h16x8 zz[4], oh[4];
#pragma unroll
        for (int j = 0; j < 4; ++j) { const size_t e = (size_t)row * 2048 + j * 512 + lane * 8; oh[j] = *(const h16x8*)(obuf + e); zz[j] = *(const h16x8*)(z + e); }
#pragma unroll
        for (int j = 0; j < 4; ++j) { o0[j] = (f32x4){(float)oh[j][0], (float)oh[j][1], (float)oh[j][2], (float)oh[j][3]}; o1[j] = (f32x4){(float)oh[j][4], (float)oh[j][5], (float)oh[j][6], (float)oh[j][7]}; }
#pragma unroll
        for (int j = 0; j < 4; ++j) {
            const float ss = red16(sq4(o0[j]) + sq4(o1[j]));
            const float sc = rsqrtf(ss * (1.0f / 128.0f) + 1e-6f);
            h16x8 r;
#pragma unroll
            for (int i = 0; i < 4; ++i) { r[i] = (h16)(o0[j][i] * sc * gw0[i] * siluf_((float)zz[j][i])); r[4 + i] = (h16)(o1[j][i] * sc * gw1[i] * siluf_((float)zz[j][4 + i])); }
            *(h16x8*)(og + (size_t)row * 2048 + j * 512 + lane * 8) = r;
        }
    }
}

__device__ __forceinline__ void phase_shift(const Args& a) {
    const int lane = threadIdx.x & 63, wid = threadIdx.x >> 6;
    const float* x1 = (const float*)(a.ws + WS_X1); h16* xs = (h16*)(a.ws + WS_XS);
    const float* nw = a.in[I_NW] + DM; const float* mu = a.in[I_MU];
    for (int pr = blockIdx.x * 8 + wid; pr < NR / 2; pr += gridDim.x * 8) {
        const int row = pr * 2;
        int b, t; bool samp; row_bt(row, b, t, samp);
        f32x4 xa[4], xb[4], xp[4];
#pragma unroll
        for (int i = 0; i < 4; ++i) { xa[i] = *(const f32x4*)(x1 + (size_t)row * DM + i * 256 + lane * 4); xb[i] = *(const f32x4*)(x1 + (size_t)(row + 1) * DM + i * 256 + lane * 4); }
        if (t > 0) {
#pragma unroll
            for (int i = 0; i < 4; ++i) xp[i] = *(const f32x4*)(x1 + (size_t)(row - 1) * DM + i * 256 + lane * 4); }
        else if (samp) {
#pragma unroll
            for (int i = 0; i < 4; ++i) xp[i] = *(const f32x4*)(a.in[I_SRS] + (size_t)b * DM + i * 256 + lane * 4); }
        else {
#pragma unroll
            for (int i = 0; i < 4; ++i) xp[i] = (f32x4){0.f, 0.f, 0.f, 0.f}; }
        float sa = 0.f, sb = 0.f, sp = 0.f;
#pragma unroll
        for (int i = 0; i < 4; ++i) { sa += sq4(xa[i]); sb += sq4(xb[i]); sp += sq4(xp[i]); }
        sa = wsum(sa); sb = wsum(sb);
        const float ca = rsqrtf(sa * (1.0f / 1024.0f) + 1e-6f), cb = rsqrtf(sb * (1.0f / 1024.0f) + 1e-6f);
        float cp = 1.0f;
        if (t > 0) { sp = wsum(sp); cp = rsqrtf(sp * (1.0f / 1024.0f) + 1e-6f); }
#pragma unroll
        for (int i = 0; i < 4; ++i) { const f32x4 w = *(const f32x4*)(nw + i * 256 + lane * 4); xa[i] = xa[i] * ca * w; xb[i] = xb[i] * cb * w; if (t > 0) xp[i] = xp[i] * cp * w; }
        for (int s = 0; s < 6; ++s) {
#pragma unroll
            for (int i = 0; i < 4; ++i) { const f32x4 m = *(const f32x4*)(mu + (size_t)s * DM + i * 256 + lane * 4);
                const f32x4 r0 = xa[i] + (xp[i] - xa[i]) * m, r1 = xb[i] + (xa[i] - xb[i]) * m;
                h16x4 o0, o1; o0[0] = (h16)r0[0]; o0[1] = (h16)r0[1]; o0[2] = (h16)r0[2]; o0[3] = (h16)r0[3]; o1[0] = (h16)r1[0]; o1[1] = (h16)r1[1]; o1[2] = (h16)r1[2]; o1[3] = (h16)r1[3];
                *(h16x4*)(xs + ((size_t)s * MP + row) * DM + i * 256 + lane * 4) = o0; *(h16x4*)(xs + ((size_t)s * MP + row + 1) * DM + i * 256 + lane * 4) = o1; }
        }
        float* so = nullptr;
        if (!samp && t == TP - 2) so = a.out + O_PRS + (size_t)b * DM;
        if (samp && t == 6) so = a.out + O_SRS + (size_t)b * DM;
        if (so) {
#pragma unroll
            for (int i = 0; i < 4; ++i) *(f32x4*)(so + i * 256 + lane * 4) = xb[i]; }
    }
}

__device__ __forceinline__ void phase_rwkv_prep(const Args& a) {
    const int lane = threadIdx.x & 63, wid = threadIdx.x >> 6;
    h16* rkvz = (h16*)(a.ws + WS_RKVZ); const h16* lo = (const h16*)(a.ws + WS_LOUT);
    float* dbuf = (float*)(a.ws + WS_DB); h16* kkb = (h16*)(a.ws + WS_KKB); h16* bbb = (h16*)(a.ws + WS_BBB); float* rkb = (float*)(a.ws + WS_RK); h16* k2b = (h16*)(a.ws + WS_K2);
    float pw0[2][8], pa0[2][8], pkk[2][8], pka[2][8], prk[2][8];
#pragma unroll
    for (int j = 0; j < 2; ++j)
#pragma unroll
        for (int i = 0; i < 8; ++i) { const int c = j * 512 + lane * 8 + i; pw0[j][i] = a.in[I_W0][c]; pa0[j][i] = a.in[I_A0][c]; pkk[j][i] = a.in[I_KK][c]; pka[j][i] = a.in[I_KA][c]; prk[j][i] = a.in[I_RK][c]; }
    for (int row = blockIdx.x * 8 + wid; row < NR; row += gridDim.x * 8) {
        h16x8 r[2], k[2], wl[2], al[2];
#pragma unroll
        for (int j = 0; j < 2; ++j) { const size_t e = (size_t)row * 1024 + j * 512 + lane * 8; const size_t e2 = (size_t)row * 2048 + j * 512 + lane * 8;
            r[j] = *(const h16x8*)(rkvz + e); k[j] = *(const h16x8*)(rkvz + (size_t)MP * 1024 + e); wl[j] = *(const h16x8*)(lo + e2); al[j] = *(const h16x8*)(lo + e2 + 1024); }
#pragma unroll
        for (int j = 0; j < 2; ++j) {
            float kkv[8], aa[8], dd[8]; h16x8 k2o; float ss = 0.f, rk = 0.f;
#pragma unroll
            for (int i = 0; i < 8; ++i) {
                const float w = -softplusf_(-(pw0[j][i] + (float)wl[j][i])) - 0.5f;
                dd[i] = expf(-expf(w));
                aa[i] = sigmoidf_(pa0[j][i] + (float)al[j][i]);
                const float kf = (float)k[j][i];
                kkv[i] = kf * pkk[j][i]; ss += kkv[i] * kkv[i];
                const float k2 = kf * (1.0f + (aa[i] - 1.0f) * pka[j][i]);
                rk += (float)r[j][i] * k2 * prk[j][i];
                k2o[i] = (h16)k2;
            }
            ss = red8(ss); rk = red8(rk);
            const float inv = rsqrtf(ss + 1e-6f);
            h16x8 kko, bbo;
#pragma unroll
            for (int i = 0; i < 8; ++i) { const float kk = kkv[i] * inv; kko[i] = (h16)kk; bbo[i] = (h16)(kk * aa[i]); }
            const size_t e = (size_t)row * 1024 + j * 512 + lane * 8;
            *(h16x8*)(k2b + e) = k2o; *(h16x8*)(kkb + e) = kko; *(h16x8*)(bbb + e) = bbo;
            *(f32x4*)(dbuf + e) = (f32x4){dd[0], dd[1], dd[2], dd[3]}; *(f32x4*)(dbuf + e + 4) = (f32x4){dd[4], dd[5], dd[6], dd[7]};
            if ((lane & 7) == 0) rkb[(size_t)row * 16 + j * 8 + (lane >> 3)] = rk;
        }
    }
}

__device__ __forceinline__ void phase_rwkv_scan(const Args& a, float* ldsf) {
    const int tid = threadIdx.x, lane = tid & 63, wid = tid >> 6;
    const int rl = lane >> 4, kq = lane & 15;
    const h16* rkvz = (const h16*)(a.ws + WS_RKVZ); const float* dbuf = (const float*)(a.ws + WS_DB); const h16* k2b = (const h16*)(a.ws + WS_K2);
    const h16* kkb = (const h16*)(a.ws + WS_KKB); const h16* bbb = (const h16*)(a.ws + WS_BBB);
    float* ybuf = (float*)(a.ws + WS_YBUF);
    const int stt = tid >> 6, sch = tid & 63;
    for (int it = blockIdx.x; it < 256 + 4096; it += gridDim.x) {
        const bool samp = it >= 256; const int q = samp ? it - 256 : it;
        const int seq = q >> 1, half = q & 1, b = seq >> 4, h = seq & 15;
        const int T = samp ? 8 : TP, row0 = samp ? NPR + b * 8 : b * TP;
        const int v = half * 32 + wid * 4 + rl;
        f32x4 S;
        if (samp) S = *(const f32x4*)(a.in[I_SR] + ((size_t)(b * 16 + h) * 64 + v) * 64 + kq * 4);
        else S = (f32x4){0.f, 0.f, 0.f, 0.f};
        float pr, pk, pd, pkk, pb, pv;
        { const size_t e = (size_t)(row0 + stt) * 1024 + h * 64 + sch;
          pr = (float)rkvz[e]; pk = (float)k2b[e]; pv = (float)rkvz[(size_t)2 * MP * 1024 + e]; pd = dbuf[e]; pkk = (float)kkb[e]; pb = (float)bbb[e]; }
        __syncthreads();
        int cur = 0;
        for (int t0 = 0; t0 < T; t0 += 8) {
            float* Lb = ldsf + cur * 3072;
            Lb[stt * 64 + sch] = pr; Lb[512 + stt * 64 + sch] = pk; Lb[1024 + stt * 64 + sch] = pd; Lb[1536 + stt * 64 + sch] = pkk; Lb[2048 + stt * 64 + sch] = pb; Lb[2560 + stt * 64 + sch] = pv;
            __syncthreads();
            if (t0 + 8 < T) { const size_t e = (size_t)(row0 + t0 + 8 + stt) * 1024 + h * 64 + sch;
                pr = (float)rkvz[e]; pk = (float)k2b[e]; pv = (float)rkvz[(size_t)2 * MP * 1024 + e]; pd = dbuf[e]; pkk = (float)kkb[e]; pb = (float)bbb[e]; }
            float yv[8];
#pragma unroll
            for (int tt = 0; tt < 8; ++tt) {
                const f32x4 kk4 = *(const f32x4*)(Lb + 1536 + tt * 64 + kq * 4), d4 = *(const f32x4*)(Lb + 1024 + tt * 64 + kq * 4), b4 = *(const f32x4*)(Lb + 2048 + tt * 64 + kq * 4);
                const f32x4 k4 = *(const f32x4*)(Lb + 512 + tt * 64 + kq * 4), r4 = *(const f32x4*)(Lb + tt * 64 + kq * 4);
                const float vv = Lb[2560 + tt * 64 + v];
                float sa = S[0] * kk4[0] + S[1] * kk4[1] + S[2] * kk4[2] + S[3] * kk4[3];
                sa = red16(sa);
                const float nsa = -sa;
                S = S * d4 + nsa * b4 + vv * k4;
                float y = S[0] * r4[0] + S[1] * r4[1] + S[2] * r4[2] + S[3] * r4[3];
                yv[tt] = red16(y);
            }
            float ysel = yv[0];
#pragma unroll
            for (int tt = 1; tt < 8; ++tt) ysel = (kq == tt) ? yv[tt] : ysel;
            if (kq < 8) ybuf[(size_t)(row0 + t0 + kq) * 1024 + h * 64 + v] = ysel;
            cur ^= 1;
        }
        *(f32x4*)(a.out + (samp ? O_SR : O_PR) + ((size_t)(b * 16 + h) * 64 + v) * 64 + kq * 4) = S;
    }
}

__device__ __forceinline__ void phase_rwkv_gate(const Args& a) {
    const int lane = threadIdx.x & 63, wid = threadIdx.x >> 6;
    const float* ybuf = (const float*)(a.ws + WS_YBUF); const float* rkb = (const float*)(a.ws + WS_RK);
    const h16* rkvz = (const h16*)(a.ws + WS_RKVZ); h16* yg = (h16*)(a.ws + WS_YG);
    float lw[2][8], lb[2][8];
#pragma unroll
    for (int j = 0; j < 2; ++j)
#pragma unroll
        for (int i = 0; i < 8; ++i) { const int c = j * 512 + lane * 8 + i; lw[j][i] = a.in[I_LNW][c]; lb[j][i] = a.in[I_LNB][c]; }
    for (int row = blockIdx.x * 8 + wid; row < NR; row += gridDim.x * 8) {
        f32x4 y0[2], y1[2]; h16x8 vv[2], zz[2]; float rk[2];
#pragma unroll
        for (int j = 0; j < 2; ++j) { const size_t e = (size_t)row * 1024 + j * 512 + lane * 8;
            y0[j] = *(const f32x4*)(ybuf + e); y1[j] = *(const f32x4*)(ybuf + e + 4); vv[j] = *(const h16x8*)(rkvz + (size_t)2 * MP * 1024 + e); zz[j] = *(const h16x8*)(rkvz + (size_t)3 * MP * 1024 + e);
            rk[j] = rkb[(size_t)row * 16 + j * 8 + (lane >> 3)]; }
#pragma unroll
        for (int j = 0; j < 2; ++j) {
            float y[8] = {y0[j][0], y0[j][1], y0[j][2], y0[j][3], y1[j][0], y1[j][1], y1[j][2], y1[j][3]};
            float sm = 0.f;
#pragma unroll
            for (int i = 0; i < 8; ++i) sm += y[i];
            const float mean = red8(sm) * (1.0f / 64.0f);
            float sv = 0.f;
#pragma unroll
            for (int i = 0; i < 8; ++i) { y[i] -= mean; sv += y[i] * y[i]; }
            const float rs = rsqrtf(red8(sv) * (1.0f / 64.0f) + 64e-5f);
            h16x8 o;
#pragma unroll
            for (int i = 0; i < 8; ++i) { const float yn = y[i] * rs * lw[j][i] + lb[j][i] + rk[j] * (float)vv[j][i]; o[i] = (h16)(yn * siluf_((float)zz[j][i])); }
            *(h16x8*)(yg + (size_t)row * 1024 + j * 512 + lane * 8) = o;
        }
    }
}

__device__ __forceinline__ void phase_final(const Args& a) {
    const int lane = threadIdx.x & 63, wid = threadIdx.x >> 6;
    const float* x2 = (const float*)(a.ws + WS_X2); const float* nw = a.in[I_FNW];
    for (int pr = blockIdx.x * 8 + wid; pr < NR / 2; pr += gridDim.x * 8) {
        const int row = pr * 2;
        int b, t; bool samp; row_bt(row, b, t, samp);
        if (!samp && t < 16) continue;
        float* op = samp ? a.out + O_YS + (size_t)(row - NPR) * DM : a.out + O_YP + ((size_t)b * 2048 + (t - 16)) * DM;
        const float* p = x2 + (size_t)row * DM; f32x4 v[4], u[4]; float ss = 0.f, su = 0.f;
#pragma unroll
        for (int i = 0; i < 4; ++i) { v[i] = *(const f32x4*)(p + i * 256 + lane * 4); u[i] = *(const f32x4*)(p + DM + i * 256 + lane * 4); }
#pragma unroll
        for (int i = 0; i < 4; ++i) { ss += sq4(v[i]); su += sq4(u[i]); }
        ss = wsum(ss); su = wsum(su);
        const float sc = rsqrtf(ss * (1.0f / 1024.0f) + 1e-6f), scu = rsqrtf(su * (1.0f / 1024.0f) + 1e-6f);
#pragma unroll
        for (int i = 0; i < 4; ++i) { const f32x4 w = *(const f32x4*)(nw + i * 256 + lane * 4); *(f32x4*)(op + i * 256 + lane * 4) = v[i] * sc * w; *(f32x4*)(op + DM + i * 256 + lane * 4) = u[i] * scu * w; }
    }
}

constexpr int NPHASE = 15;
#ifndef PROBE_MASK
#define PROBE_MASK 0
#endif
__global__ void __launch_bounds__(NTHREADS, 2) mk_fwd(Args a) {
    extern __shared__ __attribute__((aligned(16))) unsigned char smem[];
    PG8_LAS unsigned char* lds = (PG8_LAS unsigned char*)smem;
    float* ldsf = (float*)smem;
    const int G = gridDim.x, c = blockIdx.x;
#if MK_COOP
    cg::grid_group grid = cg::this_grid();
    __shared__ uint4 xb_words;
    if (threadIdx.x == 0) xb_words = make_uint4(0u, 0u, 0u, 0u);
    __syncthreads();
    const XcdBarrier xbar = xcd_barrier_post((unsigned*)(a.ws + WS_BAR), (volatile PG8_LAS unsigned*)&xb_words);
    if (a.ph_hi > 1000) grid.sync();
#define SEAM(p) do { if ((p) + 1 < a.ph_hi) xcd_barrier(xbar); } while (0)
#else
#define SEAM(p) do { } while (0)
#endif
#define IN(p) (a.ph_lo <= (p) && (p) < a.ph_hi)
#define RUN(p, ...) if (IN(p)) { __syncthreads(); __VA_ARGS__; if ((PROBE_MASK >> (p)) & 1) { __syncthreads(); __VA_ARGS__; } SEAM(p); }
    RUN(0, phase_prep(a, ldsf))
    RUN(1, { pg8::Gemm g{(const h16*)(a.ws + WS_XN0), (const h16*)(a.ws + WS_WIN), MP, 6400, 1024}; pg8::StaticOrder S; S.init(MP, 6400, G, c);
        EpiProj E{(h16*)(a.ws + WS_QKVPRE), (h16*)(a.ws + WS_Z), (float*)(a.ws + WS_BA)};
        pg8::gemm_phase<EpiProj, pg8::StaticOrder>(lds, g, S, E); })
    RUN(2, phase_conv(a, ldsf))
    RUN(3, phase_gdn_pre(a, ldsf))
    RUN(4, { phase_gdn_chunk_scan(a, smem); __syncthreads(); phase_gdn_scan(a, ldsf); })
    RUN(5, phase_gdn_gate(a))
    RUN(6, { pg8::Gemm g{(const h16*)(a.ws + WS_OG), (const h16*)(a.ws + WS_WOUT), MP, 1024, 2048}; pg8::StaticOrder S; S.init(MP, 1024, G, c);
        EpiResX E{a.in[I_META], a.in[I_XP], a.in[I_XS], (float*)(a.ws + WS_X1)};
        pg8::gemm_phase<EpiResX, pg8::StaticOrder>(lds, g, S, E); })
    RUN(7, phase_shift(a))
    RUN(8, { pg8::Gemm g{(const h16*)(a.ws + WS_XS), (const h16*)(a.ws + WS_WR), 6 * MP, 4608, 1024}; OrderG S; S.init(G, c);
        EpiG E{(h16*)(a.ws + WS_RKVZ), (h16*)(a.ws + WS_LH)};
        pg8::gemm_phase<EpiG, OrderG>(lds, g, S, E); })
    RUN(9, { pg8::Gemm g{(const h16*)(a.ws + WS_LH), (const h16*)(a.ws + WS_WL2), MP, 2048, 256}; pg8::StaticOrder S; S.init(MP, 2048, G, c);
        EpiH16 E{(h16*)(a.ws + WS_LOUT), 2048};
        pg8::gemm_phase<EpiH16, pg8::StaticOrder>(lds, g, S, E); })
    RUN(10, phase_rwkv_prep(a))
    RUN(11, phase_rwkv_scan(a, ldsf))
    RUN(12, phase_rwkv_gate(a))
    RUN(13, { pg8::Gemm g{(const h16*)(a.ws + WS_YG), (const h16*)(a.ws + WS_WO), MP, 1024, 1024}; pg8::StaticOrder S; S.init(MP, 1024, G, c);
        EpiResB E{(const float*)(a.ws + WS_X1), (float*)(a.ws + WS_X2)};
        pg8::gemm_phase<EpiResB, pg8::StaticOrder>(lds, g, S, E); })
    RUN(14, phase_final(a))
#undef RUN
#undef IN
#undef SEAM
}

extern "C" void kernel_launch(void* const* d_in, const int* in_sizes, int n_in, void* d_out, int out_size, void* d_ws, size_t ws_size, hipStream_t stream) {
    static int grid = 0;
    if (grid == 0) {
        if (n_in != 29 || ws_size < WS_END) { fprintf(stderr, "kernel_launch: unexpected n_in %d or ws_size %zu (< %zu)\n", n_in, ws_size, (size_t)WS_END); grid = -1; return; }
        int dev = 0, cus = 0, per_cu = 0;
        hipGetDevice(&dev); hipDeviceGetAttribute(&cus, hipDeviceAttributeMultiprocessorCount, dev);
        if (hipFuncSetAttribute((const void*)mk_fwd, hipFuncAttributeMaxDynamicSharedMemorySize, LDS_BYTES) != hipSuccess) { fprintf(stderr, "kernel_launch: hipFuncSetAttribute failed\n"); }
        if (hipOccupancyMaxActiveBlocksPerMultiprocessor(&per_cu, (const void*)mk_fwd, NTHREADS, LDS_BYTES) != hipSuccess || per_cu < 1) { fprintf(stderr, "kernel_launch: occupancy query gave %d\n", per_cu); per_cu = 1; }
        (void)hipGetLastError();
        grid = cus * 1;
        if (grid <= 0) grid = 256;
    }
    if (grid < 0) return;
    Args a; memset(&a, 0, sizeof(a));
    for (int i = 0; i < 29; ++i) a.in[i] = (const float*)d_in[i];
    a.out = (float*)d_out; a.ws = (unsigned char*)d_ws;
#if MK_COOP
    a.ph_lo = 0; a.ph_hi = NPHASE;
    if (hipMemsetAsync((unsigned char*)d_ws + WS_BAR, 0, 16384, stream) != hipSuccess) fprintf(stderr, "kernel_launch: memset of barrier words failed\n");
    void* args[] = {&a};
    hipError_t e = hipLaunchCooperativeKernel((const void*)mk_fwd, dim3(grid), dim3(NTHREADS), args, LDS_BYTES, stream);
    if (e != hipSuccess) fprintf(stderr, "cooperative launch failed: %s (grid %d)\n", hipGetErrorString(e), grid);
#else
    for (int p = 0; p < NPHASE; ++p) { a.ph_lo = p; a.ph_hi = p + 1; hipLaunchKernelGGL(mk_fwd, dim3(grid), dim3(NTHREADS), LDS_BYTES, stream, a); }
#endif
}
```

```cpp
#include <hip/hip_runtime.h>
#include <hip/hip_cooperative_groups.h>
#include <cstdio>
#include <cstring>
namespace cg = cooperative_groups;

#ifndef MK_COOP
#define MK_COOP 1
#endif

typedef _Float16 h16;
typedef _Float16 h16x8 __attribute__((ext_vector_type(8)));
typedef _Float16 h16x4 __attribute__((ext_vector_type(4)));
typedef _Float16 h16x2 __attribute__((ext_vector_type(2)));
typedef float f32x4 __attribute__((ext_vector_type(4)));
typedef float f32x2 __attribute__((ext_vector_type(2)));

namespace pg8 {
#define PG8_LAS __attribute__((address_space(3)))
constexpr int BM = 256, BK = 64, HALF = 128, HTB = HALF * BK * 2, STAGE_BYTES = 8 * HTB, NXCD = 8, WGM = 8;
__host__ __device__ __forceinline__ int lds_byte(int r, int c) { const int st = (r >> 4) * 2 + (c >> 5), rr = r & 15, cc = c & 31, ob = rr * 64 + cc * 2; return st * 1024 + (ob ^ (((ob >> 9) & 1) << 5)); }
__host__ __device__ __forceinline__ void stage_rc(int b, int& R, int& C) { const int st = b / 1024, sb = b % 1024, swz = sb ^ (((sb >> 9) & 1) << 5); R = (st >> 1) * 16 + swz / 64; C = (st & 1) * 32 + (swz % 64) / 2; }
__host__ __device__ __forceinline__ int perm32(int rho) { const int n = rho >> 4, i = rho & 15; return 8 * (i >> 2) + 4 * n + (i & 3); }
struct Unit { int pm, pn; };
struct Gemm { const h16* A; const h16* Bt; int M, N, K; };
struct StaticOrder {
    int nM, nN, nwg, G, c;
    __host__ __device__ void init(int M, int N, int G_, int c_) { nM = M / BM; nN = N / BM; nwg = nM * nN; G = G_; c = c_; }
    __host__ __device__ bool next(int i, Unit& u) const {
        const long L = (long)i * G + c; if (L >= nwg) return false;
        int wgid = (int)L; { const int q = nwg / NXCD, r = nwg % NXCD, xcd = wgid % NXCD, off = wgid / NXCD; wgid = (xcd < r ? xcd * (q + 1) : r * (q + 1) + (xcd - r) * q) + off; }
        const int nig = WGM * nN, gid = wgid / nig, fm = gid * WGM, gsz = (nM - fm) < WGM ? (nM - fm) : WGM;
        u.pm = fm + ((wgid % nig) % gsz); u.pn = (wgid % nig) / gsz; return true;
    }
};

template <class Epi, class Sched>
__device__ __forceinline__ void gemm_phase(PG8_LAS unsigned char* lds, const Gemm g, const Sched& S, const Epi& E) {
    const int tid = threadIdx.x, wid = __builtin_amdgcn_readfirstlane(tid >> 6), lane = tid & 63, wr = wid >> 2, wc = wid & 3, fr = lane & 15, fq = lane >> 4;
    const int K = g.K, nt = K / BK;
    unsigned voffA[2], voffB[2];
#pragma unroll
    for (int i = 0; i < 2; ++i) { int R, C; stage_rc(tid * 16 + i * 8192, R, C); const int Rb = Epi::PERM ? ((R & ~31) + perm32(R & 31)) : R;
        voffA[i] = (unsigned)(R * K + C) * 2u; voffB[i] = (unsigned)(Rb * K + C) * 2u; }
    const size_t kstep = (size_t)(BK * 2);
    const size_t hstep = (size_t)HALF * K * 2;
    const size_t tstep = 2 * hstep;
    const unsigned ldsw = (unsigned)wid * 1024u;
    const int aoff = lds_byte(wr * 64 + fr, fq * 8), boff = lds_byte(wc * 32 + fr, fq * 8);
#define PG8_SA(b, h) (((b) * 2 + (h)) * HTB)
#define PG8_SB(b, h) ((4 + (b) * 2 + (h)) * HTB)
#define PG8_STAGE(bufoff, gbase, voff) do { _Pragma("unroll") for (int _i = 0; _i < 2; ++_i) \
        __builtin_amdgcn_global_load_lds((const unsigned*)((const char*)(gbase) + (voff)[_i]), (PG8_LAS unsigned*)(lds + (bufoff) + ldsw + _i * 8192), 16, 0, 0); } while (0)
#define PG8_LDA(dst, b, h) do { _Pragma("unroll") for (int m = 0; m < 4; ++m) _Pragma("unroll") for (int k = 0; k < 2; ++k) dst[m][k] = *(const PG8_LAS h16x8*)(lds + PG8_SA(b, h) + aoff + m * 2048 + k * 1024); } while (0)
#define PG8_LDB(dst, b, h) do { _Pragma("unroll") for (int n = 0; n < 2; ++n) _Pragma("unroll") for (int k = 0; k < 2; ++k) dst[n][k] = *(const PG8_LAS h16x8*)(lds + PG8_SB(b, h) + boff + n * 2048 + k * 1024); } while (0)
#define PG8_MMA(ai, bj, At, Bt) do { __builtin_amdgcn_s_setprio(1); _Pragma("unroll") for (int m = 0; m < 4; ++m) _Pragma("unroll") for (int n = 0; n < 2; ++n) _Pragma("unroll") for (int k = 0; k < 2; ++k) \
        acc[ai][bj][m][n] = __builtin_amdgcn_mfma_f32_16x16x32_f16(Bt[n][k], At[m][k], acc[ai][bj][m][n], 0, 0, 0); __builtin_amdgcn_s_setprio(0); } while (0)
#define PG8_WAIT_V(n) asm volatile("s_waitcnt vmcnt(" #n ")" ::: "memory")
#define PG8_WAIT_L(n) asm volatile("s_waitcnt lgkmcnt(" #n ")" ::: "memory")
#define PG8_BAR __builtin_amdgcn_s_barrier()
#define PG8_SCHED __builtin_amdgcn_sched_barrier(0)
    Unit cur, nxt; int ui = 0;
    if (!S.next(0, cur)) return;
    f32x4 acc[2][2][4][2];
#pragma unroll
    for (int a = 0; a < 2; ++a)
#pragma unroll
        for (int b = 0; b < 2; ++b)
#pragma unroll
            for (int m = 0; m < 4; ++m)
#pragma unroll
                for (int n = 0; n < 2; ++n) acc[a][b][m][n] = (f32x4){0.f, 0.f, 0.f, 0.f};
    h16x8 At[4][2], B0[2][2], B1[2][2];
    const char* cA = (const char*)g.A + (size_t)cur.pm * tstep; const char* cB = (const char*)g.Bt + (size_t)cur.pn * tstep;
    PG8_STAGE(PG8_SB(0, 0), cB, voffB); PG8_STAGE(PG8_SA(0, 0), cA, voffA); PG8_STAGE(PG8_SB(0, 1), cB + hstep, voffB); PG8_STAGE(PG8_SA(0, 1), cA + hstep, voffA);
    if (wr == 1) PG8_BAR;
    PG8_WAIT_V(4); PG8_BAR;
    PG8_STAGE(PG8_SB(1, 0), cB + kstep, voffB); PG8_STAGE(PG8_SA(1, 0), cA + kstep, voffA); PG8_STAGE(PG8_SB(1, 1), cB + hstep + kstep, voffB);
    PG8_WAIT_V(6); PG8_BAR;
    for (;;) {
        const bool has_next = S.next(ui + 1, nxt);
        const char* nA = has_next ? (const char*)g.A + (size_t)nxt.pm * tstep : cA; const char* nB = has_next ? (const char*)g.Bt + (size_t)nxt.pn * tstep : cB;
        for (int t = 0; t < nt; t += 2) {
            const bool last = (t == nt - 2);
            const char* a1 = cA + (size_t)(t + 1) * kstep;
            const char* a2 = last ? nA : cA + (size_t)(t + 2) * kstep; const char* b2 = last ? nB : cB + (size_t)(t + 2) * kstep;
            const char* a3 = a2 + kstep; const char* b3 = b2 + kstep;
            PG8_LDB(B0, 0, 0); PG8_SCHED; PG8_LDA(At, 0, 0); PG8_STAGE(PG8_SA(1, 1), a1 + hstep, voffA);
            PG8_WAIT_L(8); PG8_BAR; PG8_WAIT_L(0); PG8_MMA(0, 0, At, B0); PG8_BAR; PG8_SCHED;
            PG8_LDB(B1, 0, 1); PG8_STAGE(PG8_SB(0, 0), b2, voffB);
            PG8_BAR; PG8_WAIT_L(0); PG8_MMA(0, 1, At, B1); PG8_BAR;
            PG8_LDA(At, 0, 1); PG8_STAGE(PG8_SA(0, 0), a2, voffA);
            PG8_BAR; PG8_WAIT_L(0); PG8_MMA(1, 0, At, B0); PG8_BAR; PG8_SCHED;
            PG8_STAGE(PG8_SB(0, 1), b2 + hstep, voffB);
            PG8_WAIT_V(6); PG8_BAR; PG8_MMA(1, 1, At, B1); PG8_BAR;
            PG8_LDB(B0, 1, 0); PG8_SCHED; PG8_LDA(At, 1, 0); PG8_STAGE(PG8_SA(0, 1), a2 + hstep, voffA);
            PG8_WAIT_L(8); PG8_BAR; PG8_WAIT_L(0); PG8_MMA(0, 0, At, B0); PG8_BAR; PG8_SCHED;
            PG8_LDB(B1, 1, 1); PG8_STAGE(PG8_SB(1, 0), b3, voffB);
            PG8_BAR; PG8_WAIT_L(0); PG8_MMA(0, 1, At, B1); PG8_BAR;
            PG8_LDA(At, 1, 1); PG8_STAGE(PG8_SA(1, 0), a3, voffA);
            PG8_BAR; PG8_WAIT_L(0); PG8_MMA(1, 0, At, B0); PG8_BAR; PG8_SCHED;
            PG8_STAGE(PG8_SB(1, 1), b3 + hstep, voffB);
            PG8_WAIT_V(6); PG8_BAR; PG8_MMA(1, 1, At, B1); PG8_BAR;
        }
        E(acc, cur, wr, wc, fr, fq);
        if (!has_next) break;
#pragma unroll
        for (int a = 0; a < 2; ++a)
#pragma unroll
            for (int b = 0; b < 2; ++b)
#pragma unroll
                for (int m = 0; m < 4; ++m)
#pragma unroll
                    for (int n = 0; n < 2; ++n) acc[a][b][m][n] = (f32x4){0.f, 0.f, 0.f, 0.f};
        cur = nxt; cA = nA; cB = nB; ++ui;
    }
    PG8_WAIT_V(0);
    if (wr == 0) PG8_BAR;
    PG8_BAR;
#undef PG8_SA
#undef PG8_SB
#undef PG8_STAGE
#undef PG8_LDA
#undef PG8_LDB
#undef PG8_MMA
#undef PG8_WAIT_V
#undef PG8_WAIT_L
#undef PG8_BAR
#undef PG8_SCHED
}
}

constexpr int DM = 1024, TP = 2064, NPR = 8 * TP  , NR = NPR + 1024  , MP = 17664  , MT = 69;
constexpr int NTHREADS = 512, LDS_BYTES = pg8::STAGE_BYTES;
constexpr size_t UB = (size_t)MP * 1024 * 2;
constexpr size_t WS_WIN = 0;
constexpr size_t WS_WOUT = WS_WIN + (size_t)6400 * 1024 * 2;
constexpr size_t WS_WR = WS_WOUT + (size_t)1024 * 2048 * 2;
constexpr size_t WS_WL2 = WS_WR + (size_t)4608 * 1024 * 2;
constexpr size_t WS_WO = WS_WL2 + (size_t)2048 * 256 * 2;
constexpr size_t WS_WEND = WS_WO + (size_t)1024 * 1024 * 2;
static_assert(WS_WEND <= UB, "weights fit one unit");
constexpr size_t WS_X1 = 1 * UB;
constexpr size_t WS_QKVPRE = 3 * UB;
constexpr size_t WS_OBUF = 3 * UB;
constexpr size_t WS_UT = 1 * UB;
constexpr size_t WS_WW = 5 * UB;
constexpr size_t WS_AQ = 13 * UB;
constexpr size_t WS_XS = 3 * UB;
constexpr size_t WS_LOUT = 3 * UB;
constexpr size_t WS_X2 = 3 * UB;
constexpr size_t WS_YBUF = 3 * UB;
constexpr size_t WS_DB = 5 * UB;
constexpr size_t WS_KKB = 7 * UB;
constexpr size_t WS_BBB = 8 * UB;
constexpr size_t WS_Z = 7 * UB;
constexpr size_t WS_K2 = 13 * UB;
constexpr size_t WS_YG = 13 * UB;
constexpr size_t WS_QKV = 9 * UB;
constexpr size_t WS_OG = 9 * UB;
constexpr size_t WS_RKVZ = 9 * UB;
constexpr size_t WS_XN0 = 13 * UB;
constexpr size_t WS_BA = 14 * UB;
constexpr size_t WS_GB = WS_BA + (size_t)MP * 32 * 4;
constexpr size_t WS_LH = WS_GB + (size_t)MP * 32 * 4;
constexpr size_t WS_RK = WS_LH + (size_t)MP * 256 * 2;
constexpr size_t WS_GC = WS_RK + (size_t)MP * 16 * 4;
constexpr size_t WS_BAR = WS_GC + (size_t)4224 * 64 * 4;
constexpr size_t WS_END = WS_BAR + 16384;
constexpr int NCH = 33, NITEM = 128 * NCH;
constexpr size_t O_YP = 0, O_YS = 16777216, O_PG = 17825792, O_PGC = 19922944, O_PR = 20021248, O_PRS = 20545536, O_SG = 20553728, O_SGC = 54108160, O_SR = 55681024, O_SRS = 64069632;

struct TJob { const float* src; h16* dst; int srcK, srcN, dst_ld, row0, nrows, col0, ncols, tile0; };
struct Args {
    const float* in[29];
    float* out; unsigned char* ws;
    int ph_lo, ph_hi;
};
constexpr int NTILES_PREP = 3648;
enum { I_XP = 0, I_XS, I_SG, I_SGC, I_SR, I_SRS, I_META, I_NW, I_FNW, I_WIN, I_CW, I_ALOG, I_DTB, I_GNW, I_WOUT, I_MU, I_WRKVZ, I_W0, I_W1, I_W2, I_A0, I_A1, I_A2, I_KK, I_KA, I_RK, I_LNW, I_LNB, I_WO };

__device__ __forceinline__ float wave_sum(float v) {
#pragma unroll
    for (int o = 32; o > 0; o >>= 1) v += __shfl_xor(v, o);
    return v;
}
#define DPP_ADD(x, ctrl) ((x) + __builtin_bit_cast(float, __builtin_amdgcn_update_dpp(0, __builtin_bit_cast(int, (x)), (ctrl), 0xF, 0xF, true)))
__device__ __forceinline__ float red8(float x) { x = DPP_ADD(x, 0xB1); x = DPP_ADD(x, 0x4E); x = DPP_ADD(x, 0x141); return x; }
__device__ __forceinline__ float red16(float x) { x = DPP_ADD(x, 0xB1); x = DPP_ADD(x, 0x4E); x = DPP_ADD(x, 0x141); x = DPP_ADD(x, 0x140); return x; }
__device__ __forceinline__ float wsum(float x) { x = red16(x); x += __shfl_xor(x, 16); x += __shfl_xor(x, 32); return x; }
__device__ __forceinline__ float sq4(const f32x4 v) { return v[0] * v[0] + v[1] * v[1] + v[2] * v[2] + v[3] * v[3]; }
__device__ __forceinline__ float sigmoidf_(float x) { return 1.0f / (1.0f + expf(-x)); }
__device__ __forceinline__ float siluf_(float x) { return x / (1.0f + expf(-x)); }
__device__ __forceinline__ float softplusf_(float x) { return x > 20.0f ? x : log1pf(expf(x)); }
__device__ __forceinline__ void row_bt(int r, int& b, int& t, bool& samp) {
    if (r < NPR) { b = r / TP; t = r - b * TP; samp = false; } else { const int q = r - NPR; b = q >> 3; t = q & 7; samp = true; }
}
__device__ __forceinline__ const float* xrow(const Args& a, int r) {
    if (r < NPR) { const int b = r / TP, t = r - b * TP; return t < 16 ? a.in[I_META] + (size_t)t * DM : a.in[I_XP] + ((size_t)b * 2048 + (t - 16)) * DM; }
    return a.in[I_XS] + (size_t)(r - NPR) * DM;
}
__device__ __forceinline__ h16x8 pack8(const f32x4 v0, const f32x4 v1) {
    h16x8 w; w[0] = (h16)v0[0]; w[1] = (h16)v0[1]; w[2] = (h16)v0[2]; w[3] = (h16)v0[3]; w[4] = (h16)v1[0]; w[5] = (h16)v1[1]; w[6] = (h16)v1[2]; w[7] = (h16)v1[3]; return w;
}


#define XB_TMO      128
#define XB_XCNT(j)  (256  + 64 * (j))
#define XB_XSUB(j)  (1280 + 64 * (j))
#define XB_XGEN(j)  (2304 + 64 * (j))
#define XB_TOP      3328
#define XB_TOPGEN   3392
#define XCD_BAR_WORDS 3456
#define XB_SPIN_CAP (1u << 20)
__device__ __forceinline__ unsigned xb_ld(unsigned* p)              { return __hip_atomic_load(p, __ATOMIC_RELAXED, __HIP_MEMORY_SCOPE_AGENT); }
__device__ __forceinline__ unsigned xb_add(unsigned* p, unsigned v) { return __hip_atomic_fetch_add(p, v, __ATOMIC_RELAXED, __HIP_MEMORY_SCOPE_AGENT); }
__device__ __forceinline__ unsigned xb_xcc_id() { return (unsigned)__builtin_amdgcn_s_getreg((3 << 11) | 20) & 0xFu; }
#define XB_SPIN(cond, bar) do { unsigned _sp = 0; while (cond) { __builtin_amdgcn_s_sleep(1); \
    if ((++_sp & 255u) == 0u) { if (xb_ld(&(bar)[XB_TMO])) break; if (_sp > XB_SPIN_CAP) { atomicAdd(&(bar)[XB_TMO], 1u); break; } } } } while (0)
struct XcdBarrier { unsigned* bar; unsigned x; volatile PG8_LAS unsigned* st; };
__device__ __forceinline__ XcdBarrier xcd_barrier_post(unsigned* bar, volatile PG8_LAS unsigned* st) {
    XcdBarrier b; b.bar = bar; b.x = xb_xcc_id(); b.st = st;
    if (threadIdx.x == 0) (void)xb_add(&bar[XB_XCNT(b.x)], 1u);
    return b;
}
__device__ __forceinline__ void xcd_barrier_complete(unsigned* bar, unsigned x, unsigned& nloc, unsigned& nx) {
    const unsigned G = gridDim.x * gridDim.y * gridDim.z;
    unsigned sum, cnt, mine, sp = 0u;
    for (;;) {
        sum = 0u; cnt = 0u; mine = 0u;
#pragma unroll
        for (unsigned j = 0; j < 16; ++j) { const unsigned c = xb_ld(&bar[XB_XCNT(j)]); sum += c; cnt += (c > 0u) ? 1u : 0u; mine = (j == x) ? c : mine; }
        if (sum == G) break;
        __builtin_amdgcn_s_sleep(1);
        if ((++sp & 255u) == 0u) { if (xb_ld(&bar[XB_TMO])) break; if (sp > XB_SPIN_CAP) { atomicAdd(&bar[XB_TMO], 1u); break; } }
    }
    nloc = mine > 0u ? mine : 1u; nx = cnt > 0u ? cnt : 1u;
}
__device__ __forceinline__ void xcd_barrier(const XcdBarrier& b) {
    asm volatile("s_waitcnt vmcnt(0)" ::: "memory");
    __syncthreads();
    if (threadIdx.x == 0) {
        unsigned* bar = b.bar;
        __builtin_amdgcn_s_waitcnt(0);
        unsigned nloc = b.st[0], nx = b.st[1];
        if (nloc == 0u) { xcd_barrier_complete(bar, b.x, nloc, nx); b.st[0] = nloc; b.st[1] = nx; }
        const unsigned old = xb_add(&bar[XB_XSUB(b.x)], 1u);
        const unsigned gen = old / nloc;
        if (old + 1u == (gen + 1u) * nloc) {
            __builtin_amdgcn_fence(__ATOMIC_RELEASE, "agent");
            asm volatile("s_waitcnt vmcnt(0)" ::: "memory");
            const unsigned og = xb_add(&bar[XB_TOP], 1u);
            const unsigned tg = og / nx;
            if (og + 1u == (tg + 1u) * nx) xb_add(&bar[XB_TOPGEN], 1u);
            else XB_SPIN(xb_ld(&bar[XB_TOPGEN]) == tg, bar);
            __builtin_amdgcn_fence(__ATOMIC_ACQUIRE, "agent");
            xb_add(&bar[XB_XGEN(b.x)], 1u);
            asm volatile("s_waitcnt vmcnt(0)" ::: "memory");
        } else {
            XB_SPIN(xb_ld(&bar[XB_XGEN(b.x)]) == gen, bar);
            __builtin_amdgcn_fence(__ATOMIC_ACQUIRE, "agent");
            asm volatile("s_waitcnt vmcnt(0)" ::: "memory");
        }
    }
    __syncthreads();
}

__device__ __forceinline__ void phase_prep(const Args& a, float* ldsf) {
    const int tid = threadIdx.x, lane = tid & 63, wid = tid >> 6;
    for (int tile = blockIdx.x; tile < NTILES_PREP; tile += gridDim.x) {
        TJob jb;
        { h16* Win = (h16*)(a.ws + WS_WIN); h16* Wout = (h16*)(a.ws + WS_WOUT); h16* Wr = (h16*)(a.ws + WS_WR); h16* Wl2 = (h16*)(a.ws + WS_WL2); h16* Wo = (h16*)(a.ws + WS_WO);
          if (tile < 1600)      jb = TJob{a.in[I_WIN], Win, 1024, 6176, 1024, 0, 6400, 0, 1024, 0};
          else if (tile < 2112) jb = TJob{a.in[I_WOUT], Wout, 2048, 1024, 2048, 0, 1024, 0, 2048, 1600};
          else if (tile < 3136) { const int s = (tile - 2112) >> 8; jb = TJob{a.in[I_WRKVZ] + (size_t)s * 1024 * 1024, Wr, 1024, 1024, 1024, s * 1024, 1024, 0, 1024, 2112 + s * 256}; }
          else if (tile < 3200) jb = TJob{a.in[I_W1], Wr, 1024, 64, 1024, 4096, 256, 0, 1024, 3136};
          else if (tile < 3264) jb = TJob{a.in[I_A1], Wr, 1024, 64, 1024, 4352, 256, 0, 1024, 3200};
          else if (tile < 3328) jb = TJob{a.in[I_W2], Wl2, 64, 1024, 256, 0, 1024, 0, 256, 3264};
          else if (tile < 3392) jb = TJob{a.in[I_A2], Wl2, 64, 1024, 256, 1024, 1024, 64, 256, 3328};
          else                  jb = TJob{a.in[I_WO], Wo, 1024, 1024, 1024, 0, 1024, 0, 1024, 3392}; }
        const int lt = tile - jb.tile0, nck = jb.ncols >> 6, tn = lt / nck, tk = lt - tn * nck;
        __syncthreads();
#pragma unroll
        for (int e = 0; e < 8; ++e) {
            const int idx = e * 512 + tid, kk = idx >> 6, nn = idx & 63;
            const int ks = tk * 64 + kk - jb.col0, ns = tn * 64 + nn;
            float v = 0.f;
            if (ks >= 0 && ks < jb.srcK && ns < jb.srcN) v = jb.src[(size_t)ks * jb.srcN + ns];
            ldsf[kk * 65 + nn] = v;
        }
        __syncthreads();
#pragma unroll
        for (int e = 0; e < 8; ++e) {
            const int idx = e * 512 + tid, nn = idx >> 6, kk = idx & 63;
            jb.dst[(size_t)(jb.row0 + tn * 64 + nn) * jb.dst_ld + tk * 64 + kk] = (h16)ldsf[kk * 65 + nn];
        }
    }
    h16* xn0 = (h16*)(a.ws + WS_XN0);
    const float* nw = a.in[I_NW];
    for (int row = blockIdx.x * 8 + wid; row < MP; row += gridDim.x * 8) {
        h16* op = xn0 + (size_t)row * DM;
        if (row >= NR) {
#pragma unroll
            for (int i = 0; i < 4; ++i) *(h16x4*)(op + i * 256 + lane * 4) = (h16x4){(h16)0.f, (h16)0.f, (h16)0.f, (h16)0.f};
            continue;
        }
        const float* xp = xrow(a, row);
        f32x4 v[4]; float ss = 0.f;
#pragma unroll
        for (int i = 0; i < 4; ++i) { v[i] = *(const f32x4*)(xp + i * 256 + lane * 4); ss += v[i][0] * v[i][0] + v[i][1] * v[i][1] + v[i][2] * v[i][2] + v[i][3] * v[i][3]; }
        ss = wave_sum(ss);
        const float sc = rsqrtf(ss * (1.0f / 1024.0f) + 1e-6f);
#pragma unroll
        for (int i = 0; i < 4; ++i) { const f32x4 w = *(const f32x4*)(nw + i * 256 + lane * 4); h16x4 o;
#pragma unroll
            for (int j = 0; j < 4; ++j) o[j] = (h16)(v[i][j] * sc * w[j]);
            *(h16x4*)(op + i * 256 + lane * 4) = o; }
    }
}

struct EpiProj {
    static constexpr bool PERM = true;
    h16* qkv; h16* z; float* ba;
    __device__ __forceinline__ void operator()(const f32x4 (&acc)[2][2][4][2], const pg8::Unit& u, int wr, int wc, int fr, int fq) const {
        const int row0 = u.pm * 256 + wr * 64 + fr;
        if (u.pn < 24) {
            h16* base = u.pn < 16 ? qkv : z; const int ld = u.pn < 16 ? 4096 : 2048; const int col0 = (u.pn < 16 ? u.pn : u.pn - 16) * 256 + wc * 32 + 8 * fq;
#pragma unroll
            for (int ai = 0; ai < 2; ++ai)
#pragma unroll
                for (int m = 0; m < 4; ++m) { h16* rowp = base + (size_t)(row0 + ai * 128 + m * 16) * ld + col0;
#pragma unroll
                    for (int bj = 0; bj < 2; ++bj) *(h16x8*)(rowp + bj * 128) = pack8(acc[ai][bj][m][0], acc[ai][bj][m][1]); }
        } else if (wc == 0) {
#pragma unroll
            for (int ai = 0; ai < 2; ++ai)
#pragma unroll
                for (int m = 0; m < 4; ++m) { float* rowp = ba + (size_t)(row0 + ai * 128 + m * 16) * 32 + 8 * fq;
                    *(f32x4*)rowp = acc[ai][0][m][0]; *(f32x4*)(rowp + 4) = acc[ai][0][m][1]; }
        }
    }
};
struct EpiH16 {
    static constexpr bool PERM = true;
    h16* O; int ld;
    __device__ __forceinline__ void operator()(const f32x4 (&acc)[2][2][4][2], const pg8::Unit& u, int wr, int wc, int fr, int fq) const {
        const int row0 = u.pm * 256 + wr * 64 + fr, col0 = u.pn * 256 + wc * 32 + 8 * fq;
#pragma unroll
        for (int ai = 0; ai < 2; ++ai)
#pragma unroll
            for (int m = 0; m < 4; ++m) { h16* rowp = O + (size_t)(row0 + ai * 128 + m * 16) * ld + col0;
#pragma unroll
                for (int bj = 0; bj < 2; ++bj) *(h16x8*)(rowp + bj * 128) = pack8(acc[ai][bj][m][0], acc[ai][bj][m][1]); }
    }
};
struct EpiResX {
    static constexpr bool PERM = false;
    const float* meta; const float* xpr; const float* xsm; float* O;
    __device__ __forceinline__ void operator()(const f32x4 (&acc)[2][2][4][2], const pg8::Unit& u, int wr, int wc, int fr, int fq) const {
        const int row0 = u.pm * 256 + wr * 64 + fr, col0 = u.pn * 256 + wc * 32 + 4 * fq;
#pragma unroll
        for (int ai = 0; ai < 2; ++ai)
#pragma unroll
            for (int m = 0; m < 4; ++m) { const int row = row0 + ai * 128 + m * 16; if (row >= NR) continue;
                const float* xp;
                if (row < NPR) { const int b = row / TP, t = row - b * TP; xp = t < 16 ? meta + (size_t)t * DM : xpr + ((size_t)b * 2048 + (t - 16)) * DM; } else xp = xsm + (size_t)(row - NPR) * DM;
                xp += col0; float* rowp = O + (size_t)row * DM + col0;
#pragma unroll
                for (int bj = 0; bj < 2; ++bj)
#pragma unroll
                    for (int n = 0; n < 2; ++n) *(f32x4*)(rowp + bj * 128 + n * 16) = *(const f32x4*)(xp + bj * 128 + n * 16) + acc[ai][bj][m][n]; }
    }
};
struct EpiResB {
    static constexpr bool PERM = false;
    const float* base; float* O;
    __device__ __forceinline__ void operator()(const f32x4 (&acc)[2][2][4][2], const pg8::Unit& u, int wr, int wc, int fr, int fq) const {
        const int row0 = u.pm * 256 + wr * 64 + fr, col0 = u.pn * 256 + wc * 32 + 4 * fq;
#pragma unroll
        for (int ai = 0; ai < 2; ++ai)
#pragma unroll
            for (int m = 0; m < 4; ++m) { const int row = row0 + ai * 128 + m * 16; if (row >= NR) continue;
                const float* xp = base + (size_t)row * DM + col0; float* rowp = O + (size_t)row * DM + col0;
#pragma unroll
                for (int bj = 0; bj < 2; ++bj)
#pragma unroll
                    for (int n = 0; n < 2; ++n) *(f32x4*)(rowp + bj * 128 + n * 16) = *(const f32x4*)(xp + bj * 128 + n * 16) + acc[ai][bj][m][n]; }
    }
};
struct EpiG {
    static constexpr bool PERM = true;
    h16* rkvz; h16* lh;
    __device__ __forceinline__ void operator()(const f32x4 (&acc)[2][2][4][2], const pg8::Unit& u, int wr, int wc, int fr, int fq) const {
        const int s = u.pm / MT, i = u.pm - s * MT, row0 = i * 256 + wr * 64 + fr;
        if (s < 4) {
            h16* base = rkvz + (size_t)s * MP * 1024; const int col0 = (u.pn - 4 * s) * 256 + wc * 32 + 8 * fq;
#pragma unroll
            for (int ai = 0; ai < 2; ++ai)
#pragma unroll
                for (int m = 0; m < 4; ++m) { h16* rowp = base + (size_t)(row0 + ai * 128 + m * 16) * 1024 + col0;
#pragma unroll
                    for (int bj = 0; bj < 2; ++bj) *(h16x8*)(rowp + bj * 128) = pack8(acc[ai][bj][m][0], acc[ai][bj][m][1]); }
        } else if (wc < 2) {
            const int cb = (s == 4 ? 0 : 64) + wc * 32 + 8 * fq;
#pragma unroll
            for (int ai = 0; ai < 2; ++ai)
#pragma unroll
                for (int m = 0; m < 4; ++m) { h16* rowp = lh + (size_t)(row0 + ai * 128 + m * 16) * 256;
                    f32x4 v0 = acc[ai][0][m][0], v1 = acc[ai][0][m][1];
                    if (s == 4) {
#pragma unroll
                        for (int j = 0; j < 4; ++j) { v0[j] = tanhf(v0[j]); v1[j] = tanhf(v1[j]); } }
                    *(h16x8*)(rowp + cb) = pack8(v0, v1);
                    *(h16x8*)(rowp + 128 + cb) = pack8((f32x4){0.f, 0.f, 0.f, 0.f}, (f32x4){0.f, 0.f, 0.f, 0.f}); }
        }
    }
};
struct OrderG {
    pg8::StaticOrder so; int G, c;
    __device__ void init(int G_, int c_) { so.init(4 * MT * 256, 1024, G_, c_); G = G_; c = c_; }
    __device__ bool next(int i, pg8::Unit& u) const {
        long L = (long)i * G + c;
        if (L < 4 * MT * 4) { pg8::Unit v; so.next(i, v); u.pm = v.pm; u.pn = (v.pm / MT) * 4 + v.pn; return true; }
        L -= 4 * MT * 4; if (L >= 2 * MT) return false;
        const int s = 4 + (int)(L / MT), ii = (int)(L % MT); u.pm = s * MT + ii; u.pn = 12 + s; return true;
    }
};

__device__ __forceinline__ void phase_conv(const Args& a, float* ldsf) {
    const int tid = threadIdx.x, lane = tid & 63, wid = tid >> 6;
    const h16* pre = (const h16*)(a.ws + WS_QKVPRE); h16* qkv = (h16*)(a.ws + WS_QKV);
    const float* ba = (const float*)(a.ws + WS_BA); float* gb = (float*)(a.ws + WS_GB);
    const float* cst = a.in[I_SGC];
    for (int i = tid; i < 4096; i += NTHREADS) { const f32x4 w = *(const f32x4*)(a.in[I_CW] + (size_t)i * 4); ldsf[i] = w[0]; ldsf[4096 + i] = w[1]; ldsf[8192 + i] = w[2]; ldsf[12288 + i] = w[3]; }
    __syncthreads();
    for (int row = blockIdx.x * 8 + wid; row < NR; row += gridDim.x * 8) {
        int b, t; bool samp; row_bt(row, b, t, samp);
        for (int half = 0; half < 2; ++half) {
            h16x8 x[4][4];
#pragma unroll
            for (int sg = 0; sg < 4; ++sg) {
                const int c0 = (half * 4 + sg) * 512 + lane * 8;
#pragma unroll
                for (int jj = 0; jj < 4; ++jj) {
                    const int idx = t + jj;
                    if (idx >= 3) x[sg][jj] = *(const h16x8*)(pre + (size_t)(row - 3 + jj) * 4096 + c0);
                    else if (samp) { const float* bp = cst + ((size_t)b * 3 + idx) * 4096 + c0; const f32x4 p0 = *(const f32x4*)bp, p1 = *(const f32x4*)(bp + 4); x[sg][jj] = pack8(p0, p1); }
                    else x[sg][jj] = pack8((f32x4){0.f, 0.f, 0.f, 0.f}, (f32x4){0.f, 0.f, 0.f, 0.f});
                }
            }
#pragma unroll
            for (int sg = 0; sg < 4; ++sg) {
                const int seg = half * 4 + sg, c0 = seg * 512 + lane * 8;
                float y[8];
#pragma unroll
                for (int j = 0; j < 8; ++j) y[j] = 0.f;
#pragma unroll
                for (int jj = 0; jj < 4; ++jj) { const f32x4 w0 = *(const f32x4*)(ldsf + jj * 4096 + c0), w1 = *(const f32x4*)(ldsf + jj * 4096 + c0 + 4);
#pragma unroll
                    for (int j = 0; j < 4; ++j) { y[j] += (float)x[sg][jj][j] * w0[j]; y[4 + j] += (float)x[sg][jj][4 + j] * w1[j]; } }
                float ss = 0.f;
#pragma unroll
                for (int j = 0; j < 8; ++j) { y[j] = siluf_(y[j]); ss += y[j] * y[j]; }
                float sc = 1.0f;
                if (seg < 4) { ss = red16(ss); sc = rsqrtf(ss + 1e-6f) * (seg < 2 ? 0.08838834764831845f : 1.0f); }
                h16x8 o;
#pragma unroll
                for (int j = 0; j < 8; ++j) o[j] = (h16)(y[j] * sc);
                *(h16x8*)(qkv + (size_t)row * 4096 + c0) = o;
                float* cso = nullptr;
                if (!samp && t >= TP - 3) cso = a.out + O_PGC + ((size_t)b * 3 + (t - (TP - 3))) * 4096 + c0;
                if (samp && t >= 5) cso = a.out + O_SGC + ((size_t)b * 3 + (t - 5)) * 4096 + c0;
                if (cso) { const h16x8 u = x[sg][3]; *(f32x4*)cso = (f32x4){(float)u[0], (float)u[1], (float)u[2], (float)u[3]}; *(f32x4*)(cso + 4) = (f32x4){(float)u[4], (float)u[5], (float)u[6], (float)u[7]}; }
            }
        }
        if (lane < 16) {
            const float bv = ba[(size_t)row * 32 + lane], av = ba[(size_t)row * 32 + 16 + lane];
            gb[(size_t)row * 32 + lane] = sigmoidf_(bv);
            gb[(size_t)row * 32 + 16 + lane] = -expf(a.in[I_ALOG][lane]) * softplusf_(av + a.in[I_DTB][lane]);
        }
    }
}

__device__ __forceinline__ void phase_gdn_scan(const Args& a, float* ldsf) {
    const int tid = threadIdx.x;
    const int vl = tid >> 3, kq = tid & 7;
    const h16* qkv = (const h16*)(a.ws + WS_QKV); const float* gb = (const float*)(a.ws + WS_GB); h16* obuf = (h16*)(a.ws + WS_OBUF);
    const int stt = tid >> 6, sp = tid & 63;
    for (int it = 256 + blockIdx.x; it < 256 + 4096; it += gridDim.x) {
        const bool samp = it >= 256; const int q = samp ? it - 256 : it;
        const int seq = q >> 1, vhalf = q & 1, b = seq >> 4, hv = seq & 15, hq = hv >> 1;
        const int T = samp ? 8 : TP, row0 = samp ? NPR + b * 8 : b * TP;
        const int v = vhalf * 64 + vl;
        float S[16];
        if (samp) { const float* spp = a.in[I_SG] + ((size_t)(b * 16 + hv) * 128 + kq * 16) * 128 + v;
#pragma unroll
            for (int i = 0; i < 16; ++i) S[i] = spp[(size_t)i * 128]; }
        else {
#pragma unroll
            for (int i = 0; i < 16; ++i) S[i] = 0.f; }
        h16x4 pqk; h16 pv; float pg = 0.f, pb = 0.f;
        { const h16* rp = qkv + (size_t)(row0 + stt) * 4096;
          pqk = *(const h16x4*)(rp + (sp < 32 ? hq * 128 + sp * 4 : 1024 + hq * 128 + (sp - 32) * 4)); pv = rp[2048 + hv * 128 + vhalf * 64 + sp];
          if (tid < 8) { pb = gb[(size_t)(row0 + tid) * 32 + hv]; pg = gb[(size_t)(row0 + tid) * 32 + 16 + hv]; } }
        __syncthreads();
        int cur = 0;
        for (int t0 = 0; t0 < T; t0 += 8) {
            float* Lb = ldsf + cur * 2576;
            *(f32x4*)(Lb + (sp < 32 ? 0 : 1024) + stt * 128 + (sp & 31) * 4) = (f32x4){(float)pqk[0], (float)pqk[1], (float)pqk[2], (float)pqk[3]};
            Lb[2048 + stt * 64 + sp] = (float)pv;
            if (tid < 8) { Lb[2560 + tid] = expf(pg); Lb[2568 + tid] = pb; }
            __syncthreads();
            if (t0 + 8 < T) { const h16* rp = qkv + (size_t)(row0 + t0 + 8 + stt) * 4096;
                pqk = *(const h16x4*)(rp + (sp < 32 ? hq * 128 + sp * 4 : 1024 + hq * 128 + (sp - 32) * 4)); pv = rp[2048 + hv * 128 + vhalf * 64 + sp];
                if (tid < 8) { pb = gb[(size_t)(row0 + t0 + 8 + tid) * 32 + hv]; pg = gb[(size_t)(row0 + t0 + 8 + tid) * 32 + 16 + hv]; } }
#pragma unroll 2
            for (int tt = 0; tt < 8; ++tt) {
                const float al = Lb[2560 + tt], be = Lb[2568 + tt], vv = Lb[2048 + tt * 64 + vl];
                const f32x4* kp = (const f32x4*)(Lb + 1024 + tt * 128 + kq * 16); const f32x4* qp = (const f32x4*)(Lb + tt * 128 + kq * 16);
                float kr[16];
                float dot = 0.f;
#pragma unroll
                for (int i = 0; i < 4; ++i) { const f32x4 kv = kp[i]; kr[4 * i] = kv[0]; kr[4 * i + 1] = kv[1]; kr[4 * i + 2] = kv[2]; kr[4 * i + 3] = kv[3]; }
#pragma unroll
                for (int i = 0; i < 16; ++i) dot += kr[i] * S[i];
                dot = red8(dot);
                const float c = be * (vv - al * dot);
                float od = 0.f;
#pragma unroll
                for (int i = 0; i < 4; ++i) { const f32x4 qv = qp[i];
#pragma unroll
                    for (int j = 0; j < 4; ++j) { const float s = al * S[4 * i + j] + kr[4 * i + j] * c; S[4 * i + j] = s; od += qv[j] * s; } }
                od = red8(od);
                if (kq == 0) obuf[(size_t)(row0 + t0 + tt) * 2048 + hv * 128 + v] = (h16)od;
            }
            cur ^= 1;
        }
        float* so = a.out + (samp ? O_SG : O_PG) + ((size_t)(b * 16 + hv) * 128 + kq * 16) * 128 + v;
#pragma unroll
        for (int i = 0; i < 16; ++i) so[(size_t)i * 128] = S[i];
    }
}

__device__ __forceinline__ void phase_gdn_pre(const Args& a, float* ldsf) {
    const int tid = threadIdx.x, hb = tid >> 8, ht = tid & 255, hw = ht >> 6, l = tid & 63, lr = l & 15, lq = l >> 4;
    const h16* qkv = (const h16*)(a.ws + WS_QKV); const float* gb = (const float*)(a.ws + WS_GB);
    h16* UT = (h16*)(a.ws + WS_UT); h16* WW = (h16*)(a.ws + WS_WW); h16* AQ = (h16*)(a.ws + WS_AQ); float* GC = (float*)(a.ws + WS_GC);
    float* Am = ldsf + hb * 4352;
    float* gs = Am + 4096, *bs = Am + 4160, *gcs = Am + 4224;
    const int niter = (NITEM + gridDim.x * 2 - 1) / (gridDim.x * 2);
    for (int n = 0; n < niter; ++n) {
        const int itm = (n * gridDim.x + blockIdx.x) * 2 + hb;
        const bool valid = itm < NITEM;
        const int seq = valid ? itm / NCH : 0, c = valid ? itm - seq * NCH : 0, b = seq >> 4, hv = seq & 15, hq = hv >> 1;
        const int rowb = b * TP + 64 * c, nval = (TP - 64 * c) < 64 ? (TP - 64 * c) : 64;
        const int ib = hw;
        h16x8 aq[4], ak[4], kf[4][4]; h16x2 xr[32]; float gv = 0.f, bv = 0.f;
#pragma unroll
        for (int ks = 0; ks < 4; ++ks) { aq[ks] = *(const h16x8*)(qkv + (size_t)(rowb + 16 * ib + lr) * 4096 + hq * 128 + 32 * ks + 8 * lq); ak[ks] = *(const h16x8*)(qkv + (size_t)(rowb + 16 * ib + lr) * 4096 + 1024 + hq * 128 + 32 * ks + 8 * lq);
#pragma unroll
            for (int jb = 0; jb < 4; ++jb) kf[jb][ks] = *(const h16x8*)(qkv + (size_t)(rowb + 16 * jb + lr) * 4096 + 1024 + hq * 128 + 32 * ks + 8 * lq); }
        { const h16* xp = qkv + (size_t)rowb * 4096 + (ht < 128 ? 2048 + hv * 128 + ht : 1024 + hq * 128 + (ht - 128));
#pragma unroll
          for (int i = 0; i < 32; ++i) { xr[i][0] = xp[(size_t)(2 * i) * 4096]; xr[i][1] = xp[(size_t)(2 * i + 1) * 4096]; } }
        if (ht < 64 && ht < nval) { gv = gb[(size_t)(rowb + ht) * 32 + 16 + hv]; bv = gb[(size_t)(rowb + ht) * 32 + hv]; }
        __syncthreads();
        if (ht < 64) { gs[ht] = gv; bs[ht] = bv; }
        __syncthreads();
        if (ht < 64) { float sgc = 0.f;
#pragma unroll
            for (int j4 = 0; j4 < 16; ++j4) { const f32x4 g4 = *(const f32x4*)(gs + 4 * j4);
#pragma unroll
                for (int jj = 0; jj < 4; ++jj) sgc += (4 * j4 + jj <= ht) ? g4[jj] : 0.f; }
            gcs[ht] = sgc; if (valid) GC[(size_t)itm * 64 + ht] = sgc; }
        __syncthreads();
        if (valid) {
            float gci[4], bei[4];
#pragma unroll
            for (int r = 0; r < 4; ++r) { gci[r] = gcs[16 * ib + 4 * lq + r]; bei[r] = bs[16 * ib + 4 * lq + r]; }
#pragma unroll
            for (int jb = 0; jb < 4; ++jb) {
                h16* aqp = AQ + (size_t)itm * 4096 + (size_t)(16 * ib + 4 * lq) * 64 + 16 * jb + lr;
                if (jb > ib) {
#pragma unroll
                    for (int r = 0; r < 4; ++r) aqp[r * 64] = (h16)0.f;
                } else {
                    f32x4 ckk = (f32x4){0.f, 0.f, 0.f, 0.f}, cqk = (f32x4){0.f, 0.f, 0.f, 0.f};
#pragma unroll
                    for (int ks = 0; ks < 4; ++ks) {
                        ckk = __builtin_amdgcn_mfma_f32_16x16x32_f16(ak[ks], kf[jb][ks], ckk, 0, 0, 0); cqk = __builtin_amdgcn_mfma_f32_16x16x32_f16(aq[ks], kf[jb][ks], cqk, 0, 0, 0); }
                    const int j = 16 * jb + lr; const float gcj = gcs[j];
#pragma unroll
                    for (int r = 0; r < 4; ++r) { const int i = 16 * ib + 4 * lq + r; const float dec = expf(gci[r] - gcj);
                        Am[i * 64 + j] = (j < i) ? bei[r] * ckk[r] * dec : 0.f;
                        aqp[r * 64] = (h16)((j <= i) ? cqk[r] * dec : 0.f); }
                }
            }
        }
        __syncthreads();
        if (valid) {
            float x[64];
            if (ht < 128) {
#pragma unroll
                for (int i = 0; i < 64; ++i) x[i] = (float)xr[i >> 1][i & 1] * bs[i]; }
            else {
#pragma unroll
                for (int i = 0; i < 64; ++i) x[i] = (float)xr[i >> 1][i & 1] * bs[i] * expf(gcs[i]); }
            {
                f32x4 ab0[8], ab1[8];
#define SUB_LOAD(dst, i, c) do { _Pragma("unroll") for (int v_ = 0; v_ < 8; ++v_) if (32 * (c) + 4 * v_ < (i)) dst[v_] = *(const f32x4*)(Am + (i) * 64 + 32 * (c) + 4 * v_); } while (0)
#define SUB_FMA(src, i, c) do { _Pragma("unroll") for (int v_ = 0; v_ < 8; ++v_) { const int j_ = 32 * (c) + 4 * v_; \
                    if (j_ < (i))     a0 = __builtin_fmaf(src[v_][0], x[j_], a0); if (j_ + 1 < (i)) a1 = __builtin_fmaf(src[v_][1], x[j_ + 1], a1); \
                    if (j_ + 2 < (i)) a2 = __builtin_fmaf(src[v_][2], x[j_ + 2], a2); if (j_ + 3 < (i)) a3 = __builtin_fmaf(src[v_][3], x[j_ + 3], a3); } } while (0)
                SUB_LOAD(ab0, 1, 0);
#pragma unroll
                for (int i = 1; i < 33; i += 2) {
                    { float a0 = 0.f, a1 = 0.f, a2 = 0.f, a3 = 0.f; SUB_LOAD(ab1, i + 1, 0); __builtin_amdgcn_sched_barrier(0); SUB_FMA(ab0, i, 0); x[i] -= (a0 + a1) + (a2 + a3); }
                    { float a0 = 0.f, a1 = 0.f, a2 = 0.f, a3 = 0.f; SUB_LOAD(ab0, i + 2, 0); __builtin_amdgcn_sched_barrier(0); SUB_FMA(ab1, i + 1, 0); x[i + 1] -= (a0 + a1) + (a2 + a3); }
                }
#pragma unroll
                for (int i = 33; i < 64; ++i) {
                    float a0 = 0.f, a1 = 0.f, a2 = 0.f, a3 = 0.f;
                    SUB_LOAD(ab1, i, 1); __builtin_amdgcn_sched_barrier(0); SUB_FMA(ab0, i, 0);
                    if (i + 1 < 64) SUB_LOAD(ab0, i + 1, 0);
                    __builtin_amdgcn_sched_barrier(0); SUB_FMA(ab1, i, 1);
                    x[i] -= (a0 + a1) + (a2 + a3);
                }
#undef SUB_LOAD
#undef SUB_FMA
            }
            if (ht < 128) { h16* up = UT + (size_t)itm * 8192 + (size_t)ht * 64;
#pragma unroll
                for (int i8 = 0; i8 < 8; ++i8) { h16x8 o;
#pragma unroll
                    for (int jj = 0; jj < 8; ++jj) o[jj] = (h16)x[8 * i8 + jj];
                    *(h16x8*)(up + 8 * i8) = o; } }
            else { h16* wp = WW + (size_t)itm * 8192 + (ht - 128);
#pragma unroll
                for (int i = 0; i < 64; ++i) wp[(size_t)i * 128] = (h16)x[i]; }
        }
    }
}

__device__ __forceinline__ void phase_gdn_chunk_scan(const Args& a, unsigned char* smem) {
    const int tid = threadIdx.x, wid = tid >> 6, l = tid & 63, lr = l & 15, lq = l >> 4;
    const int ib = wid & 3, vp = wid >> 2;
    const h16* qkv = (const h16*)(a.ws + WS_QKV);
    const h16* UT = (const h16*)(a.ws + WS_UT); const h16* WW = (const h16*)(a.ws + WS_WW); const h16* AQ = (const h16*)(a.ws + WS_AQ); const float* GC = (const float*)(a.ws + WS_GC);
    h16* obuf = (h16*)(a.ws + WS_OBUF);
    h16* ST = (h16*)smem;
    h16* vnT = ST + 64 * 136;
    h16* vsT = vnT + 64 * 72;
    h16* kT = vsT + 64 * 72;
    for (int it = blockIdx.x; it < 256; it += gridDim.x) {
        const int seq = it >> 1, vhalf = it & 1, b = seq >> 4, hv = seq & 15, hq = hv >> 1, v0 = vhalf * 64;
        __syncthreads();
        for (int e = tid; e < 64 * 136 / 8; e += NTHREADS) *(h16x8*)(ST + e * 8) = pack8((f32x4){0.f, 0.f, 0.f, 0.f}, (f32x4){0.f, 0.f, 0.f, 0.f});
        f32x4 Sacc[4];
#pragma unroll
        for (int vt = 0; vt < 4; ++vt) Sacc[vt] = (f32x4){0.f, 0.f, 0.f, 0.f};
        h16x8 wf[4], qf[4], af[2], ks0, ks1; h16x4 ut[2]; f32x4 gcr; float gl;
        const int si = tid >> 3, skg = tid & 7;
#define GDN_LOAD(c) do { const int itm_ = seq * NCH + (c); const int rowb_ = b * TP + 64 * (c); \
            _Pragma("unroll") for (int ks = 0; ks < 4; ++ks) { wf[ks] = *(const h16x8*)(WW + (size_t)itm_ * 8192 + (size_t)(16 * ib + lr) * 128 + 32 * ks + 8 * lq); \
                qf[ks] = *(const h16x8*)(qkv + (size_t)(rowb_ + 16 * ib + lr) * 4096 + hq * 128 + 32 * ks + 8 * lq); } \
            _Pragma("unroll") for (int k2 = 0; k2 < 2; ++k2) af[k2] = *(const h16x8*)(AQ + (size_t)itm_ * 4096 + (size_t)(16 * ib + lr) * 64 + 32 * k2 + 8 * lq); \
            _Pragma("unroll") for (int vt = 0; vt < 2; ++vt) ut[vt] = *(const h16x4*)(UT + (size_t)itm_ * 8192 + (size_t)(v0 + 16 * (2 * vp + vt) + lr) * 64 + 16 * ib + 4 * lq); \
            gcr = *(const f32x4*)(GC + (size_t)itm_ * 64 + 16 * ib + 4 * lq); gl = GC[(size_t)itm_ * 64 + 63]; \
            { const h16* kp_ = qkv + (size_t)(rowb_ + si) * 4096 + 1024 + hq * 128 + 16 * skg; ks0 = *(const h16x8*)kp_; ks1 = *(const h16x8*)(kp_ + 8); } } while (0)
        GDN_LOAD(0);
        for (int c = 0; c < NCH; ++c) {
            const int rowb = b * TP + 64 * c, nval = (TP - 64 * c) < 64 ? (TP - 64 * c) : 64;
            __syncthreads();
#pragma unroll
            for (int jj = 0; jj < 8; ++jj) { kT[(16 * skg + jj) * 72 + si] = ks0[jj]; kT[(16 * skg + 8 + jj) * 72 + si] = ks1[jj]; }
            f32x4 c1[2], c2[2];
#pragma unroll
            for (int vt = 0; vt < 2; ++vt) { c1[vt] = (f32x4){0.f, 0.f, 0.f, 0.f}; c2[vt] = (f32x4){0.f, 0.f, 0.f, 0.f}; }
#pragma unroll
            for (int vt = 0; vt < 2; ++vt)
#pragma unroll
                for (int ks = 0; ks < 4; ++ks) { const h16x8 bf = *(const h16x8*)(ST + (16 * (2 * vp + vt) + lr) * 136 + 32 * ks + 8 * lq);
                    c1[vt] = __builtin_amdgcn_mfma_f32_16x16x32_f16(wf[ks], bf, c1[vt], 0, 0, 0); c2[vt] = __builtin_amdgcn_mfma_f32_16x16x32_f16(qf[ks], bf, c2[vt], 0, 0, 0); }
            const float egl = expf(gl);
            f32x4 eg, es;
#pragma unroll
            for (int r = 0; r < 4; ++r) { eg[r] = expf(gcr[r]); es[r] = expf(gl - gcr[r]); }
#pragma unroll
            for (int vt = 0; vt < 2; ++vt) { h16x4 vn, vs;
#pragma unroll
                for (int r = 0; r < 4; ++r) { const float x = (float)ut[vt][r] - c1[vt][r]; vn[r] = (h16)x; vs[r] = (h16)(x * es[r]); }
                *(h16x4*)(vnT + (16 * (2 * vp + vt) + lr) * 72 + 16 * ib + 4 * lq) = vn; *(h16x4*)(vsT + (16 * (2 * vp + vt) + lr) * 72 + 16 * ib + 4 * lq) = vs; }
            const h16x8 afc0 = af[0], afc1 = af[1];
            __syncthreads();
            if (c + 1 < NCH) GDN_LOAD(c + 1);
#pragma unroll
            for (int vt = 0; vt < 2; ++vt) {
                f32x4 c3 = (f32x4){0.f, 0.f, 0.f, 0.f};
                c3 = __builtin_amdgcn_mfma_f32_16x16x32_f16(afc0, *(const h16x8*)(vnT + (16 * (2 * vp + vt) + lr) * 72 + 8 * lq), c3, 0, 0, 0);
                c3 = __builtin_amdgcn_mfma_f32_16x16x32_f16(afc1, *(const h16x8*)(vnT + (16 * (2 * vp + vt) + lr) * 72 + 32 + 8 * lq), c3, 0, 0, 0);
#pragma unroll
                for (int r = 0; r < 4; ++r) { const int i = 16 * ib + 4 * lq + r;
                    if (i < nval) obuf[(size_t)(rowb + i) * 2048 + hv * 128 + v0 + 16 * (2 * vp + vt) + lr] = (h16)(eg[r] * c2[vt][r] + c3[r]); }
            }
            const h16x8 ka0 = *(const h16x8*)(kT + (16 * wid + lr) * 72 + 8 * lq), ka1 = *(const h16x8*)(kT + (16 * wid + lr) * 72 + 32 + 8 * lq);
#pragma unroll
            for (int vt = 0; vt < 4; ++vt) {
                Sacc[vt] = Sacc[vt] * egl;
                Sacc[vt] = __builtin_amdgcn_mfma_f32_16x16x32_f16(ka0, *(const h16x8*)(vsT + (16 * vt + lr) * 72 + 8 * lq), Sacc[vt], 0, 0, 0);
                Sacc[vt] = __builtin_amdgcn_mfma_f32_16x16x32_f16(ka1, *(const h16x8*)(vsT + (16 * vt + lr) * 72 + 32 + 8 * lq), Sacc[vt], 0, 0, 0);
                h16x4 sh;
#pragma unroll
                for (int r = 0; r < 4; ++r) sh[r] = (h16)Sacc[vt][r];
                *(h16x4*)(ST + (16 * vt + lr) * 136 + 16 * wid + 4 * lq) = sh;
            }
        }
#undef GDN_LOAD
        float* so = a.out + O_PG + ((size_t)(b * 16 + hv) * 128 + 16 * wid + 4 * lq) * 128 + v0 + lr;
#pragma unroll
        for (int vt = 0; vt < 4; ++vt)
#pragma unroll
            for (int r = 0; r < 4; ++r) so[(size_t)r * 128 + 16 * vt] = Sacc[vt][r];
    }
}

__device__ __forceinline__ void phase_gdn_gate(const Args& a) {
    const int lane = threadIdx.x & 63, wid = threadIdx.x >> 6;
    const h16* obuf = (const h16*)(a.ws + WS_OBUF); const h16* z = (const h16*)(a.ws + WS_Z); h16* og = (h16*)(a.ws + WS_OG);
    const f32x4 gw0 = *(const f32x4*)(a.in[I_GNW] + (lane & 15) * 8), gw1 = *(const f32x4*)(a.in[I_GNW] + (lane & 15) * 8 + 4);
    for (int row = blockIdx.x * 8 + wid; row < NR; row += gridDim.x * 8) {
        f32x4 o0[4], o1[4]; h16x8 zz[4], oh[4];
#pragma unroll
        for (int j = 0; j < 4; ++j) { const size_t e = (size_t)row * 2048 + j * 512 + lane * 8; oh[j] = *(const h16x8*)(obuf + e); zz[j] = *(const h16x8*)(z + e); }
#pragma unroll
        for (int j = 0; j < 4; ++j) { o0[j] = (f32x4){(float)oh[j][0], (float)oh[j][1], (float)oh[j][2], (float)oh[j][3]}; o1[j] = (f32x4){(float)oh[j][4], (float)oh[j][5], (float)oh[j][6], (float)oh[j][7]}; }
#pragma unroll
        for (int j = 0; j < 4; ++j) {
            const float ss = red16(sq4(o0[j]) + sq4(o1[j]));
            const float sc = rsqrtf(ss * (1.0f / 128.0f) + 1e-6f);
            h16x8 r;
#pragma unroll
            for (int i = 0; i < 4; ++i) { r[i] = (h16)(o0[j][i] * sc * gw0[i] * siluf_((float)zz[j][i])); r[4 + i] = (h16)(o1[j][i] * sc * gw1[i] * siluf_((float)zz[j][4 + i])); }
            *(h16x8*)(og + (size_t)row * 2048 + j * 512 + lane * 8) = r;
        }
    }
}

__device__ __forceinline__ void phase_shift(const Args& a) {
    const int lane = threadIdx.x & 63, wid = threadIdx.x >> 6;
    const float* x1 = (const float*)(a.ws + WS_X1); h16* xs = (h16*)(a.ws + WS_XS);
    const float* nw = a.in[I_NW] + DM; const float* mu = a.in[I_MU];
    for (int pr = blockIdx.x * 8 + wid; pr < NR / 2; pr += gridDim.x * 8) {
        const int row = pr * 2;
        int b, t; bool samp; row_bt(row, b, t, samp);
        f32x4 xa[4], xb[4], xp[4];
#pragma unroll
        for (int i = 0; i < 4; ++i) { xa[i] = *(const f32x4*)(x1 + (size_t)row * DM + i * 256 + lane * 4); xb[i] = *(const f32x4*)(x1 + (size_t)(row + 1) * DM + i * 256 + lane * 4); }
        if (t > 0) {
#pragma unroll
            for (int i = 0; i < 4; ++i) xp[i] = *(const f32x4*)(x1 + (size_t)(row - 1) * DM + i * 256 + lane * 4); }
        else if (samp) {
#pragma unroll
            for (int i = 0; i < 4; ++i) xp[i] = *(const f32x4*)(a.in[I_SRS] + (size_t)b * DM + i * 256 + lane * 4); }
        else {
#pragma unroll
            for (int i = 0; i < 4; ++i) xp[i] = (f32x4){0.f, 0.f, 0.f, 0.f}; }
        float sa = 0.f, sb = 0.f, sp = 0.f;
#pragma unroll
        for (int i = 0; i < 4; ++i) { sa += sq4(xa[i]); sb += sq4(xb[i]); sp += sq4(xp[i]); }
        sa = wsum(sa); sb = wsum(sb);
        const float ca = rsqrtf(sa * (1.0f / 1024.0f) + 1e-6f), cb = rsqrtf(sb * (1.0f / 1024.0f) + 1e-6f);
        float cp = 1.0f;
        if (t > 0) { sp = wsum(sp); cp = rsqrtf(sp * (1.0f / 1024.0f) + 1e-6f); }
#pragma unroll
        for (int i = 0; i < 4; ++i) { const f32x4 w = *(const f32x4*)(nw + i * 256 + lane * 4); xa[i] = xa[i] * ca * w; xb[i] = xb[i] * cb * w; if (t > 0) xp[i] = xp[i] * cp * w; }
        for (int s = 0; s < 6; ++s) {
#pragma unroll
            for (int i = 0; i < 4; ++i) { const f32x4 m = *(const f32x4*)(mu + (size_t)s * DM + i * 256 + lane * 4);
                const f32x4 r0 = xa[i] + (xp[i] - xa[i]) * m, r1 = xb[i] + (xa[i] - xb[i]) * m;
                h16x4 o0, o1; o0[0] = (h16)r0[0]; o0[1] = (h16)r0[1]; o0[2] = (h16)r0[2]; o0[3] = (h16)r0[3]; o1[0] = (h16)r1[0]; o1[1] = (h16)r1[1]; o1[2] = (h16)r1[2]; o1[3] = (h16)r1[3];
                *(h16x4*)(xs + ((size_t)s * MP + row) * DM + i * 256 + lane * 4) = o0; *(h16x4*)(xs + ((size_t)s * MP + row + 1) * DM + i * 256 + lane * 4) = o1; }
        }
        float* so = nullptr;
        if (!samp && t == TP - 2) so = a.out + O_PRS + (size_t)b * DM;
        if (samp && t == 6) so = a.out + O_SRS + (size_t)b * DM;
        if (so) {
#pragma unroll
            for (int i = 0; i < 4; ++i) *(f32x4*)(so + i * 256 + lane * 4) = xb[i]; }
    }
}

__device__ __forceinline__ void phase_rwkv_prep(const Args& a) {
    const int lane = threadIdx.x & 63, wid = threadIdx.x >> 6;
    h16* rkvz = (h16*)(a.ws + WS_RKVZ); const h16* lo = (const h16*)(a.ws + WS_LOUT);
    float* dbuf = (float*)(a.ws + WS_DB); h16* kkb = (h16*)(a.ws + WS_KKB); h16* bbb = (h16*)(a.ws + WS_BBB); float* rkb = (float*)(a.ws + WS_RK); h16* k2b = (h16*)(a.ws + WS_K2);
    float pw0[2][8], pa0[2][8], pkk[2][8], pka[2][8], prk[2][8];
#pragma unroll
    for (int j = 0; j < 2; ++j)
#pragma unroll
        for (int i = 0; i < 8; ++i) { const int c = j * 512 + lane * 8 + i; pw0[j][i] = a.in[I_W0][c]; pa0[j][i] = a.in[I_A0][c]; pkk[j][i] = a.in[I_KK][c]; pka[j][i] = a.in[I_KA][c]; prk[j][i] = a.in[I_RK][c]; }
    for (int row = blockIdx.x * 8 + wid; row < NR; row += gridDim.x * 8) {
        h16x8 r[2], k[2], wl[2], al[2];
#pragma unroll
        for (int j = 0; j < 2; ++j) { const size_t e = (size_t)row * 1024 + j * 512 + lane * 8; const size_t e2 = (size_t)row * 2048 + j * 512 + lane * 8;
            r[j] = *(const h16x8*)(rkvz + e); k[j] = *(const h16x8*)(rkvz + (size_t)MP * 1024 + e); wl[j] = *(const h16x8*)(lo + e2); al[j] = *(const h16x8*)(lo + e2 + 1024); }
#pragma unroll
        for (int j = 0; j < 2; ++j) {
            float kkv[8], aa[8], dd[8]; h16x8 k2o; float ss = 0.f, rk = 0.f;
#pragma unroll
            for (int i = 0; i < 8; ++i) {
                const float w = -softplusf_(-(pw0[j][i] + (float)wl[j][i])) - 0.5f;
                dd[i] = expf(-expf(w));
                aa[i] = sigmoidf_(pa0[j][i] + (float)al[j][i]);
                const float kf = (float)k[j][i];
                kkv[i] = kf * pkk[j][i]; ss += kkv[i] * kkv[i];
                const float k2 = kf * (1.0f + (aa[i] - 1.0f) * pka[j][i]);
                rk += (float)r[j][i] * k2 * prk[j][i];
                k2o[i] = (h16)k2;
            }
            ss = red8(ss); rk = red8(rk);
            const float inv = rsqrtf(ss + 1e-6f);
            h16x8 kko, bbo;
#pragma unroll
            for (int i = 0; i < 8; ++i) { const float kk = kkv[i] * inv; kko[i] = (h16)kk; bbo[i] = (h16)(kk * aa[i]); }
            const size_t e = (size_t)row * 1024 + j * 512 + lane * 8;
            *(h16x8*)(k2b + e) = k2o; *(h16x8*)(kkb + e) = kko; *(h16x8*)(bbb + e) = bbo;
            *(f32x4*)(dbuf + e) = (f32x4){dd[0], dd[1], dd[2], dd[3]}; *(f32x4*)(dbuf + e + 4) = (f32x4){dd[4], dd[5], dd[6], dd[7]};
            if ((lane & 7) == 0) rkb[(size_t)row * 16 + j * 8 + (lane >> 3)] = rk;
        }
    }
}

__device__ __forceinline__ void phase_rwkv_scan(const Args& a, float* ldsf) {
    const int tid = threadIdx.x, lane = tid & 63, wid = tid >> 6;
    const bool prod = wid >= 4;
    const int rl = lane >> 3, kq = lane & 7;
    const int st = tid & 255, stt = st >> 4, sc4 = (st & 15) * 4;
    const h16* rkvz = (const h16*)(a.ws + WS_RKVZ); const float* dbuf = (const float*)(a.ws + WS_DB); const h16* k2b = (const h16*)(a.ws + WS_K2);
    const h16* kkb = (const h16*)(a.ws + WS_KKB); const h16* bbb = (const h16*)(a.ws + WS_BBB);
    float* ybuf = (float*)(a.ws + WS_YBUF);
    for (int it = blockIdx.x; it < 256 + 4096; it += gridDim.x) {
        const bool samp = it >= 256; const int q = samp ? it - 256 : it;
        const int seq = q >> 1, half = q & 1, b = seq >> 4, h = seq & 15;
        const int T = samp ? 8 : TP, row0 = samp ? NPR + b * 8 : b * TP;
        const int v = half * 32 + (wid & 3) * 8 + rl;
        f32x2 S[4];
        if (!prod && samp) { const float* sp = a.in[I_SR] + ((size_t)(b * 16 + h) * 64 + v) * 64 + kq * 8; const f32x4 s0 = *(const f32x4*)sp, s1 = *(const f32x4*)(sp + 4);
            S[0] = (f32x2){s0[0], s0[1]}; S[1] = (f32x2){s0[2], s0[3]}; S[2] = (f32x2){s1[0], s1[1]}; S[3] = (f32x2){s1[2], s1[3]}; }
        else {
#pragma unroll
            for (int i = 0; i < 4; ++i) S[i] = (f32x2){0.f, 0.f}; }
        h16x4 pr = {}, pk = {}, pv = {}, pkk = {}, pb = {}; f32x4 pd = {0.f, 0.f, 0.f, 0.f};
        if (prod && stt < T) { const size_t e = (size_t)(row0 + stt) * 1024 + h * 64 + sc4;
            pr = *(const h16x4*)(rkvz + e); pk = *(const h16x4*)(k2b + e); pv = *(const h16x4*)(rkvz + (size_t)2 * MP * 1024 + e); pd = *(const f32x4*)(dbuf + e); pkk = *(const h16x4*)(kkb + e); pb = *(const h16x4*)(bbb + e); }
        __syncthreads();
        int cur = 0;
        for (int t0 = 0; t0 < T; t0 += 16) {
            float* Lb = ldsf + cur * 6144;
            if (prod) {
                float* p = Lb + stt * 64 + sc4;
                *(f32x4*)p = (f32x4){(float)pr[0], (float)pr[1], (float)pr[2], (float)pr[3]};
                *(f32x4*)(p + 1024) = (f32x4){(float)pk[0], (float)pk[1], (float)pk[2], (float)pk[3]};
                *(f32x4*)(p + 2048) = pd;
                *(f32x4*)(p + 3072) = (f32x4){(float)pkk[0], (float)pkk[1], (float)pkk[2], (float)pkk[3]};
                *(f32x4*)(p + 4096) = (f32x4){(float)pb[0], (float)pb[1], (float)pb[2], (float)pb[3]};
                *(f32x4*)(p + 5120) = (f32x4){(float)pv[0], (float)pv[1], (float)pv[2], (float)pv[3]};
            }
            __syncthreads();
            if (prod) {
                if (t0 + 16 + stt < T) { const size_t e = (size_t)(row0 + t0 + 16 + stt) * 1024 + h * 64 + sc4;
                    pr = *(const h16x4*)(rkvz + e); pk = *(const h16x4*)(k2b + e); pv = *(const h16x4*)(rkvz + (size_t)2 * MP * 1024 + e); pd = *(const f32x4*)(dbuf + e); pkk = *(const h16x4*)(kkb + e); pb = *(const h16x4*)(bbb + e); }
            } else {
                for (int hh = 0; hh < 2; ++hh) {
                    if (t0 + hh * 8 >= T) break;
                    float yv[8];
                    f32x4 Rr0[2], Rr1[2], Rk0[2], Rk1[2], Rd0[2], Rd1[2], Rq0[2], Rq1[2], Rb0[2], Rb1[2]; float Rv[2];
#define RW_LOAD(slot, idx) do { const float* p_ = Lb + (idx) * 64 + kq * 8; \
                        Rq0[slot] = *(const f32x4*)(p_ + 3072); Rq1[slot] = *(const f32x4*)(p_ + 3076); Rd0[slot] = *(const f32x4*)(p_ + 2048); Rd1[slot] = *(const f32x4*)(p_ + 2052); \
                        Rb0[slot] = *(const f32x4*)(p_ + 4096); Rb1[slot] = *(const f32x4*)(p_ + 4100); Rk0[slot] = *(const f32x4*)(p_ + 1024); Rk1[slot] = *(const f32x4*)(p_ + 1028); \
                        Rr0[slot] = *(const f32x4*)p_; Rr1[slot] = *(const f32x4*)(p_ + 4); Rv[slot] = Lb[5120 + (idx) * 64 + v]; } while (0)
                    RW_LOAD(0, hh * 8);
#pragma unroll
                    for (int t8 = 0; t8 < 8; ++t8) {
                        const int sl = t8 & 1;
                        if (t8 < 7) RW_LOAD(sl ^ 1, hh * 8 + t8 + 1);
                        __builtin_amdgcn_sched_barrier(0);
                        const f32x4 r0 = Rr0[sl], r1 = Rr1[sl], k0 = Rk0[sl], k1 = Rk1[sl], d0 = Rd0[sl], d1 = Rd1[sl], q0 = Rq0[sl], q1 = Rq1[sl], b0 = Rb0[sl], b1 = Rb1[sl];
                        const float vv = Rv[sl];
                        f32x2 sa2 = S[0] * (f32x2){q0[0], q0[1]} + S[1] * (f32x2){q0[2], q0[3]};
                        f32x2 sb2 = S[2] * (f32x2){q1[0], q1[1]} + S[3] * (f32x2){q1[2], q1[3]};
                        sa2 = sa2 + sb2;
                        const float nsa = -red8(sa2[0] + sa2[1]);
                        S[0] = S[0] * (f32x2){d0[0], d0[1]} + nsa * (f32x2){b0[0], b0[1]} + vv * (f32x2){k0[0], k0[1]};
                        S[1] = S[1] * (f32x2){d0[2], d0[3]} + nsa * (f32x2){b0[2], b0[3]} + vv * (f32x2){k0[2], k0[3]};
                        S[2] = S[2] * (f32x2){d1[0], d1[1]} + nsa * (f32x2){b1[0], b1[1]} + vv * (f32x2){k1[0], k1[1]};
                        S[3] = S[3] * (f32x2){d1[2], d1[3]} + nsa * (f32x2){b1[2], b1[3]} + vv * (f32x2){k1[2], k1[3]};
                        f32x2 ya = S[0] * (f32x2){r0[0], r0[1]} + S[1] * (f32x2){r0[2], r0[3]};
                        f32x2 yb = S[2] * (f32x2){r1[0], r1[1]} + S[3] * (f32x2){r1[2], r1[3]};
                        ya = ya + yb;
                        yv[t8] = red8(ya[0] + ya[1]);
                    }
#undef RW_LOAD
                    float ysel = yv[0];
#pragma unroll
                    for (int t8 = 1; t8 < 8; ++t8) ysel = (kq == t8) ? yv[t8] : ysel;
                    ybuf[(size_t)(row0 + t0 + hh * 8 + kq) * 1024 + h * 64 + v] = ysel;
                }
            }
            cur ^= 1;
        }
        if (!prod) { float* so = a.out + (samp ? O_SR : O_PR) + ((size_t)(b * 16 + h) * 64 + v) * 64 + kq * 8;
            *(f32x4*)so = (f32x4){S[0][0], S[0][1], S[1][0], S[1][1]}; *(f32x4*)(so + 4) = (f32x4){S[2][0], S[2][1], S[3][0], S[3][1]}; }
    }
}

__device__ __forceinline__ void phase_rwkv_gate(const Args& a) {
    const int lane = threadIdx.x & 63, wid = threadIdx.x >> 6;
    const float* ybuf = (const float*)(a.ws + WS_YBUF); const float* rkb = (const float*)(a.ws + WS_RK);
    const h16* rkvz = (const h16*)(a.ws + WS_RKVZ); h16* yg = (h16*)(a.ws + WS_YG);
    float lw[2][8], lb[2][8];
#pragma unroll
    for (int j = 0; j < 2; ++j)
#pragma unroll
        for (int i = 0; i < 8; ++i) { const int c = j * 512 + lane * 8 + i; lw[j][i] = a.in[I_LNW][c]; lb[j][i] = a.in[I_LNB][c]; }
    for (int row = blockIdx.x * 8 + wid; row < NR; row += gridDim.x * 8) {
        f32x4 y0[2], y1[2]; h16x8 vv[2], zz[2]; float rk[2];
#pragma unroll
        for (int j = 0; j < 2; ++j) { const size_t e = (size_t)row * 1024 + j * 512 + lane * 8;
            y0[j] = *(const f32x4*)(ybuf + e); y1[j] = *(const f32x4*)(ybuf + e + 4); vv[j] = *(const h16x8*)(rkvz + (size_t)2 * MP * 1024 + e); zz[j] = *(const h16x8*)(rkvz + (size_t)3 * MP * 1024 + e);
            rk[j] = rkb[(size_t)row * 16 + j * 8 + (lane >> 3)]; }
#pragma unroll
        for (int j = 0; j < 2; ++j) {
            float y[8] = {y0[j][0], y0[j][1], y0[j][2], y0[j][3], y1[j][0], y1[j][1], y1[j][2], y1[j][3]};
            float sm = 0.f;
#pragma unroll
            for (int i = 0; i < 8; ++i) sm += y[i];
            const float mean = red8(sm) * (1.0f / 64.0f);
            float sv = 0.f;
#pragma unroll
            for (int i = 0; i < 8; ++i) { y[i] -= mean; sv += y[i] * y[i]; }
            const float rs = rsqrtf(red8(sv) * (1.0f / 64.0f) + 64e-5f);
            h16x8 o;
#pragma unroll
            for (int i = 0; i < 8; ++i) { const float yn = y[i] * rs * lw[j][i] + lb[j][i] + rk[j] * (float)vv[j][i]; o[i] = (h16)(yn * siluf_((float)zz[j][i])); }
            *(h16x8*)(yg + (size_t)row * 1024 + j * 512 + lane * 8) = o;
        }
    }
}

__device__ __forceinline__ void phase_final(const Args& a) {
    const int lane = threadIdx.x & 63, wid = threadIdx.x >> 6;
    const float* x2 = (const float*)(a.ws + WS_X2); const float* nw = a.in[I_FNW];
    for (int pr = blockIdx.x * 8 + wid; pr < NR / 2; pr += gridDim.x * 8) {
        const int row = pr * 2;
        int b, t; bool samp; row_bt(row, b, t, samp);
        if (!samp && t < 16) continue;
        float* op = samp ? a.out + O_YS + (size_t)(row - NPR) * DM : a.out + O_YP + ((size_t)b * 2048 + (t - 16)) * DM;
        const float* p = x2 + (size_t)row * DM; f32x4 v[4], u[4]; float ss = 0.f, su = 0.f;
#pragma unroll
        for (int i = 0; i < 4; ++i) { v[i] = *(const f32x4*)(p + i * 256 + lane * 4); u[i] = *(const f32x4*)(p + DM + i * 256 + lane * 4); }
#pragma unroll
        for (int i = 0; i < 4; ++i) { ss += sq4(v[i]); su += sq4(u[i]); }
        ss = wsum(ss); su = wsum(su);
        const float sc = rsqrtf(ss * (1.0f / 1024.0f) + 1e-6f), scu = rsqrtf(su * (1.0f / 1024.0f) + 1e-6f);
#pragma unroll
        for (int i = 0; i < 4; ++i) { const f32x4 w = *(const f32x4*)(nw + i * 256 + lane * 4); *(f32x4*)(op + i * 256 + lane * 4) = v[i] * sc * w; *(f32x4*)(op + DM + i * 256 + lane * 4) = u[i] * scu * w; }
    }
}

constexpr int NPHASE = 15;
#ifndef PROBE_MASK
#define PROBE_MASK 0
#endif
__global__ void __launch_bounds__(NTHREADS, 2) mk_fwd(Args a) {
    extern __shared__ __attribute__((aligned(16))) unsigned char smem[];
    PG8_LAS unsigned char* lds = (PG8_LAS unsigned char*)smem;
    float* ldsf = (float*)smem;
    const int G = gridDim.x, c = blockIdx.x;
#if MK_COOP
    cg::grid_group grid = cg::this_grid();
    __shared__ uint4 xb_words;
    if (threadIdx.x == 0) xb_words = make_uint4(0u, 0u, 0u, 0u);
    __syncthreads();
    const XcdBarrier xbar = xcd_barrier_post((unsigned*)(a.ws + WS_BAR), (volatile PG8_LAS unsigned*)&xb_words);
    if (a.ph_hi > 1000) grid.sync();
#define SEAM(p) do { if ((p) + 1 < a.ph_hi) xcd_barrier(xbar); } while (0)
#else
#define SEAM(p) do { } while (0)
#endif
#define IN(p) (a.ph_lo <= (p) && (p) < a.ph_hi)
#define RUN(p, ...) if (IN(p)) { __syncthreads(); __VA_ARGS__; if ((PROBE_MASK >> (p)) & 1) { __syncthreads(); __VA_ARGS__; } SEAM(p); }
    RUN(0, phase_prep(a, ldsf))
    RUN(1, { pg8::Gemm g{(const h16*)(a.ws + WS_XN0), (const h16*)(a.ws + WS_WIN), MP, 6400, 1024}; pg8::StaticOrder S; S.init(MP, 6400, G, c);
        EpiProj E{(h16*)(a.ws + WS_QKVPRE), (h16*)(a.ws + WS_Z), (float*)(a.ws + WS_BA)};
        pg8::gemm_phase<EpiProj, pg8::StaticOrder>(lds, g, S, E); })
    RUN(2, phase_conv(a, ldsf))
    RUN(3, phase_gdn_pre(a, ldsf))
    RUN(4, { phase_gdn_chunk_scan(a, smem); __syncthreads(); phase_gdn_scan(a, ldsf); })
    RUN(5, phase_gdn_gate(a))
    RUN(6, { pg8::Gemm g{(const h16*)(a.ws + WS_OG), (const h16*)(a.ws + WS_WOUT), MP, 1024, 2048}; pg8::StaticOrder S; S.init(MP, 1024, G, c);
        EpiResX E{a.in[I_META], a.in[I_XP], a.in[I_XS], (float*)(a.ws + WS_X1)};
        pg8::gemm_phase<EpiResX, pg8::StaticOrder>(lds, g, S, E); })
    RUN(7, phase_shift(a))
    RUN(8, { pg8::Gemm g{(const h16*)(a.ws + WS_XS), (const h16*)(a.ws + WS_WR), 6 * MP, 4608, 1024}; OrderG S; S.init(G, c);
        EpiG E{(h16*)(a.ws + WS_RKVZ), (h16*)(a.ws + WS_LH)};
        pg8::gemm_phase<EpiG, OrderG>(lds, g, S, E); })
    RUN(9, { pg8::Gemm g{(const h16*)(a.ws + WS_LH), (const h16*)(a.ws + WS_WL2), MP, 2048, 256}; pg8::StaticOrder S; S.init(MP, 2048, G, c);
        EpiH16 E{(h16*)(a.ws + WS_LOUT), 2048};
        pg8::gemm_phase<EpiH16, pg8::StaticOrder>(lds, g, S, E); })
    RUN(10, phase_rwkv_prep(a))
    RUN(11, phase_rwkv_scan(a, ldsf))
    RUN(12, phase_rwkv_gate(a))
    RUN(13, { pg8::Gemm g{(const h16*)(a.ws + WS_YG), (const h16*)(a.ws + WS_WO), MP, 1024, 1024}; pg8::StaticOrder S; S.init(MP, 1024, G, c);
        EpiResB E{(const float*)(a.ws + WS_X1), (float*)(a.ws + WS_X2)};
        pg8::gemm_phase<EpiResB, pg8::StaticOrder>(lds, g, S, E); })
    RUN(14, phase_final(a))
#undef RUN
#undef IN
#undef SEAM
}

extern "C" void kernel_launch(void* const* d_in, const int* in_sizes, int n_in, void* d_out, int out_size, void* d_ws, size_t ws_size, hipStream_t stream) {
    static int grid = 0;
    if (grid == 0) {
        if (n_in != 29 || ws_size < WS_END) { fprintf(stderr, "kernel_launch: unexpected n_in %d or ws_size %zu (< %zu)\n", n_in, ws_size, (size_t)WS_END); grid = -1; return; }
        int dev = 0, cus = 0, per_cu = 0;
        hipGetDevice(&dev); hipDeviceGetAttribute(&cus, hipDeviceAttributeMultiprocessorCount, dev);
        if (hipFuncSetAttribute((const void*)mk_fwd, hipFuncAttributeMaxDynamicSharedMemorySize, LDS_BYTES) != hipSuccess) { fprintf(stderr, "kernel_launch: hipFuncSetAttribute failed\n"); }
        if (hipOccupancyMaxActiveBlocksPerMultiprocessor(&per_cu, (const void*)mk_fwd, NTHREADS, LDS_BYTES) != hipSuccess || per_cu < 1) { fprintf(stderr, "kernel_launch: occupancy query gave %d\n", per_cu); per_cu = 1; }
        (void)hipGetLastError();
        grid = cus * 1;
        if (grid <= 0) grid = 256;
    }
    if (grid < 0) return;
    Args a; memset(&a, 0, sizeof(a));
    for (int i = 0; i < 29; ++i) a.in[i] = (const float*)d_in[i];
    a.out = (float*)d_out; a.ws = (unsigned char*)d_ws;
#if MK_COOP
    a.ph_lo = 0; a.ph_hi = NPHASE;
    if (hipMemsetAsync((unsigned char*)d_ws + WS_BAR, 0, 16384, stream) != hipSuccess) fprintf(stderr, "kernel_launch: memset of barrier words failed\n");
    void* args[] = {&a};
    hipError_t e = hipLaunchCooperativeKernel((const void*)mk_fwd, dim3(grid), dim3(NTHREADS), args, LDS_BYTES, stream);
    if (e != hipSuccess) fprintf(stderr, "cooperative launch failed: %s (grid %d)\n", hipGetErrorString(e), grid);
#else
    for (int p = 0; p < NPHASE; ++p) { a.ph_lo = p; a.ph_hi = p + 1; hipLaunchKernelGGL(mk_fwd, dim3(grid), dim3(NTHREADS), LDS_BYTES, stream, a); }
#endif
}
```

```cpp
#include <hip/hip_runtime.h>
#include <hip/hip_cooperative_groups.h>
#include <cstdio>
#include <cstring>
namespace cg = cooperative_groups;

#ifndef MK_COOP
#define MK_COOP 1
#endif

typedef _Float16 h16;
typedef _Float16 h16x8 __attribute__((ext_vector_type(8)));
typedef _Float16 h16x4 __attribute__((ext_vector_type(4)));
typedef _Float16 h16x2 __attribute__((ext_vector_type(2)));
typedef float f32x4 __attribute__((ext_vector_type(4)));
typedef float f32x2 __attribute__((ext_vector_type(2)));

namespace pg8 {
#define PG8_LAS __attribute__((address_space(3)))
constexpr int BM = 256, BK = 64, HALF = 128, HTB = HALF * BK * 2, STAGE_BYTES = 8 * HTB, NXCD = 8, WGM = 8;
__host__ __device__ __forceinline__ int lds_byte(int r, int c) { const int st = (r >> 4) * 2 + (c >> 5), rr = r & 15, cc = c & 31, ob = rr * 64 + cc * 2; return st * 1024 + (ob ^ (((ob >> 9) & 1) << 5)); }
__host__ __device__ __forceinline__ void stage_rc(int b, int& R, int& C) { const int st = b / 1024, sb = b % 1024, swz = sb ^ (((sb >> 9) & 1) << 5); R = (st >> 1) * 16 + swz / 64; C = (st & 1) * 32 + (swz % 64) / 2; }
__host__ __device__ __forceinline__ int perm32(int rho) { const int n = rho >> 4, i = rho & 15; return 8 * (i >> 2) + 4 * n + (i & 3); }
struct Unit { int pm, pn; };
struct Gemm { const h16* A; const h16* Bt; int M, N, K; };
struct StaticOrder {
    int nM, nN, nwg, G, c;
    __host__ __device__ void init(int M, int N, int G_, int c_) { nM = M / BM; nN = N / BM; nwg = nM * nN; G = G_; c = c_; }
    __host__ __device__ bool next(int i, Unit& u) const {
        const long L = (long)i * G + c; if (L >= nwg) return false;
        int wgid = (int)L; { const int q = nwg / NXCD, r = nwg % NXCD, xcd = wgid % NXCD, off = wgid / NXCD; wgid = (xcd < r ? xcd * (q + 1) : r * (q + 1) + (xcd - r) * q) + off; }
        const int nig = WGM * nN, gid = wgid / nig, fm = gid * WGM, gsz = (nM - fm) < WGM ? (nM - fm) : WGM;
        u.pm = fm + ((wgid % nig) % gsz); u.pn = (wgid % nig) / gsz; return true;
    }
};

template <class Epi, class Sched>
__device__ __forceinline__ void gemm_phase(PG8_LAS unsigned char* lds, const Gemm g, const Sched& S, const Epi& E) {
    const int tid = threadIdx.x, wid = __builtin_amdgcn_readfirstlane(tid >> 6), lane = tid & 63, wr = wid >> 2, wc = wid & 3, fr = lane & 15, fq = lane >> 4;
    const int K = g.K, nt = K / BK;
    unsigned voffA[2], voffB[2];
#pragma unroll
    for (int i = 0; i < 2; ++i) { int R, C; stage_rc(tid * 16 + i * 8192, R, C); const int Rb = Epi::PERM ? ((R & ~31) + perm32(R & 31)) : R;
        voffA[i] = (unsigned)(R * K + C) * 2u; voffB[i] = (unsigned)(Rb * K + C) * 2u; }
    const size_t kstep = (size_t)(BK * 2);
    const size_t hstep = (size_t)HALF * K * 2;
    const size_t tstep = 2 * hstep;
    const unsigned ldsw = (unsigned)wid * 1024u;
    const int aoff = lds_byte(wr * 64 + fr, fq * 8), boff = lds_byte(wc * 32 + fr, fq * 8);
#define PG8_SA(b, h) (((b) * 2 + (h)) * HTB)
#define PG8_SB(b, h) ((4 + (b) * 2 + (h)) * HTB)
#define PG8_STAGE(bufoff, gbase, voff) do { _Pragma("unroll") for (int _i = 0; _i < 2; ++_i) \
        __builtin_amdgcn_global_load_lds((const unsigned*)((const char*)(gbase) + (voff)[_i]), (PG8_LAS unsigned*)(lds + (bufoff) + ldsw + _i * 8192), 16, 0, 0); } while (0)
#define PG8_LDA(dst, b, h) do { _Pragma("unroll") for (int m = 0; m < 4; ++m) _Pragma("unroll") for (int k = 0; k < 2; ++k) dst[m][k] = *(const PG8_LAS h16x8*)(lds + PG8_SA(b, h) + aoff + m * 2048 + k * 1024); } while (0)
#define PG8_LDB(dst, b, h) do { _Pragma("unroll") for (int n = 0; n < 2; ++n) _Pragma("unroll") for (int k = 0; k < 2; ++k) dst[n][k] = *(const PG8_LAS h16x8*)(lds + PG8_SB(b, h) + boff + n * 2048 + k * 1024); } while (0)
#define PG8_MMA(ai, bj, At, Bt) do { __builtin_amdgcn_s_setprio(1); _Pragma("unroll") for (int m = 0; m < 4; ++m) _Pragma("unroll") for (int n = 0; n < 2; ++n) _Pragma("unroll") for (int k = 0; k < 2; ++k) \
        acc[ai][bj][m][n] = __builtin_amdgcn_mfma_f32_16x16x32_f16(Bt[n][k], At[m][k], acc[ai][bj][m][n], 0, 0, 0); __builtin_amdgcn_s_setprio(0); } while (0)
#define PG8_WAIT_V(n) asm volatile("s_waitcnt vmcnt(" #n ")" ::: "memory")
#define PG8_WAIT_L(n) asm volatile("s_waitcnt lgkmcnt(" #n ")" ::: "memory")
#define PG8_BAR __builtin_amdgcn_s_barrier()
#define PG8_SCHED __builtin_amdgcn_sched_barrier(0)
    Unit cur, nxt; int ui = 0;
    if (!S.next(0, cur)) return;
    f32x4 acc[2][2][4][2];
#pragma unroll
    for (int a = 0; a < 2; ++a)
#pragma unroll
        for (int b = 0; b < 2; ++b)
#pragma unroll
            for (int m = 0; m < 4; ++m)
#pragma unroll
                for (int n = 0; n < 2; ++n) acc[a][b][m][n] = (f32x4){0.f, 0.f, 0.f, 0.f};
    h16x8 At[4][2], B0[2][2], B1[2][2];
    const char* cA = (const char*)g.A + (size_t)cur.pm * tstep; const char* cB = (const char*)g.Bt + (size_t)cur.pn * tstep;
    PG8_STAGE(PG8_SB(0, 0), cB, voffB); PG8_STAGE(PG8_SA(0, 0), cA, voffA); PG8_STAGE(PG8_SB(0, 1), cB + hstep, voffB); PG8_STAGE(PG8_SA(0, 1), cA + hstep, voffA);
    if (wr == 1) PG8_BAR;
    PG8_WAIT_V(4); PG8_BAR;
    PG8_STAGE(PG8_SB(1, 0), cB + kstep, voffB); PG8_STAGE(PG8_SA(1, 0), cA + kstep, voffA); PG8_STAGE(PG8_SB(1, 1), cB + hstep + kstep, voffB);
    PG8_WAIT_V(6); PG8_BAR;
    for (;;) {
        const bool has_next = S.next(ui + 1, nxt);
        const char* nA = has_next ? (const char*)g.A + (size_t)nxt.pm * tstep : cA; const char* nB = has_next ? (const char*)g.Bt + (size_t)nxt.pn * tstep : cB;
        for (int t = 0; t < nt; t += 2) {
            const bool last = (t == nt - 2);
            const char* a1 = cA + (size_t)(t + 1) * kstep;
            const char* a2 = last ? nA : cA + (size_t)(t + 2) * kstep; const char* b2 = last ? nB : cB + (size_t)(t + 2) * kstep;
            const char* a3 = a2 + kstep; const char* b3 = b2 + kstep;
            PG8_LDB(B0, 0, 0); PG8_SCHED; PG8_LDA(At, 0, 0); PG8_STAGE(PG8_SA(1, 1), a1 + hstep, voffA);
            PG8_WAIT_L(8); PG8_BAR; PG8_WAIT_L(0); PG8_MMA(0, 0, At, B0); PG8_BAR; PG8_SCHED;
            PG8_LDB(B1, 0, 1); PG8_STAGE(PG8_SB(0, 0), b2, voffB);
            PG8_BAR; PG8_WAIT_L(0); PG8_MMA(0, 1, At, B1); PG8_BAR;
            PG8_LDA(At, 0, 1); PG8_STAGE(PG8_SA(0, 0), a2, voffA);
            PG8_BAR; PG8_WAIT_L(0); PG8_MMA(1, 0, At, B0); PG8_BAR; PG8_SCHED;
            PG8_STAGE(PG8_SB(0, 1), b2 + hstep, voffB);
            PG8_WAIT_V(6); PG8_BAR; PG8_MMA(1, 1, At, B1); PG8_BAR;
            PG8_LDB(B0, 1, 0); PG8_SCHED; PG8_LDA(At, 1, 0); PG8_STAGE(PG8_SA(0, 1), a2 + hstep, voffA);
            PG8_WAIT_L(8); PG8_BAR; PG8_WAIT_L(0); PG8_MMA(0, 0, At, B0); PG8_BAR; PG8_SCHED;
            PG8_LDB(B1, 1, 1); PG8_STAGE(PG8_SB(1, 0), b3, voffB);
            PG8_BAR; PG8_WAIT_L(0); PG8_MMA(0, 1, At, B1); PG8_BAR;
            PG8_LDA(At, 1, 1); PG8_STAGE(PG8_SA(1, 0), a3, voffA);
            PG8_BAR; PG8_WAIT_L(0); PG8_MMA(1, 0, At, B0); PG8_BAR; PG8_SCHED;
            PG8_STAGE(PG8_SB(1, 1), b3 + hstep, voffB);
            PG8_WAIT_V(6); PG8_BAR; PG8_MMA(1, 1, At, B1); PG8_BAR;
        }
        E(acc, cur, wr, wc, fr, fq);
        if (!has_next) break;
#pragma unroll
        for (int a = 0; a < 2; ++a)
#pragma unroll
            for (int b = 0; b < 2; ++b)
#pragma unroll
                for (int m = 0; m < 4; ++m)
#pragma unroll
                    for (int n = 0; n < 2; ++n) acc[a][b][m][n] = (f32x4){0.f, 0.f, 0.f, 0.f};
        cur = nxt; cA = nA; cB = nB; ++ui;
    }
    PG8_WAIT_V(0);
    if (wr == 0) PG8_BAR;
    PG8_BAR;
#undef PG8_SA
#undef PG8_SB
#undef PG8_STAGE
#undef PG8_LDA
#undef PG8_LDB
#undef PG8_MMA
#undef PG8_WAIT_V
#undef PG8_WAIT_L
#undef PG8_BAR
#undef PG8_SCHED
}
}

constexpr int DM = 1024, TP = 2064, NPR = 8 * TP  , NR = NPR + 1024  , MP = 17664  , MT = 69;
constexpr int NTHREADS = 512, LDS_BYTES = pg8::STAGE_BYTES;
constexpr size_t UB = (size_t)MP * 1024 * 2;
constexpr size_t WS_WIN = 0;
constexpr size_t WS_WOUT = WS_WIN + (size_t)6400 * 1024 * 2;
constexpr size_t WS_WR = WS_WOUT + (size_t)1024 * 2048 * 2;
constexpr size_t WS_WL2 = WS_WR + (size_t)4608 * 1024 * 2;
constexpr size_t WS_WO = WS_WL2 + (size_t)2048 * 256 * 2;
constexpr size_t WS_WEND = WS_WO + (size_t)1024 * 1024 * 2;
static_assert(WS_WEND <= UB, "weights fit one unit");
constexpr size_t WS_X1 = 1 * UB;
constexpr size_t WS_QKVPRE = 3 * UB;
constexpr size_t WS_OBUF = 3 * UB;
constexpr size_t WS_UT = 1 * UB;
constexpr size_t WS_WW = 5 * UB;
constexpr size_t WS_AQ = 13 * UB;
constexpr size_t WS_XS = 3 * UB;
constexpr size_t WS_LOUT = 3 * UB;
constexpr size_t WS_X2 = 3 * UB;
constexpr size_t WS_YBUF = 3 * UB;
constexpr size_t WS_DB = 5 * UB;
constexpr size_t WS_KKB = 7 * UB;
constexpr size_t WS_BBB = 8 * UB;
constexpr size_t WS_Z = 7 * UB;
constexpr size_t WS_K2 = 13 * UB;
constexpr size_t WS_YG = 13 * UB;
constexpr size_t WS_QKV = 9 * UB;
constexpr size_t WS_OG = 9 * UB;
constexpr size_t WS_RKVZ = 9 * UB;
constexpr size_t WS_XN0 = 13 * UB;
constexpr size_t WS_BA = 14 * UB;
constexpr size_t WS_GB = WS_BA + (size_t)MP * 32 * 4;
constexpr size_t WS_LH = WS_GB + (size_t)MP * 32 * 4;
constexpr size_t WS_RK = WS_LH + (size_t)MP * 256 * 2;
constexpr size_t WS_GC = WS_RK + (size_t)MP * 16 * 4;
constexpr size_t WS_BAR = WS_GC + (size_t)4224 * 64 * 4;
constexpr size_t WS_END = WS_BAR + 16384;
constexpr int NCH = 33, NITEM = 128 * NCH;
constexpr size_t O_YP = 0, O_YS = 16777216, O_PG = 17825792, O_PGC = 19922944, O_PR = 20021248, O_PRS = 20545536, O_SG = 20553728, O_SGC = 54108160, O_SR = 55681024, O_SRS = 64069632;

struct TJob { const float* src; h16* dst; int srcK, srcN, dst_ld, row0, nrows, col0, ncols, tile0; };
struct Args {
    const float* in[29];
    float* out; unsigned char* ws;
    int ph_lo, ph_hi;
};
constexpr int NTILES_PREP = 3648;
enum { I_XP = 0, I_XS, I_SG, I_SGC, I_SR, I_SRS, I_META, I_NW, I_FNW, I_WIN, I_CW, I_ALOG, I_DTB, I_GNW, I_WOUT, I_MU, I_WRKVZ, I_W0, I_W1, I_W2, I_A0, I_A1, I_A2, I_KK, I_KA, I_RK, I_LNW, I_LNB, I_WO };

__device__ __forceinline__ float wave_sum(float v) {
#pragma unroll
    for (int o = 32; o > 0; o >>= 1) v += __shfl_xor(v, o);
    return v;
}
#define DPP_ADD(x, ctrl) ((x) + __builtin_bit_cast(float, __builtin_amdgcn_update_dpp(0, __builtin_bit_cast(int, (x)), (ctrl), 0xF, 0xF, true)))
__device__ __forceinline__ float red8(float x) { x = DPP_ADD(x, 0xB1); x = DPP_ADD(x, 0x4E); x = DPP_ADD(x, 0x141); return x; }
__device__ __forceinline__ float red16(float x) { x = DPP_ADD(x, 0xB1); x = DPP_ADD(x, 0x4E); x = DPP_ADD(x, 0x141); x = DPP_ADD(x, 0x140); return x; }
__device__ __forceinline__ float wsum(float x) { x = red16(x); x += __shfl_xor(x, 16); x += __shfl_xor(x, 32); return x; }
__device__ __forceinline__ float sq4(const f32x4 v) { return v[0] * v[0] + v[1] * v[1] + v[2] * v[2] + v[3] * v[3]; }
__device__ __forceinline__ float fexp_(float x) { return __builtin_amdgcn_exp2f(x * 1.4426950408889634f); }
__device__ __forceinline__ float sigmoidf_(float x) { return __builtin_amdgcn_rcpf(1.0f + fexp_(-x)); }
__device__ __forceinline__ float siluf_(float x) { return x * __builtin_amdgcn_rcpf(1.0f + fexp_(-x)); }
__device__ __forceinline__ float softplusf_(float x) { if (x > 20.0f) return x; const float t = fexp_(x); return t < 0.02f ? t * (1.0f - t * (0.5f - t * 0.33333334f)) : __builtin_amdgcn_logf(1.0f + t) * 0.6931471805599453f; }
__device__ __forceinline__ void row_bt(int r, int& b, int& t, bool& samp) {
    if (r < NPR) { b = r / TP; t = r - b * TP; samp = false; } else { const int q = r - NPR; b = q >> 3; t = q & 7; samp = true; }
}
__device__ __forceinline__ const float* xrow(const Args& a, int r) {
    if (r < NPR) { const int b = r / TP, t = r - b * TP; return t < 16 ? a.in[I_META] + (size_t)t * DM : a.in[I_XP] + ((size_t)b * 2048 + (t - 16)) * DM; }
    return a.in[I_XS] + (size_t)(r - NPR) * DM;
}
__device__ __forceinline__ h16x8 pack8(const f32x4 v0, const f32x4 v1) {
    h16x8 w; w[0] = (h16)v0[0]; w[1] = (h16)v0[1]; w[2] = (h16)v0[2]; w[3] = (h16)v0[3]; w[4] = (h16)v1[0]; w[5] = (h16)v1[1]; w[6] = (h16)v1[2]; w[7] = (h16)v1[3]; return w;
}


#define XB_TMO      128
#define XB_XCNT(j)  (256  + 64 * (j))
#define XB_XSUB(j)  (1280 + 64 * (j))
#define XB_XGEN(j)  (2304 + 64 * (j))
#define XB_TOP      3328
#define XB_TOPGEN   3392
#define XCD_BAR_WORDS 3456
#define XB_SPIN_CAP (1u << 20)
__device__ __forceinline__ unsigned xb_ld(unsigned* p)              { return __hip_atomic_load(p, __ATOMIC_RELAXED, __HIP_MEMORY_SCOPE_AGENT); }
__device__ __forceinline__ unsigned xb_add(unsigned* p, unsigned v) { return __hip_atomic_fetch_add(p, v, __ATOMIC_RELAXED, __HIP_MEMORY_SCOPE_AGENT); }
__device__ __forceinline__ unsigned xb_xcc_id() { return (unsigned)__builtin_amdgcn_s_getreg((3 << 11) | 20) & 0xFu; }
#define XB_SPIN(cond, bar) do { unsigned _sp = 0; while (cond) { __builtin_amdgcn_s_sleep(1); \
    if ((++_sp & 255u) == 0u) { if (xb_ld(&(bar)[XB_TMO])) break; if (_sp > XB_SPIN_CAP) { atomicAdd(&(bar)[XB_TMO], 1u); break; } } } } while (0)
struct XcdBarrier { unsigned* bar; unsigned x; volatile PG8_LAS unsigned* st; };
__device__ __forceinline__ XcdBarrier xcd_barrier_post(unsigned* bar, volatile PG8_LAS unsigned* st) {
    XcdBarrier b; b.bar = bar; b.x = xb_xcc_id(); b.st = st;
    if (threadIdx.x == 0) (void)xb_add(&bar[XB_XCNT(b.x)], 1u);
    return b;
}
__device__ __forceinline__ void xcd_barrier_complete(unsigned* bar, unsigned x, unsigned& nloc, unsigned& nx) {
    const unsigned G = gridDim.x * gridDim.y * gridDim.z;
    unsigned sum, cnt, mine, sp = 0u;
    for (;;) {
        sum = 0u; cnt = 0u; mine = 0u;
#pragma unroll
        for (unsigned j = 0; j < 16; ++j) { const unsigned c = xb_ld(&bar[XB_XCNT(j)]); sum += c; cnt += (c > 0u) ? 1u : 0u; mine = (j == x) ? c : mine; }
        if (sum == G) break;
        __builtin_amdgcn_s_sleep(1);
        if ((++sp & 255u) == 0u) { if (xb_ld(&bar[XB_TMO])) break; if (sp > XB_SPIN_CAP) { atomicAdd(&bar[XB_TMO], 1u); break; } }
    }
    nloc = mine > 0u ? mine : 1u; nx = cnt > 0u ? cnt : 1u;
}
__device__ __forceinline__ void xcd_barrier(const XcdBarrier& b) {
    asm volatile("s_waitcnt vmcnt(0)" ::: "memory");
    __syncthreads();
    if (threadIdx.x == 0) {
        unsigned* bar = b.bar;
        __builtin_amdgcn_s_waitcnt(0);
        unsigned nloc = b.st[0], nx = b.st[1];
        if (nloc == 0u) { xcd_barrier_complete(bar, b.x, nloc, nx); b.st[0] = nloc; b.st[1] = nx; }
        const unsigned old = xb_add(&bar[XB_XSUB(b.x)], 1u);
        const unsigned gen = old / nloc;
        if (old + 1u == (gen + 1u) * nloc) {
            __builtin_amdgcn_fence(__ATOMIC_RELEASE, "agent");
            asm volatile("s_waitcnt vmcnt(0)" ::: "memory");
            const unsigned og = xb_add(&bar[XB_TOP], 1u);
            const unsigned tg = og / nx;
            if (og + 1u == (tg + 1u) * nx) xb_add(&bar[XB_TOPGEN], 1u);
            else XB_SPIN(xb_ld(&bar[XB_TOPGEN]) == tg, bar);
            __builtin_amdgcn_fence(__ATOMIC_ACQUIRE, "agent");
            xb_add(&bar[XB_XGEN(b.x)], 1u);
            asm volatile("s_waitcnt vmcnt(0)" ::: "memory");
        } else {
            XB_SPIN(xb_ld(&bar[XB_XGEN(b.x)]) == gen, bar);
            __builtin_amdgcn_fence(__ATOMIC_ACQUIRE, "agent");
            asm volatile("s_waitcnt vmcnt(0)" ::: "memory");
        }
    }
    __syncthreads();
}

__device__ __forceinline__ void phase_prep(const Args& a, float* ldsf) {
    const int tid = threadIdx.x, lane = tid & 63, wid = tid >> 6;
    for (int tile = blockIdx.x; tile < NTILES_PREP; tile += gridDim.x) {
        TJob jb;
        { h16* Win = (h16*)(a.ws + WS_WIN); h16* Wout = (h16*)(a.ws + WS_WOUT); h16* Wr = (h16*)(a.ws + WS_WR); h16* Wl2 = (h16*)(a.ws + WS_WL2); h16* Wo = (h16*)(a.ws + WS_WO);
          if (tile < 1600)      jb = TJob{a.in[I_WIN], Win, 1024, 6176, 1024, 0, 6400, 0, 1024, 0};
          else if (tile < 2112) jb = TJob{a.in[I_WOUT], Wout, 2048, 1024, 2048, 0, 1024, 0, 2048, 1600};
          else if (tile < 3136) { const int s = (tile - 2112) >> 8; jb = TJob{a.in[I_WRKVZ] + (size_t)s * 1024 * 1024, Wr, 1024, 1024, 1024, s * 1024, 1024, 0, 1024, 2112 + s * 256}; }
          else if (tile < 3200) jb = TJob{a.in[I_W1], Wr, 1024, 64, 1024, 4096, 256, 0, 1024, 3136};
          else if (tile < 3264) jb = TJob{a.in[I_A1], Wr, 1024, 64, 1024, 4352, 256, 0, 1024, 3200};
          else if (tile < 3328) jb = TJob{a.in[I_W2], Wl2, 64, 1024, 256, 0, 1024, 0, 256, 3264};
          else if (tile < 3392) jb = TJob{a.in[I_A2], Wl2, 64, 1024, 256, 1024, 1024, 64, 256, 3328};
          else                  jb = TJob{a.in[I_WO], Wo, 1024, 1024, 1024, 0, 1024, 0, 1024, 3392}; }
        const int lt = tile - jb.tile0, nck = jb.ncols >> 6, tn = lt / nck, tk = lt - tn * nck;
        __syncthreads();
#pragma unroll
        for (int e = 0; e < 8; ++e) {
            const int idx = e * 512 + tid, kk = idx >> 6, nn = idx & 63;
            const int ks = tk * 64 + kk - jb.col0, ns = tn * 64 + nn;
            float v = 0.f;
            if (ks >= 0 && ks < jb.srcK && ns < jb.srcN) v = jb.src[(size_t)ks * jb.srcN + ns];
            ldsf[kk * 65 + nn] = v;
        }
        __syncthreads();
#pragma unroll
        for (int e = 0; e < 8; ++e) {
            const int idx = e * 512 + tid, nn = idx >> 6, kk = idx & 63;
            jb.dst[(size_t)(jb.row0 + tn * 64 + nn) * jb.dst_ld + tk * 64 + kk] = (h16)ldsf[kk * 65 + nn];
        }
    }
    h16* xn0 = (h16*)(a.ws + WS_XN0);
    const float* nw = a.in[I_NW];
    for (int row = blockIdx.x * 8 + wid; row < MP; row += gridDim.x * 8) {
        h16* op = xn0 + (size_t)row * DM;
        if (row >= NR) {
#pragma unroll
            for (int i = 0; i < 4; ++i) *(h16x4*)(op + i * 256 + lane * 4) = (h16x4){(h16)0.f, (h16)0.f, (h16)0.f, (h16)0.f};
            continue;
        }
        const float* xp = xrow(a, row);
        f32x4 v[4]; float ss = 0.f;
#pragma unroll
        for (int i = 0; i < 4; ++i) { v[i] = *(const f32x4*)(xp + i * 256 + lane * 4); ss += v[i][0] * v[i][0] + v[i][1] * v[i][1] + v[i][2] * v[i][2] + v[i][3] * v[i][3]; }
        ss = wave_sum(ss);
        const float sc = rsqrtf(ss * (1.0f / 1024.0f) + 1e-6f);
#pragma unroll
        for (int i = 0; i < 4; ++i) { const f32x4 w = *(const f32x4*)(nw + i * 256 + lane * 4); h16x4 o;
#pragma unroll
            for (int j = 0; j < 4; ++j) o[j] = (h16)(v[i][j] * sc * w[j]);
            *(h16x4*)(op + i * 256 + lane * 4) = o; }
    }
}

struct EpiProj {
    static constexpr bool PERM = true;
    h16* qkv; h16* z; float* ba;
    __device__ __forceinline__ void operator()(const f32x4 (&acc)[2][2][4][2], const pg8::Unit& u, int wr, int wc, int fr, int fq) const {
        const int row0 = u.pm * 256 + wr * 64 + fr;
        if (u.pn < 24) {
            h16* base = u.pn < 16 ? qkv : z; const int ld = u.pn < 16 ? 4096 : 2048; const int col0 = (u.pn < 16 ? u.pn : u.pn - 16) * 256 + wc * 32 + 8 * fq;
#pragma unroll
            for (int ai = 0; ai < 2; ++ai)
#pragma unroll
                for (int m = 0; m < 4; ++m) { h16* rowp = base + (size_t)(row0 + ai * 128 + m * 16) * ld + col0;
#pragma unroll
                    for (int bj = 0; bj < 2; ++bj) *(h16x8*)(rowp + bj * 128) = pack8(acc[ai][bj][m][0], acc[ai][bj][m][1]); }
        } else if (wc == 0) {
#pragma unroll
            for (int ai = 0; ai < 2; ++ai)
#pragma unroll
                for (int m = 0; m < 4; ++m) { float* rowp = ba + (size_t)(row0 + ai * 128 + m * 16) * 32 + 8 * fq;
                    *(f32x4*)rowp = acc[ai][0][m][0]; *(f32x4*)(rowp + 4) = acc[ai][0][m][1]; }
        }
    }
};
struct EpiH16 {
    static constexpr bool PERM = true;
    h16* O; int ld;
    __device__ __forceinline__ void operator()(const f32x4 (&acc)[2][2][4][2], const pg8::Unit& u, int wr, int wc, int fr, int fq) const {
        const int row0 = u.pm * 256 + wr * 64 + fr, col0 = u.pn * 256 + wc * 32 + 8 * fq;
#pragma unroll
        for (int ai = 0; ai < 2; ++ai)
#pragma unroll
            for (int m = 0; m < 4; ++m) { h16* rowp = O + (size_t)(row0 + ai * 128 + m * 16) * ld + col0;
#pragma unroll
                for (int bj = 0; bj < 2; ++bj) *(h16x8*)(rowp + bj * 128) = pack8(acc[ai][bj][m][0], acc[ai][bj][m][1]); }
    }
};
struct EpiResX {
    static constexpr bool PERM = false;
    const float* meta; const float* xpr; const float* xsm; float* O;
    __device__ __forceinline__ void operator()(const f32x4 (&acc)[2][2][4][2], const pg8::Unit& u, int wr, int wc, int fr, int fq) const {
        const int row0 = u.pm * 256 + wr * 64 + fr, col0 = u.pn * 256 + wc * 32 + 4 * fq;
#pragma unroll
        for (int ai = 0; ai < 2; ++ai)
#pragma unroll
            for (int m = 0; m < 4; ++m) { const int row = row0 + ai * 128 + m * 16; if (row >= NR) continue;
                const float* xp;
                if (row < NPR) { const int b = row / TP, t = row - b * TP; xp = t < 16 ? meta + (size_t)t * DM : xpr + ((size_t)b * 2048 + (t - 16)) * DM; } else xp = xsm + (size_t)(row - NPR) * DM;
                xp += col0; float* rowp = O + (size_t)row * DM + col0;
#pragma unroll
                for (int bj = 0; bj < 2; ++bj)
#pragma unroll
                    for (int n = 0; n < 2; ++n) *(f32x4*)(rowp + bj * 128 + n * 16) = *(const f32x4*)(xp + bj * 128 + n * 16) + acc[ai][bj][m][n]; }
    }
};
struct EpiResB {
    static constexpr bool PERM = false;
    const float* base; float* O;
    __device__ __forceinline__ void operator()(const f32x4 (&acc)[2][2][4][2], const pg8::Unit& u, int wr, int wc, int fr, int fq) const {
        const int row0 = u.pm * 256 + wr * 64 + fr, col0 = u.pn * 256 + wc * 32 + 4 * fq;
#pragma unroll
        for (int ai = 0; ai < 2; ++ai)
#pragma unroll
            for (int m = 0; m < 4; ++m) { const int row = row0 + ai * 128 + m * 16; if (row >= NR) continue;
                const float* xp = base + (size_t)row * DM + col0; float* rowp = O + (size_t)row * DM + col0;
#pragma unroll
                for (int bj = 0; bj < 2; ++bj)
#pragma unroll
                    for (int n = 0; n < 2; ++n) *(f32x4*)(rowp + bj * 128 + n * 16) = *(const f32x4*)(xp + bj * 128 + n * 16) + acc[ai][bj][m][n]; }
    }
};
struct EpiG {
    static constexpr bool PERM = true;
    h16* rkvz; h16* lh;
    __device__ __forceinline__ void operator()(const f32x4 (&acc)[2][2][4][2], const pg8::Unit& u, int wr, int wc, int fr, int fq) const {
        const int s = u.pm / MT, i = u.pm - s * MT, row0 = i * 256 + wr * 64 + fr;
        if (s < 4) {
            h16* base = rkvz + (size_t)s * MP * 1024; const int col0 = (u.pn - 4 * s) * 256 + wc * 32 + 8 * fq;
#pragma unroll
            for (int ai = 0; ai < 2; ++ai)
#pragma unroll
                for (int m = 0; m < 4; ++m) { h16* rowp = base + (size_t)(row0 + ai * 128 + m * 16) * 1024 + col0;
#pragma unroll
                    for (int bj = 0; bj < 2; ++bj) *(h16x8*)(rowp + bj * 128) = pack8(acc[ai][bj][m][0], acc[ai][bj][m][1]); }
        } else if (wc < 2) {
            const int cb = (s == 4 ? 0 : 64) + wc * 32 + 8 * fq;
#pragma unroll
            for (int ai = 0; ai < 2; ++ai)
#pragma unroll
                for (int m = 0; m < 4; ++m) { h16* rowp = lh + (size_t)(row0 + ai * 128 + m * 16) * 256;
                    f32x4 v0 = acc[ai][0][m][0], v1 = acc[ai][0][m][1];
                    if (s == 4) {
#pragma unroll
                        for (int j = 0; j < 4; ++j) { v0[j] = tanhf(v0[j]); v1[j] = tanhf(v1[j]); } }
                    *(h16x8*)(rowp + cb) = pack8(v0, v1);
                    *(h16x8*)(rowp + 128 + cb) = pack8((f32x4){0.f, 0.f, 0.f, 0.f}, (f32x4){0.f, 0.f, 0.f, 0.f}); }
        }
    }
};
struct OrderG {
    pg8::StaticOrder so; int G, c;
    __device__ void init(int G_, int c_) { so.init(4 * MT * 256, 1024, G_, c_); G = G_; c = c_; }
    __device__ bool next(int i, pg8::Unit& u) const {
        long L = (long)i * G + c;
        if (L < 4 * MT * 4) { pg8::Unit v; so.next(i, v); u.pm = v.pm; u.pn = (v.pm / MT) * 4 + v.pn; return true; }
        L -= 4 * MT * 4; if (L >= 2 * MT) return false;
        const int s = 4 + (int)(L / MT), ii = (int)(L % MT); u.pm = s * MT + ii; u.pn = 12 + s; return true;
    }
};

__device__ __forceinline__ void phase_conv(const Args& a, float* ldsf) {
    const int tid = threadIdx.x, lane = tid & 63, wid = tid >> 6;
    const h16* pre = (const h16*)(a.ws + WS_QKVPRE); h16* qkv = (h16*)(a.ws + WS_QKV);
    const float* ba = (const float*)(a.ws + WS_BA); float* gb = (float*)(a.ws + WS_GB);
    const float* cst = a.in[I_SGC];
    for (int i = tid; i < 4096; i += NTHREADS) { const f32x4 w = *(const f32x4*)(a.in[I_CW] + (size_t)i * 4); ldsf[i] = w[0]; ldsf[4096 + i] = w[1]; ldsf[8192 + i] = w[2]; ldsf[12288 + i] = w[3]; }
    __syncthreads();
    for (int row = blockIdx.x * 8 + wid; row < NR; row += gridDim.x * 8) {
        int b, t; bool samp; row_bt(row, b, t, samp);
        for (int half = 0; half < 2; ++half) {
            h16x8 x[4][4];
#pragma unroll
            for (int sg = 0; sg < 4; ++sg) {
                const int c0 = (half * 4 + sg) * 512 + lane * 8;
#pragma unroll
                for (int jj = 0; jj < 4; ++jj) {
                    const int idx = t + jj;
                    if (idx >= 3) x[sg][jj] = *(const h16x8*)(pre + (size_t)(row - 3 + jj) * 4096 + c0);
                    else if (samp) { const float* bp = cst + ((size_t)b * 3 + idx) * 4096 + c0; const f32x4 p0 = *(const f32x4*)bp, p1 = *(const f32x4*)(bp + 4); x[sg][jj] = pack8(p0, p1); }
                    else x[sg][jj] = pack8((f32x4){0.f, 0.f, 0.f, 0.f}, (f32x4){0.f, 0.f, 0.f, 0.f});
                }
            }
#pragma unroll
            for (int sg = 0; sg < 4; ++sg) {
                const int seg = half * 4 + sg, c0 = seg * 512 + lane * 8;
                float y[8];
#pragma unroll
                for (int j = 0; j < 8; ++j) y[j] = 0.f;
#pragma unroll
                for (int jj = 0; jj < 4; ++jj) { const f32x4 w0 = *(const f32x4*)(ldsf + jj * 4096 + c0), w1 = *(const f32x4*)(ldsf + jj * 4096 + c0 + 4);
#pragma unroll
                    for (int j = 0; j < 4; ++j) { y[j] += (float)x[sg][jj][j] * w0[j]; y[4 + j] += (float)x[sg][jj][4 + j] * w1[j]; } }
                float ss = 0.f;
#pragma unroll
                for (int j = 0; j < 8; ++j) { y[j] = siluf_(y[j]); ss += y[j] * y[j]; }
                float sc = 1.0f;
                if (seg < 4) { ss = red16(ss); sc = rsqrtf(ss + 1e-6f) * (seg < 2 ? 0.08838834764831845f : 1.0f); }
                h16x8 o;
#pragma unroll
                for (int j = 0; j < 8; ++j) o[j] = (h16)(y[j] * sc);
                *(h16x8*)(qkv + (size_t)row * 4096 + c0) = o;
                float* cso = nullptr;
                if (!samp && t >= TP - 3) cso = a.out + O_PGC + ((size_t)b * 3 + (t - (TP - 3))) * 4096 + c0;
                if (samp && t >= 5) cso = a.out + O_SGC + ((size_t)b * 3 + (t - 5)) * 4096 + c0;
                if (cso) { const h16x8 u = x[sg][3]; *(f32x4*)cso = (f32x4){(float)u[0], (float)u[1], (float)u[2], (float)u[3]}; *(f32x4*)(cso + 4) = (f32x4){(float)u[4], (float)u[5], (float)u[6], (float)u[7]}; }
            }
        }
        if (lane < 16) {
            const float bv = ba[(size_t)row * 32 + lane], av = ba[(size_t)row * 32 + 16 + lane];
            gb[(size_t)row * 32 + lane] = sigmoidf_(bv);
            gb[(size_t)row * 32 + 16 + lane] = -expf(a.in[I_ALOG][lane]) * softplusf_(av + a.in[I_DTB][lane]);
        }
    }
}

__device__ __forceinline__ void phase_gdn_scan(const Args& a, float* ldsf) {
    const int tid = threadIdx.x;
    const int vl = tid >> 3, kq = tid & 7;
    const h16* qkv = (const h16*)(a.ws + WS_QKV); const float* gb = (const float*)(a.ws + WS_GB); h16* obuf = (h16*)(a.ws + WS_OBUF);
    const int stt = tid >> 6, sp = tid & 63;
    for (int it = 256 + blockIdx.x; it < 256 + 4096; it += gridDim.x) {
        const bool samp = it >= 256; const int q = samp ? it - 256 : it;
        const int seq = q >> 1, vhalf = q & 1, b = seq >> 4, hv = seq & 15, hq = hv >> 1;
        const int T = samp ? 8 : TP, row0 = samp ? NPR + b * 8 : b * TP;
        const int v = vhalf * 64 + vl;
        float S[16];
        if (samp) { const float* spp = a.in[I_SG] + ((size_t)(b * 16 + hv) * 128 + kq * 16) * 128 + v;
#pragma unroll
            for (int i = 0; i < 16; ++i) S[i] = spp[(size_t)i * 128]; }
        else {
#pragma unroll
            for (int i = 0; i < 16; ++i) S[i] = 0.f; }
        h16x4 pqk; h16 pv; float pg = 0.f, pb = 0.f;
        { const h16* rp = qkv + (size_t)(row0 + stt) * 4096;
          pqk = *(const h16x4*)(rp + (sp < 32 ? hq * 128 + sp * 4 : 1024 + hq * 128 + (sp - 32) * 4)); pv = rp[2048 + hv * 128 + vhalf * 64 + sp];
          if (tid < 8) { pb = gb[(size_t)(row0 + tid) * 32 + hv]; pg = gb[(size_t)(row0 + tid) * 32 + 16 + hv]; } }
        __syncthreads();
        int cur = 0;
        for (int t0 = 0; t0 < T; t0 += 8) {
            float* Lb = ldsf + cur * 2576;
            *(f32x4*)(Lb + (sp < 32 ? 0 : 1024) + stt * 128 + (sp & 31) * 4) = (f32x4){(float)pqk[0], (float)pqk[1], (float)pqk[2], (float)pqk[3]};
            Lb[2048 + stt * 64 + sp] = (float)pv;
            if (tid < 8) { Lb[2560 + tid] = fexp_(pg); Lb[2568 + tid] = pb; }
            __syncthreads();
            if (t0 + 8 < T) { const h16* rp = qkv + (size_t)(row0 + t0 + 8 + stt) * 4096;
                pqk = *(const h16x4*)(rp + (sp < 32 ? hq * 128 + sp * 4 : 1024 + hq * 128 + (sp - 32) * 4)); pv = rp[2048 + hv * 128 + vhalf * 64 + sp];
                if (tid < 8) { pb = gb[(size_t)(row0 + t0 + 8 + tid) * 32 + hv]; pg = gb[(size_t)(row0 + t0 + 8 + tid) * 32 + 16 + hv]; } }
#pragma unroll 2
            for (int tt = 0; tt < 8; ++tt) {
                const float al = Lb[2560 + tt], be = Lb[2568 + tt], vv = Lb[2048 + tt * 64 + vl];
                const f32x4* kp = (const f32x4*)(Lb + 1024 + tt * 128 + kq * 16); const f32x4* qp = (const f32x4*)(Lb + tt * 128 + kq * 16);
                float kr[16];
                float dot = 0.f;
#pragma unroll
                for (int i = 0; i < 4; ++i) { const f32x4 kv = kp[i]; kr[4 * i] = kv[0]; kr[4 * i + 1] = kv[1]; kr[4 * i + 2] = kv[2]; kr[4 * i + 3] = kv[3]; }
#pragma unroll
                for (int i = 0; i < 16; ++i) dot += kr[i] * S[i];
                dot = red8(dot);
                const float c = be * (vv - al * dot);
                float od = 0.f;
#pragma unroll
                for (int i = 0; i < 4; ++i) { const f32x4 qv = qp[i];
#pragma unroll
                    for (int j = 0; j < 4; ++j) { const float s = al * S[4 * i + j] + kr[4 * i + j] * c; S[4 * i + j] = s; od += qv[j] * s; } }
                od = red8(od);
                if (kq == 0) obuf[(size_t)(row0 + t0 + tt) * 2048 + hv * 128 + v] = (h16)od;
            }
            cur ^= 1;
        }
        float* so = a.out + (samp ? O_SG : O_PG) + ((size_t)(b * 16 + hv) * 128 + kq * 16) * 128 + v;
#pragma unroll
        for (int i = 0; i < 16; ++i) so[(size_t)i * 128] = S[i];
    }
}

__device__ __forceinline__ void phase_gdn_pre(const Args& a, float* ldsf) {
    const int tid = threadIdx.x, hb = tid >> 8, ht = tid & 255, hw = ht >> 6, l = tid & 63, lr = l & 15, lq = l >> 4;
    const h16* qkv = (const h16*)(a.ws + WS_QKV); const float* gb = (const float*)(a.ws + WS_GB);
    h16* UT = (h16*)(a.ws + WS_UT); h16* WW = (h16*)(a.ws + WS_WW); h16* AQ = (h16*)(a.ws + WS_AQ); float* GC = (float*)(a.ws + WS_GC);
    float* Am = ldsf + hb * 4352;
    float* gs = Am + 4096, *bs = Am + 4160, *gcs = Am + 4224;
    const int niter = (NITEM + gridDim.x * 2 - 1) / (gridDim.x * 2);
    for (int n = 0; n < niter; ++n) {
        const int itm = (n * gridDim.x + blockIdx.x) * 2 + hb;
        const bool valid = itm < NITEM;
        const int seq = valid ? itm / NCH : 0, c = valid ? itm - seq * NCH : 0, b = seq >> 4, hv = seq & 15, hq = hv >> 1;
        const int rowb = b * TP + 64 * c, nval = (TP - 64 * c) < 64 ? (TP - 64 * c) : 64;
        const int ib = hw;
        h16x8 aq[4], ak[4], kf[4][4]; h16x2 xr[32]; float gv = 0.f, bv = 0.f;
#pragma unroll
        for (int ks = 0; ks < 4; ++ks) { aq[ks] = *(const h16x8*)(qkv + (size_t)(rowb + 16 * ib + lr) * 4096 + hq * 128 + 32 * ks + 8 * lq); ak[ks] = *(const h16x8*)(qkv + (size_t)(rowb + 16 * ib + lr) * 4096 + 1024 + hq * 128 + 32 * ks + 8 * lq);
#pragma unroll
            for (int jb = 0; jb < 4; ++jb) kf[jb][ks] = *(const h16x8*)(qkv + (size_t)(rowb + 16 * jb + lr) * 4096 + 1024 + hq * 128 + 32 * ks + 8 * lq); }
        { const h16* xp = qkv + (size_t)rowb * 4096 + (ht < 128 ? 2048 + hv * 128 + ht : 1024 + hq * 128 + (ht - 128));
#pragma unroll
          for (int i = 0; i < 32; ++i) { xr[i][0] = xp[(size_t)(2 * i) * 4096]; xr[i][1] = xp[(size_t)(2 * i + 1) * 4096]; } }
        if (ht < 64 && ht < nval) { gv = gb[(size_t)(rowb + ht) * 32 + 16 + hv]; bv = gb[(size_t)(rowb + ht) * 32 + hv]; }
        __syncthreads();
        if (ht < 64) { gs[ht] = gv; bs[ht] = bv; }
        __syncthreads();
        if (ht < 64) { float sgc = 0.f;
#pragma unroll
            for (int j4 = 0; j4 < 16; ++j4) { const f32x4 g4 = *(const f32x4*)(gs + 4 * j4);
#pragma unroll
                for (int jj = 0; jj < 4; ++jj) sgc += (4 * j4 + jj <= ht) ? g4[jj] : 0.f; }
            gcs[ht] = sgc; if (valid) GC[(size_t)itm * 64 + ht] = sgc; }
        __syncthreads();
        if (valid) {
            float gci[4], bei[4];
#pragma unroll
            for (int r = 0; r < 4; ++r) { gci[r] = gcs[16 * ib + 4 * lq + r]; bei[r] = bs[16 * ib + 4 * lq + r]; }
#pragma unroll
            for (int jb = 0; jb < 4; ++jb) {
                h16* aqp = AQ + (size_t)itm * 4096 + (size_t)(16 * ib + 4 * lq) * 64 + 16 * jb + lr;
                if (jb > ib) {
#pragma unroll
                    for (int r = 0; r < 4; ++r) aqp[r * 64] = (h16)0.f;
                } else {
                    f32x4 ckk = (f32x4){0.f, 0.f, 0.f, 0.f}, cqk = (f32x4){0.f, 0.f, 0.f, 0.f};
#pragma unroll
                    for (int ks = 0; ks < 4; ++ks) {
                        ckk = __builtin_amdgcn_mfma_f32_16x16x32_f16(ak[ks], kf[jb][ks], ckk, 0, 0, 0); cqk = __builtin_amdgcn_mfma_f32_16x16x32_f16(aq[ks], kf[jb][ks], cqk, 0, 0, 0); }
                    const int j = 16 * jb + lr; const float gcj = gcs[j];
#pragma unroll
                    for (int r = 0; r < 4; ++r) { const int i = 16 * ib + 4 * lq + r; const float dec = fexp_(gci[r] - gcj);
                        Am[i * 64 + j] = (j < i) ? bei[r] * ckk[r] * dec : 0.f;
                        aqp[r * 64] = (h16)((j <= i) ? cqk[r] * dec : 0.f); }
                }
            }
        }
        __syncthreads();
        if (valid) {
            float x[64];
            if (ht < 128) {
#pragma unroll
                for (int i = 0; i < 64; ++i) x[i] = (float)xr[i >> 1][i & 1] * bs[i]; }
            else {
#pragma unroll
                for (int i = 0; i < 64; ++i) x[i] = (float)xr[i >> 1][i & 1] * bs[i] * fexp_(gcs[i]); }
            {
                f32x4 ab0[8], ab1[8];
#define SUB_LOAD(dst, i, c) do { _Pragma("unroll") for (int v_ = 0; v_ < 8; ++v_) if (32 * (c) + 4 * v_ < (i)) dst[v_] = *(const f32x4*)(Am + (i) * 64 + 32 * (c) + 4 * v_); } while (0)
#define SUB_FMA(src, i, c) do { _Pragma("unroll") for (int v_ = 0; v_ < 8; ++v_) { const int j_ = 32 * (c) + 4 * v_; \
                    if (j_ < (i))     a0 = __builtin_fmaf(src[v_][0], x[j_], a0); if (j_ + 1 < (i)) a1 = __builtin_fmaf(src[v_][1], x[j_ + 1], a1); \
                    if (j_ + 2 < (i)) a2 = __builtin_fmaf(src[v_][2], x[j_ + 2], a2); if (j_ + 3 < (i)) a3 = __builtin_fmaf(src[v_][3], x[j_ + 3], a3); } } while (0)
                SUB_LOAD(ab0, 1, 0);
#pragma unroll
                for (int i = 1; i < 33; i += 2) {
                    { float a0 = 0.f, a1 = 0.f, a2 = 0.f, a3 = 0.f; SUB_LOAD(ab1, i + 1, 0); __builtin_amdgcn_sched_barrier(0); SUB_FMA(ab0, i, 0); x[i] -= (a0 + a1) + (a2 + a3); }
                    { float a0 = 0.f, a1 = 0.f, a2 = 0.f, a3 = 0.f; SUB_LOAD(ab0, i + 2, 0); __builtin_amdgcn_sched_barrier(0); SUB_FMA(ab1, i + 1, 0); x[i + 1] -= (a0 + a1) + (a2 + a3); }
                }
#pragma unroll
                for (int i = 33; i < 64; ++i) {
                    float a0 = 0.f, a1 = 0.f, a2 = 0.f, a3 = 0.f;
                    SUB_LOAD(ab1, i, 1); __builtin_amdgcn_sched_barrier(0); SUB_FMA(ab0, i, 0);
                    if (i + 1 < 64) SUB_LOAD(ab0, i + 1, 0);
                    __builtin_amdgcn_sched_barrier(0); SUB_FMA(ab1, i, 1);
                    x[i] -= (a0 + a1) + (a2 + a3);
                }
#undef SUB_LOAD
#undef SUB_FMA
            }
            if (ht < 128) { h16* up = UT + (size_t)itm * 8192 + (size_t)ht * 64;
#pragma unroll
                for (int i8 = 0; i8 < 8; ++i8) { h16x8 o;
#pragma unroll
                    for (int jj = 0; jj < 8; ++jj) o[jj] = (h16)x[8 * i8 + jj];
                    *(h16x8*)(up + 8 * i8) = o; } }
            else { h16* wp = WW + (size_t)itm * 8192 + (ht - 128);
#pragma unroll
                for (int i = 0; i < 64; ++i) wp[(size_t)i * 128] = (h16)x[i]; }
        }
    }
}

__device__ __forceinline__ void phase_gdn_chunk_scan(const Args& a, unsigned char* smem) {
    const int tid = threadIdx.x, wid = tid >> 6, l = tid & 63, lr = l & 15, lq = l >> 4;
    const int ib = wid & 3, vp = wid >> 2;
    const h16* qkv = (const h16*)(a.ws + WS_QKV);
    const h16* UT = (const h16*)(a.ws + WS_UT); const h16* WW = (const h16*)(a.ws + WS_WW); const h16* AQ = (const h16*)(a.ws + WS_AQ); const float* GC = (const float*)(a.ws + WS_GC);
    h16* obuf = (h16*)(a.ws + WS_OBUF);
    h16* ST = (h16*)smem;
    h16* vnT = ST + 64 * 136;
    h16* vsT = vnT + 64 * 72;
    h16* kT = vsT + 64 * 72;
    for (int it = blockIdx.x; it < 256; it += gridDim.x) {
        const int seq = it >> 1, vhalf = it & 1, b = seq >> 4, hv = seq & 15, hq = hv >> 1, v0 = vhalf * 64;
        __syncthreads();
        for (int e = tid; e < 64 * 136 / 8; e += NTHREADS) *(h16x8*)(ST + e * 8) = pack8((f32x4){0.f, 0.f, 0.f, 0.f}, (f32x4){0.f, 0.f, 0.f, 0.f});
        f32x4 Sacc[4];
#pragma unroll
        for (int vt = 0; vt < 4; ++vt) Sacc[vt] = (f32x4){0.f, 0.f, 0.f, 0.f};
        h16x8 wf[4], qf[4], af[2], ks0, ks1; h16x4 ut[2]; f32x4 gcr; float gl;
        const int si = tid >> 3, skg = tid & 7;
#define GDN_LOAD(c) do { const int itm_ = seq * NCH + (c); const int rowb_ = b * TP + 64 * (c); \
            _Pragma("unroll") for (int ks = 0; ks < 4; ++ks) { wf[ks] = *(const h16x8*)(WW + (size_t)itm_ * 8192 + (size_t)(16 * ib + lr) * 128 + 32 * ks + 8 * lq); \
                qf[ks] = *(const h16x8*)(qkv + (size_t)(rowb_ + 16 * ib + lr) * 4096 + hq * 128 + 32 * ks + 8 * lq); } \
            _Pragma("unroll") for (int k2 = 0; k2 < 2; ++k2) af[k2] = *(const h16x8*)(AQ + (size_t)itm_ * 4096 + (size_t)(16 * ib + lr) * 64 + 32 * k2 + 8 * lq); \
            _Pragma("unroll") for (int vt = 0; vt < 2; ++vt) ut[vt] = *(const h16x4*)(UT + (size_t)itm_ * 8192 + (size_t)(v0 + 16 * (2 * vp + vt) + lr) * 64 + 16 * ib + 4 * lq); \
            gcr = *(const f32x4*)(GC + (size_t)itm_ * 64 + 16 * ib + 4 * lq); gl = GC[(size_t)itm_ * 64 + 63]; \
            { const h16* kp_ = qkv + (size_t)(rowb_ + si) * 4096 + 1024 + hq * 128 + 16 * skg; ks0 = *(const h16x8*)kp_; ks1 = *(const h16x8*)(kp_ + 8); } } while (0)
        GDN_LOAD(0);
        for (int c = 0; c < NCH; ++c) {
            const int rowb = b * TP + 64 * c, nval = (TP - 64 * c) < 64 ? (TP - 64 * c) : 64;
            __syncthreads();
#pragma unroll
            for (int jj = 0; jj < 8; ++jj) { kT[(16 * skg + jj) * 72 + si] = ks0[jj]; kT[(16 * skg + 8 + jj) * 72 + si] = ks1[jj]; }
            f32x4 c1[2], c2[2];
#pragma unroll
            for (int vt = 0; vt < 2; ++vt) { c1[vt] = (f32x4){0.f, 0.f, 0.f, 0.f}; c2[vt] = (f32x4){0.f, 0.f, 0.f, 0.f}; }
#pragma unroll
            for (int vt = 0; vt < 2; ++vt)
#pragma unroll
                for (int ks = 0; ks < 4; ++ks) { const h16x8 bf = *(const h16x8*)(ST + (16 * (2 * vp + vt) + lr) * 136 + 32 * ks + 8 * lq);
                    c1[vt] = __builtin_amdgcn_mfma_f32_16x16x32_f16(wf[ks], bf, c1[vt], 0, 0, 0); c2[vt] = __builtin_amdgcn_mfma_f32_16x16x32_f16(qf[ks], bf, c2[vt], 0, 0, 0); }
            const float egl = fexp_(gl);
            f32x4 eg, es;
#pragma unroll
            for (int r = 0; r < 4; ++r) { eg[r] = fexp_(gcr[r]); es[r] = fexp_(gl - gcr[r]); }
#pragma unroll
            for (int vt = 0; vt < 2; ++vt) { h16x4 vn, vs;
#pragma unroll
                for (int r = 0; r < 4; ++r) { const float x = (float)ut[vt][r] - c1[vt][r]; vn[r] = (h16)x; vs[r] = (h16)(x * es[r]); }
                *(h16x4*)(vnT + (16 * (2 * vp + vt) + lr) * 72 + 16 * ib + 4 * lq) = vn; *(h16x4*)(vsT + (16 * (2 * vp + vt) + lr) * 72 + 16 * ib + 4 * lq) = vs; }
            const h16x8 afc0 = af[0], afc1 = af[1];
            __syncthreads();
            if (c + 1 < NCH) GDN_LOAD(c + 1);
#pragma unroll
            for (int vt = 0; vt < 2; ++vt) {
                f32x4 c3 = (f32x4){0.f, 0.f, 0.f, 0.f};
                c3 = __builtin_amdgcn_mfma_f32_16x16x32_f16(afc0, *(const h16x8*)(vnT + (16 * (2 * vp + vt) + lr) * 72 + 8 * lq), c3, 0, 0, 0);
                c3 = __builtin_amdgcn_mfma_f32_16x16x32_f16(afc1, *(const h16x8*)(vnT + (16 * (2 * vp + vt) + lr) * 72 + 32 + 8 * lq), c3, 0, 0, 0);
#pragma unroll
                for (int r = 0; r < 4; ++r) { const int i = 16 * ib + 4 * lq + r;
                    if (i < nval) obuf[(size_t)(rowb + i) * 2048 + hv * 128 + v0 + 16 * (2 * vp + vt) + lr] = (h16)(eg[r] * c2[vt][r] + c3[r]); }
            }
            const h16x8 ka0 = *(const h16x8*)(kT + (16 * wid + lr) * 72 + 8 * lq), ka1 = *(const h16x8*)(kT + (16 * wid + lr) * 72 + 32 + 8 * lq);
#pragma unroll
            for (int vt = 0; vt < 4; ++vt) {
                Sacc[vt] = Sacc[vt] * egl;
                Sacc[vt] = __builtin_amdgcn_mfma_f32_16x16x32_f16(ka0, *(const h16x8*)(vsT + (16 * vt + lr) * 72 + 8 * lq), Sacc[vt], 0, 0, 0);
                Sacc[vt] = __builtin_amdgcn_mfma_f32_16x16x32_f16(ka1, *(const h16x8*)(vsT + (16 * vt + lr) * 72 + 32 + 8 * lq), Sacc[vt], 0, 0, 0);
                h16x4 sh;
#pragma unroll
                for (int r = 0; r < 4; ++r) sh[r] = (h16)Sacc[vt][r];
                *(h16x4*)(ST + (16 * vt + lr) * 136 + 16 * wid + 4 * lq) = sh;
            }
        }
#undef GDN_LOAD
        float* so = a.out + O_PG + ((size_t)(b * 16 + hv) * 128 + 16 * wid + 4 * lq) * 128 + v0 + lr;
#pragma unroll
        for (int vt = 0; vt < 4; ++vt)
#pragma unroll
            for (int r = 0; r < 4; ++r) so[(size_t)r * 128 + 16 * vt] = Sacc[vt][r];
    }
}

__device__ __forceinline__ void phase_gdn_gate(const Args& a) {
    const int lane = threadIdx.x & 63, wid = threadIdx.x >> 6;
    const h16* obuf = (const h16*)(a.ws + WS_OBUF); const h16* z = (const h16*)(a.ws + WS_Z); h16* og = (h16*)(a.ws + WS_OG);
    const f32x4 gw0 = *(const f32x4*)(a.in[I_GNW] + (lane & 15) * 8), gw1 = *(const f32x4*)(a.in[I_GNW] + (lane & 15) * 8 + 4);
    for (int row = blockIdx.x * 8 + wid; row < NR; row += gridDim.x * 8) {
        f32x4 o0[4], o1[4]; h16x8 zz[4], oh[4];
#pragma unroll
        for (int j = 0; j < 4; ++j) { const size_t e = (size_t)row * 2048 + j * 512 + lane * 8; oh[j] = *(const h16x8*)(obuf + e); zz[j] = *(const h16x8*)(z + e); }
#pragma unroll
        for (int j = 0; j < 4; ++j) { o0[j] = (f32x4){(float)oh[j][0], (float)oh[j][1], (float)oh[j][2], (float)oh[j][3]}; o1[j] = (f32x4){(float)oh[j][4], (float)oh[j][5], (float)oh[j][6], (float)oh[j][7]}; }
#pragma unroll
        for (int j = 0; j < 4; ++j) {
            const float ss = red16(sq4(o0[j]) + sq4(o1[j]));
            const float sc = rsqrtf(ss * (1.0f / 128.0f) + 1e-6f);
            h16x8 r;
#pragma unroll
            for (int i = 0; i < 4; ++i) { r[i] = (h16)(o0[j][i] * sc * gw0[i] * siluf_((float)zz[j][i])); r[4 + i] = (h16)(o1[j][i] * sc * gw1[i] * siluf_((float)zz[j][4 + i])); }
            *(h16x8*)(og + (size_t)row * 2048 + j * 512 + lane * 8) = r;
        }
    }
}

__device__ __forceinline__ void phase_shift(const Args& a) {
    const int lane = threadIdx.x & 63, wid = threadIdx.x >> 6;
    const float* x1 = (const float*)(a.ws + WS_X1); h16* xs = (h16*)(a.ws + WS_XS);
    const float* nw = a.in[I_NW] + DM; const float* mu = a.in[I_MU];
    for (int pr = blockIdx.x * 8 + wid; pr < NR / 2; pr += gridDim.x * 8) {
        const int row = pr * 2;
        int b, t; bool samp; row_bt(row, b, t, samp);
        f32x4 xa[4], xb[4], xp[4];
#pragma unroll
        for (int i = 0; i < 4; ++i) { xa[i] = *(const f32x4*)(x1 + (size_t)row * DM + i * 256 + lane * 4); xb[i] = *(const f32x4*)(x1 + (size_t)(row + 1) * DM + i * 256 + lane * 4); }
        if (t > 0) {
#pragma unroll
            for (int i = 0; i < 4; ++i) xp[i] = *(const f32x4*)(x1 + (size_t)(row - 1) * DM + i * 256 + lane * 4); }
        else if (samp) {
#pragma unroll
            for (int i = 0; i < 4; ++i) xp[i] = *(const f32x4*)(a.in[I_SRS] + (size_t)b * DM + i * 256 + lane * 4); }
        else {
#pragma unroll
            for (int i = 0; i < 4; ++i) xp[i] = (f32x4){0.f, 0.f, 0.f, 0.f}; }
        float sa = 0.f, sb = 0.f, sp = 0.f;
#pragma unroll
        for (int i = 0; i < 4; ++i) { sa += sq4(xa[i]); sb += sq4(xb[i]); sp += sq4(xp[i]); }
        sa = wsum(sa); sb = wsum(sb);
        const float ca = rsqrtf(sa * (1.0f / 1024.0f) + 1e-6f), cb = rsqrtf(sb * (1.0f / 1024.0f) + 1e-6f);
        float cp = 1.0f;
        if (t > 0) { sp = wsum(sp); cp = rsqrtf(sp * (1.0f / 1024.0f) + 1e-6f); }
#pragma unroll
        for (int i = 0; i < 4; ++i) { const f32x4 w = *(const f32x4*)(nw + i * 256 + lane * 4); xa[i] = xa[i] * ca * w; xb[i] = xb[i] * cb * w; if (t > 0) xp[i] = xp[i] * cp * w; }
        for (int s = 0; s < 6; ++s) {
#pragma unroll
            for (int i = 0; i < 4; ++i) { const f32x4 m = *(const f32x4*)(mu + (size_t)s * DM + i * 256 + lane * 4);
                const f32x4 r0 = xa[i] + (xp[i] - xa[i]) * m, r1 = xb[i] + (xa[i] - xb[i]) * m;
                h16x4 o0, o1; o0[0] = (h16)r0[0]; o0[1] = (h16)r0[1]; o0[2] = (h16)r0[2]; o0[3] = (h16)r0[3]; o1[0] = (h16)r1[0]; o1[1] = (h16)r1[1]; o1[2] = (h16)r1[2]; o1[3] = (h16)r1[3];
                *(h16x4*)(xs + ((size_t)s * MP + row) * DM + i * 256 + lane * 4) = o0; *(h16x4*)(xs + ((size_t)s * MP + row + 1) * DM + i * 256 + lane * 4) = o1; }
        }
        float* so = nullptr;
        if (!samp && t == TP - 2) so = a.out + O_PRS + (size_t)b * DM;
        if (samp && t == 6) so = a.out + O_SRS + (size_t)b * DM;
        if (so) {
#pragma unroll
            for (int i = 0; i < 4; ++i) *(f32x4*)(so + i * 256 + lane * 4) = xb[i]; }
    }
}

__device__ __forceinline__ void phase_rwkv_prep(const Args& a) {
    const int lane = threadIdx.x & 63, wid = threadIdx.x >> 6;
    h16* rkvz = (h16*)(a.ws + WS_RKVZ); const h16* lo = (const h16*)(a.ws + WS_LOUT);
    float* dbuf = (float*)(a.ws + WS_DB); h16* kkb = (h16*)(a.ws + WS_KKB); h16* bbb = (h16*)(a.ws + WS_BBB); float* rkb = (float*)(a.ws + WS_RK); h16* k2b = (h16*)(a.ws + WS_K2);
    float pw0[2][8], pa0[2][8], pkk[2][8], pka[2][8], prk[2][8];
#pragma unroll
    for (int j = 0; j < 2; ++j)
#pragma unroll
        for (int i = 0; i < 8; ++i) { const int c = j * 512 + lane * 8 + i; pw0[j][i] = a.in[I_W0][c]; pa0[j][i] = a.in[I_A0][c]; pkk[j][i] = a.in[I_KK][c]; pka[j][i] = a.in[I_KA][c]; prk[j][i] = a.in[I_RK][c]; }
    for (int row = blockIdx.x * 8 + wid; row < NR; row += gridDim.x * 8) {
        h16x8 r[2], k[2], wl[2], al[2];
#pragma unroll
        for (int j = 0; j < 2; ++j) { const size_t e = (size_t)row * 1024 + j * 512 + lane * 8; const size_t e2 = (size_t)row * 2048 + j * 512 + lane * 8;
            r[j] = *(const h16x8*)(rkvz + e); k[j] = *(const h16x8*)(rkvz + (size_t)MP * 1024 + e); wl[j] = *(const h16x8*)(lo + e2); al[j] = *(const h16x8*)(lo + e2 + 1024); }
#pragma unroll
        for (int j = 0; j < 2; ++j) {
            float kkv[8], aa[8], dd[8]; h16x8 k2o; float ss = 0.f, rk = 0.f;
#pragma unroll
            for (int i = 0; i < 8; ++i) {
                const float w = -softplusf_(-(pw0[j][i] + (float)wl[j][i])) - 0.5f;
                dd[i] = fexp_(-fexp_(w));
                aa[i] = sigmoidf_(pa0[j][i] + (float)al[j][i]);
                const float kf = (float)k[j][i];
                kkv[i] = kf * pkk[j][i]; ss += kkv[i] * kkv[i];
                const float k2 = kf * (1.0f + (aa[i] - 1.0f) * pka[j][i]);
                rk += (float)r[j][i] * k2 * prk[j][i];
                k2o[i] = (h16)k2;
            }
            ss = red8(ss); rk = red8(rk);
            const float inv = rsqrtf(ss + 1e-6f);
            h16x8 kko, bbo;
#pragma unroll
            for (int i = 0; i < 8; ++i) { const float kk = kkv[i] * inv; kko[i] = (h16)kk; bbo[i] = (h16)(kk * aa[i]); }
            const size_t e = (size_t)row * 1024 + j * 512 + lane * 8;
            *(h16x8*)(k2b + e) = k2o; *(h16x8*)(kkb + e) = kko; *(h16x8*)(bbb + e) = bbo;
            *(f32x4*)(dbuf + e) = (f32x4){dd[0], dd[1], dd[2], dd[3]}; *(f32x4*)(dbuf + e + 4) = (f32x4){dd[4], dd[5], dd[6], dd[7]};
            if ((lane & 7) == 0) rkb[(size_t)row * 16 + j * 8 + (lane >> 3)] = rk;
        }
    }
}

struct RwStage { h16x4 r[2], k[2], v[2], kk[2], b[2]; f32x4 d[2]; };
__device__ __forceinline__ void phase_rwkv_scan(const Args& a, float* ldsf) {
    const int tid = threadIdx.x, lane = tid & 63, wid = tid >> 6;
    const bool prod = wid >= 4;
    const int g = lane >> 4, kq = lane & 15;
    const int st = tid & 255, stt = st >> 4, sc4 = (st & 15) * 4;
    const h16* rkvz = (const h16*)(a.ws + WS_RKVZ); const float* dbuf = (const float*)(a.ws + WS_DB); const h16* k2b = (const h16*)(a.ws + WS_K2);
    const h16* kkb = (const h16*)(a.ws + WS_KKB); const h16* bbb = (const h16*)(a.ws + WS_BBB);
    float* ybuf = (float*)(a.ws + WS_YBUF);
#define RW_GLOAD(R, tbase) do { _Pragma("unroll") for (int u_ = 0; u_ < 2; ++u_) { const int tok_ = (tbase) + stt + 16 * u_; if (tok_ < T) { const size_t e_ = (size_t)(row0 + tok_) * 1024 + h * 64 + sc4; \
        R.r[u_] = *(const h16x4*)(rkvz + e_); R.k[u_] = *(const h16x4*)(k2b + e_); R.v[u_] = *(const h16x4*)(rkvz + (size_t)2 * MP * 1024 + e_); R.d[u_] = *(const f32x4*)(dbuf + e_); \
        R.kk[u_] = *(const h16x4*)(kkb + e_); R.b[u_] = *(const h16x4*)(bbb + e_); } } } while (0)
#define RW_LWRITE(R, Lb) do { _Pragma("unroll") for (int u_ = 0; u_ < 2; ++u_) { float* p_ = (Lb) + (stt + 16 * u_) * 64 + sc4; \
        *(f32x4*)p_ = (f32x4){(float)R.r[u_][0], (float)R.r[u_][1], (float)R.r[u_][2], (float)R.r[u_][3]}; \
        *(f32x4*)(p_ + 2048) = (f32x4){(float)R.k[u_][0], (float)R.k[u_][1], (float)R.k[u_][2], (float)R.k[u_][3]}; \
        *(f32x4*)(p_ + 4096) = R.d[u_]; \
        *(f32x4*)(p_ + 6144) = (f32x4){(float)R.kk[u_][0], (float)R.kk[u_][1], (float)R.kk[u_][2], (float)R.kk[u_][3]}; \
        *(f32x4*)(p_ + 8192) = (f32x4){(float)R.b[u_][0], (float)R.b[u_][1], (float)R.b[u_][2], (float)R.b[u_][3]}; \
        *(f32x4*)(p_ + 10240) = (f32x4){(float)R.v[u_][0], (float)R.v[u_][1], (float)R.v[u_][2], (float)R.v[u_][3]}; } } while (0)
    for (int it = blockIdx.x; it < 256 + 4096; it += gridDim.x) {
        const bool samp = it >= 256; const int q = samp ? it - 256 : it;
        const int seq = q >> 1, half = q & 1, b = seq >> 4, h = seq & 15;
        const int T = samp ? 8 : TP, row0 = samp ? NPR + b * 8 : b * TP;
        const int v0 = half * 32 + (wid & 3) * 8 + g * 2;
        f32x4 S0 = {0.f, 0.f, 0.f, 0.f}, S1 = {0.f, 0.f, 0.f, 0.f};
        if (!prod && samp) { const float* sp = a.in[I_SR] + ((size_t)(b * 16 + h) * 64 + v0) * 64 + kq * 4; S0 = *(const f32x4*)sp; S1 = *(const f32x4*)(sp + 64); }
        RwStage RA = {}, RB = {};
        if (prod) { RW_GLOAD(RA, 0); RW_GLOAD(RB, 32); }
        __syncthreads();
        for (int t0 = 0; t0 < T; t0 += 64) {
#pragma unroll
            for (int par = 0; par < 2; ++par) {
                const int tb = t0 + 32 * par;
                if (tb >= T) break;
                float* Lb = ldsf + par * 12288;
                if (prod) { if (par == 0) RW_LWRITE(RA, Lb); else RW_LWRITE(RB, Lb); }
                __syncthreads();
                if (prod) {
                    if (par == 0) RW_GLOAD(RA, tb + 64); else RW_GLOAD(RB, tb + 64);
                } else {
                    for (int hh = 0; hh < 4; ++hh) {
                        if (tb + hh * 8 >= T) break;
                        float ya[8], yb[8];
                        f32x4 Rr[2], Rk[2], Rd[2], Rq[2], Rb[2]; f32x2 Rv[2];
#define RW_LOAD(slot, idx) do { const float* p_ = Lb + (idx) * 64 + kq * 4; \
                            Rq[slot] = *(const f32x4*)(p_ + 6144); Rd[slot] = *(const f32x4*)(p_ + 4096); Rb[slot] = *(const f32x4*)(p_ + 8192); Rk[slot] = *(const f32x4*)(p_ + 2048); \
                            Rr[slot] = *(const f32x4*)p_; Rv[slot] = *(const f32x2*)(Lb + 10240 + (idx) * 64 + v0); } while (0)
                        RW_LOAD(0, hh * 8);
#pragma unroll
                        for (int t8 = 0; t8 < 8; ++t8) {
                            const int sl = t8 & 1;
                            if (t8 < 7) RW_LOAD(sl ^ 1, hh * 8 + t8 + 1);
                            __builtin_amdgcn_sched_barrier(0);
                            const f32x4 rr = Rr[sl], kk2 = Rk[sl], dd = Rd[sl], qq = Rq[sl], bb = Rb[sl]; const f32x2 vv = Rv[sl];
                            const f32x4 m0 = S0 * qq, m1 = S1 * qq;
                            const float nsa0 = -red16((m0[0] + m0[1]) + (m0[2] + m0[3])), nsa1 = -red16((m1[0] + m1[1]) + (m1[2] + m1[3]));
                            S0 = S0 * dd + nsa0 * bb + vv[0] * kk2;
                            S1 = S1 * dd + nsa1 * bb + vv[1] * kk2;
                            const f32x4 n0 = S0 * rr, n1 = S1 * rr;
                            ya[t8] = (n0[0] + n0[1]) + (n0[2] + n0[3]); yb[t8] = (n1[0] + n1[1]) + (n1[2] + n1[3]);
                        }
#undef RW_LOAD
#pragma unroll
                        for (int t8 = 0; t8 < 8; ++t8) { ya[t8] = red16(ya[t8]); yb[t8] = red16(yb[t8]); }
                        f32x2 ysel = {ya[0], yb[0]};
#pragma unroll
                        for (int t8 = 1; t8 < 8; ++t8) { ysel[0] = (kq == t8) ? ya[t8] : ysel[0]; ysel[1] = (kq == t8) ? yb[t8] : ysel[1]; }
                        if (kq < 8) *(f32x2*)(ybuf + (size_t)(row0 + tb + hh * 8 + kq) * 1024 + h * 64 + v0) = ysel;
                    }
                }
            }
        }
        if (!prod) { float* so = a.out + (samp ? O_SR : O_PR) + ((size_t)(b * 16 + h) * 64 + v0) * 64 + kq * 4; *(f32x4*)so = S0; *(f32x4*)(so + 64) = S1; }
    }
#undef RW_GLOAD
#undef RW_LWRITE
}

__device__ __forceinline__ void phase_rwkv_gate(const Args& a) {
    const int lane = threadIdx.x & 63, wid = threadIdx.x >> 6;
    const float* ybuf = (const float*)(a.ws + WS_YBUF); const float* rkb = (const float*)(a.ws + WS_RK);
    const h16* rkvz = (const h16*)(a.ws + WS_RKVZ); h16* yg = (h16*)(a.ws + WS_YG);
    float lw[2][8], lb[2][8];
#pragma unroll
    for (int j = 0; j < 2; ++j)
#pragma unroll
        for (int i = 0; i < 8; ++i) { const int c = j * 512 + lane * 8 + i; lw[j][i] = a.in[I_LNW][c]; lb[j][i] = a.in[I_LNB][c]; }
    for (int row = blockIdx.x * 8 + wid; row < NR; row += gridDim.x * 8) {
        f32x4 y0[2], y1[2]; h16x8 vv[2], zz[2]; float rk[2];
#pragma unroll
        for (int j = 0; j < 2; ++j) { const size_t e = (size_t)row * 1024 + j * 512 + lane * 8;
            y0[j] = *(const f32x4*)(ybuf + e); y1[j] = *(const f32x4*)(ybuf + e + 4); vv[j] = *(const h16x8*)(rkvz + (size_t)2 * MP * 1024 + e); zz[j] = *(const h16x8*)(rkvz + (size_t)3 * MP * 1024 + e);
            rk[j] = rkb[(size_t)row * 16 + j * 8 + (lane >> 3)]; }
#pragma unroll
        for (int j = 0; j < 2; ++j) {
            float y[8] = {y0[j][0], y0[j][1], y0[j][2], y0[j][3], y1[j][0], y1[j][1], y1[j][2], y1[j][3]};
            float sm = 0.f;
#pragma unroll
            for (int i = 0; i < 8; ++i) sm += y[i];
            const float mean = red8(sm) * (1.0f / 64.0f);
            float sv = 0.f;
#pragma unroll
            for (int i = 0; i < 8; ++i) { y[i] -= mean; sv += y[i] * y[i]; }
            const float rs = rsqrtf(red8(sv) * (1.0f / 64.0f) + 64e-5f);
            h16x8 o;
#pragma unroll
            for (int i = 0; i < 8; ++i) { const float yn = y[i] * rs * lw[j][i] + lb[j][i] + rk[j] * (float)vv[j][i]; o[i] = (h16)(yn * siluf_((float)zz[j][i])); }
            *(h16x8*)(yg + (size_t)row * 1024 + j * 512 + lane * 8) = o;
        }
    }
}

__device__ __forceinline__ void phase_final(const Args& a) {
    const int lane = threadIdx.x & 63, wid = threadIdx.x >> 6;
    const float* x2 = (const float*)(a.ws + WS_X2); const float* nw = a.in[I_FNW];
    for (int pr = blockIdx.x * 8 + wid; pr < NR / 2; pr += gridDim.x * 8) {
        const int row = pr * 2;
        int b, t; bool samp; row_bt(row, b, t, samp);
        if (!samp && t < 16) continue;
        float* op = samp ? a.out + O_YS + (size_t)(row - NPR) * DM : a.out + O_YP + ((size_t)b * 2048 + (t - 16)) * DM;
        const float* p = x2 + (size_t)row * DM; f32x4 v[4], u[4]; float ss = 0.f, su = 0.f;
#pragma unroll
        for (int i = 0; i < 4; ++i) { v[i] = *(const f32x4*)(p + i * 256 + lane * 4); u[i] = *(const f32x4*)(p + DM + i * 256 + lane * 4); }
#pragma unroll
        for (int i = 0; i < 4; ++i) { ss += sq4(v[i]); su += sq4(u[i]); }
        ss = wsum(ss); su = wsum(su);
        const float sc = rsqrtf(ss * (1.0f / 1024.0f) + 1e-6f), scu = rsqrtf(su * (1.0f / 1024.0f) + 1e-6f);
#pragma unroll
        for (int i = 0; i < 4; ++i) { const f32x4 w = *(const f32x4*)(nw + i * 256 + lane * 4); *(f32x4*)(op + i * 256 + lane * 4) = v[i] * sc * w; *(f32x4*)(op + DM + i * 256 + lane * 4) = u[i] * scu * w; }
    }
}

constexpr int NPHASE = 15;
#ifndef PROBE_MASK
#define PROBE_MASK 0
#endif
__global__ void __launch_bounds__(NTHREADS, 2) mk_fwd(Args a) {
    extern __shared__ __attribute__((aligned(16))) unsigned char smem[];
    PG8_LAS unsigned char* lds = (PG8_LAS unsigned char*)smem;
    float* ldsf = (float*)smem;
    const int G = gridDim.x, c = blockIdx.x;
#if MK_COOP
    cg::grid_group grid = cg::this_grid();
    __shared__ uint4 xb_words;
    if (threadIdx.x == 0) xb_words = make_uint4(0u, 0u, 0u, 0u);
    __syncthreads();
    const XcdBarrier xbar = xcd_barrier_post((unsigned*)(a.ws + WS_BAR), (volatile PG8_LAS unsigned*)&xb_words);
    if (a.ph_hi > 1000) grid.sync();
#define SEAM(p) do { if ((p) + 1 < a.ph_hi) xcd_barrier(xbar); } while (0)
#else
#define SEAM(p) do { } while (0)
#endif
#define IN(p) (a.ph_lo <= (p) && (p) < a.ph_hi)
#define RUN(p, ...) if (IN(p)) { __syncthreads(); __VA_ARGS__; if ((PROBE_MASK >> (p)) & 1) { __syncthreads(); __VA_ARGS__; } SEAM(p); }
    RUN(0, phase_prep(a, ldsf))
    RUN(1, { pg8::Gemm g{(const h16*)(a.ws + WS_XN0), (const h16*)(a.ws + WS_WIN), MP, 6400, 1024}; pg8::StaticOrder S; S.init(MP, 6400, G, c);
        EpiProj E{(h16*)(a.ws + WS_QKVPRE), (h16*)(a.ws + WS_Z), (float*)(a.ws + WS_BA)};
        pg8::gemm_phase<EpiProj, pg8::StaticOrder>(lds, g, S, E); })
    RUN(2, phase_conv(a, ldsf))
    RUN(3, phase_gdn_pre(a, ldsf))
    RUN(4, { phase_gdn_chunk_scan(a, smem); __syncthreads(); phase_gdn_scan(a, ldsf); })
    RUN(5, phase_gdn_gate(a))
    RUN(6, { pg8::Gemm g{(const h16*)(a.ws + WS_OG), (const h16*)(a.ws + WS_WOUT), MP, 1024, 2048}; pg8::StaticOrder S; S.init(MP, 1024, G, c);
        EpiResX E{a.in[I_META], a.in[I_XP], a.in[I_XS], (float*)(a.ws + WS_X1)};
        pg8::gemm_phase<EpiResX, pg8::StaticOrder>(lds, g, S, E); })
    RUN(7, phase_shift(a))
    RUN(8, { pg8::Gemm g{(const h16*)(a.ws + WS_XS), (const h16*)(a.ws + WS_WR), 6 * MP, 4608, 1024}; OrderG S; S.init(G, c);
        EpiG E{(h16*)(a.ws + WS_RKVZ), (h16*)(a.ws + WS_LH)};
        pg8::gemm_phase<EpiG, OrderG>(lds, g, S, E); })
    RUN(9, { pg8::Gemm g{(const h16*)(a.ws + WS_LH), (const h16*)(a.ws + WS_WL2), MP, 2048, 256}; pg8::StaticOrder S; S.init(MP, 2048, G, c);
        EpiH16 E{(h16*)(a.ws + WS_LOUT), 2048};
        pg8::gemm_phase<EpiH16, pg8::StaticOrder>(lds, g, S, E); })
    RUN(10, phase_rwkv_prep(a))
    RUN(11, phase_rwkv_scan(a, ldsf))
    RUN(12, phase_rwkv_gate(a))
    RUN(13, { pg8::Gemm g{(const h16*)(a.ws + WS_YG), (const h16*)(a.ws + WS_WO), MP, 1024, 1024}; pg8::StaticOrder S; S.init(MP, 1024, G, c);
        EpiResB E{(const float*)(a.ws + WS_X1), (float*)(a.ws + WS_X2)};
        pg8::gemm_phase<EpiResB, pg8::StaticOrder>(lds, g, S, E); })
    RUN(14, phase_final(a))
#undef RUN
#undef IN
#undef SEAM
}

extern "C" void kernel_launch(void* const* d_in, const int* in_sizes, int n_in, void* d_out, int out_size, void* d_ws, size_t ws_size, hipStream_t stream) {
    static int grid = 0;
    if (grid == 0) {
        if (n_in != 29 || ws_size < WS_END) { fprintf(stderr, "kernel_launch: unexpected n_in %d or ws_size %zu (< %zu)\n", n_in, ws_size, (size_t)WS_END); grid = -1; return; }
        int dev = 0, cus = 0, per_cu = 0;
        hipGetDevice(&dev); hipDeviceGetAttribute(&cus, hipDeviceAttributeMultiprocessorCount, dev);
        if (hipFuncSetAttribute((const void*)mk_fwd, hipFuncAttributeMaxDynamicSharedMemorySize, LDS_BYTES) != hipSuccess) { fprintf(stderr, "kernel_launch: hipFuncSetAttribute failed\n"); }
        if (hipOccupancyMaxActiveBlocksPerMultiprocessor(&per_cu, (const void*)mk_fwd, NTHREADS, LDS_BYTES) != hipSuccess || per_cu < 1) { fprintf(stderr, "kernel_launch: occupancy query gave %d\n", per_cu); per_cu = 1; }
        (void)hipGetLastError();
        grid = cus * 1;
        if (grid <= 0) grid = 256;
    }
    if (grid < 0) return;
    Args a; memset(&a, 0, sizeof(a));
    for (int i = 0; i < 29; ++i) a.in[i] = (const float*)d_in[i];
    a.out = (float*)d_out; a.ws = (unsigned char*)d_ws;
#if MK_COOP
    a.ph_lo = 0; a.ph_hi = NPHASE;
    if (hipMemsetAsync((unsigned char*)d_ws + WS_BAR, 0, 16384, stream) != hipSuccess) fprintf(stderr, "kernel_launch: memset of barrier words failed\n");
    void* args[] = {&a};
    hipError_t e = hipLaunchCooperativeKernel((const void*)mk_fwd, dim3(grid), dim3(NTHREADS), args, LDS_BYTES, stream);
    if (e != hipSuccess) fprintf(stderr, "cooperative launch failed: %s (grid %d)\n", hipGetErrorString(e), grid);
#else
    for (int p = 0; p < NPHASE; ++p) { a.ph_lo = p; a.ph_hi = p + 1; hipLaunchKernelGGL(mk_fwd, dim3(grid), dim3(NTHREADS), LDS_BYTES, stream, a); }
#endif
}
```

```cpp
#include <hip/hip_runtime.h>
#include <hip/hip_cooperative_groups.h>
#include <cstdio>
#include <cstring>
namespace cg = cooperative_groups;

#ifndef MK_COOP
#define MK_COOP 1
#endif

typedef _Float16 h16;
typedef _Float16 h16x8 __attribute__((ext_vector_type(8)));
typedef _Float16 h16x4 __attribute__((ext_vector_type(4)));
typedef _Float16 h16x2 __attribute__((ext_vector_type(2)));
typedef float f32x4 __attribute__((ext_vector_type(4)));
typedef float f32x2 __attribute__((ext_vector_type(2)));

namespace pg8 {
#define PG8_LAS __attribute__((address_space(3)))
constexpr int BM = 256, BK = 64, HALF = 128, HTB = HALF * BK * 2, STAGE_BYTES = 8 * HTB, NXCD = 8, WGM = 8;
__host__ __device__ __forceinline__ int lds_byte(int r, int c) { const int st = (r >> 4) * 2 + (c >> 5), rr = r & 15, cc = c & 31, ob = rr * 64 + cc * 2; return st * 1024 + (ob ^ (((ob >> 9) & 1) << 5)); }
__host__ __device__ __forceinline__ void stage_rc(int b, int& R, int& C) { const int st = b / 1024, sb = b % 1024, swz = sb ^ (((sb >> 9) & 1) << 5); R = (st >> 1) * 16 + swz / 64; C = (st & 1) * 32 + (swz % 64) / 2; }
__host__ __device__ __forceinline__ int perm32(int rho) { const int n = rho >> 4, i = rho & 15; return 8 * (i >> 2) + 4 * n + (i & 3); }
struct Unit { int pm, pn; };
struct Gemm { const h16* A; const h16* Bt; int M, N, K; };
struct StaticOrder {
    int nM, nN, nwg, G, c;
    __host__ __device__ void init(int M, int N, int G_, int c_) { nM = M / BM; nN = N / BM; nwg = nM * nN; G = G_; c = c_; }
    __host__ __device__ bool next(int i, Unit& u) const {
        const long L = (long)i * G + c; if (L >= nwg) return false;
        int wgid = (int)L; { const int q = nwg / NXCD, r = nwg % NXCD, xcd = wgid % NXCD, off = wgid / NXCD; wgid = (xcd < r ? xcd * (q + 1) : r * (q + 1) + (xcd - r) * q) + off; }
        const int nig = WGM * nN, gid = wgid / nig, fm = gid * WGM, gsz = (nM - fm) < WGM ? (nM - fm) : WGM;
        u.pm = fm + ((wgid % nig) % gsz); u.pn = (wgid % nig) / gsz; return true;
    }
};

template <class Epi, class Sched>
__device__ __forceinline__ void gemm_phase(PG8_LAS unsigned char* lds, const Gemm g, const Sched& S, const Epi& E) {
    const int tid = threadIdx.x, wid = __builtin_amdgcn_readfirstlane(tid >> 6), lane = tid & 63, wr = wid >> 2, wc = wid & 3, fr = lane & 15, fq = lane >> 4;
    const int K = g.K, nt = K / BK;
    unsigned voffA[2], voffB[2];
#pragma unroll
    for (int i = 0; i < 2; ++i) { int R, C; stage_rc(tid * 16 + i * 8192, R, C); const int Rb = Epi::PERM ? ((R & ~31) + perm32(R & 31)) : R;
        voffA[i] = (unsigned)(R * K + C) * 2u; voffB[i] = (unsigned)(Rb * K + C) * 2u; }
    const size_t kstep = (size_t)(BK * 2);
    const size_t hstep = (size_t)HALF * K * 2;
    const size_t tstep = 2 * hstep;
    const unsigned ldsw = (unsigned)wid * 1024u;
    const int aoff = lds_byte(wr * 64 + fr, fq * 8), boff = lds_byte(wc * 32 + fr, fq * 8);
#define PG8_SA(b, h) (((b) * 2 + (h)) * HTB)
#define PG8_SB(b, h) ((4 + (b) * 2 + (h)) * HTB)
#define PG8_STAGE(bufoff, gbase, voff) do { _Pragma("unroll") for (int _i = 0; _i < 2; ++_i) \
        __builtin_amdgcn_global_load_lds((const unsigned*)((const char*)(gbase) + (voff)[_i]), (PG8_LAS unsigned*)(lds + (bufoff) + ldsw + _i * 8192), 16, 0, 0); } while (0)
#define PG8_LDA(dst, b, h) do { _Pragma("unroll") for (int m = 0; m < 4; ++m) _Pragma("unroll") for (int k = 0; k < 2; ++k) dst[m][k] = *(const PG8_LAS h16x8*)(lds + PG8_SA(b, h) + aoff + m * 2048 + k * 1024); } while (0)
#define PG8_LDB(dst, b, h) do { _Pragma("unroll") for (int n = 0; n < 2; ++n) _Pragma("unroll") for (int k = 0; k < 2; ++k) dst[n][k] = *(const PG8_LAS h16x8*)(lds + PG8_SB(b, h) + boff + n * 2048 + k * 1024); } while (0)
#define PG8_MMA(ai, bj, At, Bt) do { __builtin_amdgcn_s_setprio(1); _Pragma("unroll") for (int m = 0; m < 4; ++m) _Pragma("unroll") for (int n = 0; n < 2; ++n) _Pragma("unroll") for (int k = 0; k < 2; ++k) \
        acc[ai][bj][m][n] = __builtin_amdgcn_mfma_f32_16x16x32_f16(Bt[n][k], At[m][k], acc[ai][bj][m][n], 0, 0, 0); __builtin_amdgcn_s_setprio(0); } while (0)
#define PG8_WAIT_V(n) asm volatile("s_waitcnt vmcnt(" #n ")" ::: "memory")
#define PG8_WAIT_L(n) asm volatile("s_waitcnt lgkmcnt(" #n ")" ::: "memory")
#define PG8_BAR __builtin_amdgcn_s_barrier()
#define PG8_SCHED __builtin_amdgcn_sched_barrier(0)
    Unit cur, nxt; int ui = 0;
    if (!S.next(0, cur)) return;
    f32x4 acc[2][2][4][2];
#pragma unroll
    for (int a = 0; a < 2; ++a)
#pragma unroll
        for (int b = 0; b < 2; ++b)
#pragma unroll
            for (int m = 0; m < 4; ++m)
#pragma unroll
                for (int n = 0; n < 2; ++n) acc[a][b][m][n] = (f32x4){0.f, 0.f, 0.f, 0.f};
    h16x8 At[4][2], B0[2][2], B1[2][2];
    const char* cA = (const char*)g.A + (size_t)cur.pm * tstep; const char* cB = (const char*)g.Bt + (size_t)cur.pn * tstep;
    PG8_STAGE(PG8_SB(0, 0), cB, voffB); PG8_STAGE(PG8_SA(0, 0), cA, voffA); PG8_STAGE(PG8_SB(0, 1), cB + hstep, voffB); PG8_STAGE(PG8_SA(0, 1), cA + hstep, voffA);
    if (wr == 1) PG8_BAR;
    PG8_WAIT_V(4); PG8_BAR;
    PG8_STAGE(PG8_SB(1, 0), cB + kstep, voffB); PG8_STAGE(PG8_SA(1, 0), cA + kstep, voffA); PG8_STAGE(PG8_SB(1, 1), cB + hstep + kstep, voffB);
    PG8_WAIT_V(6); PG8_BAR;
    for (;;) {
        const bool has_next = S.next(ui + 1, nxt);
        const char* nA = has_next ? (const char*)g.A + (size_t)nxt.pm * tstep : cA; const char* nB = has_next ? (const char*)g.Bt + (size_t)nxt.pn * tstep : cB;
        for (int t = 0; t < nt; t += 2) {
            const bool last = (t == nt - 2);
            const char* a1 = cA + (size_t)(t + 1) * kstep;
            const char* a2 = last ? nA : cA + (size_t)(t + 2) * kstep; const char* b2 = last ? nB : cB + (size_t)(t + 2) * kstep;
            const char* a3 = a2 + kstep; const char* b3 = b2 + kstep;
            PG8_LDB(B0, 0, 0); PG8_SCHED; PG8_LDA(At, 0, 0); PG8_STAGE(PG8_SA(1, 1), a1 + hstep, voffA);
            PG8_WAIT_L(8); PG8_BAR; PG8_WAIT_L(0); PG8_MMA(0, 0, At, B0); PG8_BAR; PG8_SCHED;
            PG8_LDB(B1, 0, 1); PG8_STAGE(PG8_SB(0, 0), b2, voffB);
            PG8_BAR; PG8_WAIT_L(0); PG8_MMA(0, 1, At, B1); PG8_BAR;
            PG8_LDA(At, 0, 1); PG8_STAGE(PG8_SA(0, 0), a2, voffA);
            PG8_BAR; PG8_WAIT_L(0); PG8_MMA(1, 0, At, B0); PG8_BAR; PG8_SCHED;
            PG8_STAGE(PG8_SB(0, 1), b2 + hstep, voffB);
            PG8_WAIT_V(6); PG8_BAR; PG8_MMA(1, 1, At, B1); PG8_BAR;
            PG8_LDB(B0, 1, 0); PG8_SCHED; PG8_LDA(At, 1, 0); PG8_STAGE(PG8_SA(0, 1), a2 + hstep, voffA);
            PG8_WAIT_L(8); PG8_BAR; PG8_WAIT_L(0); PG8_MMA(0, 0, At, B0); PG8_BAR; PG8_SCHED;
            PG8_LDB(B1, 1, 1); PG8_STAGE(PG8_SB(1, 0), b3, voffB);
            PG8_BAR; PG8_WAIT_L(0); PG8_MMA(0, 1, At, B1); PG8_BAR;
            PG8_LDA(At, 1, 1); PG8_STAGE(PG8_SA(1, 0), a3, voffA);
            PG8_BAR; PG8_WAIT_L(0); PG8_MMA(1, 0, At, B0); PG8_BAR; PG8_SCHED;
            PG8_STAGE(PG8_SB(1, 1), b3 + hstep, voffB);
            PG8_WAIT_V(6); PG8_BAR; PG8_MMA(1, 1, At, B1); PG8_BAR;
        }
        E(acc, cur, wr, wc, fr, fq);
        if (!has_next) break;
#pragma unroll
        for (int a = 0; a < 2; ++a)
#pragma unroll
            for (int b = 0; b < 2; ++b)
#pragma unroll
                for (int m = 0; m < 4; ++m)
#pragma unroll
                    for (int n = 0; n < 2; ++n) acc[a][b][m][n] = (f32x4){0.f, 0.f, 0.f, 0.f};
        cur = nxt; cA = nA; cB = nB; ++ui;
    }
    PG8_WAIT_V(0);
    if (wr == 0) PG8_BAR;
    PG8_BAR;
#undef PG8_SA
#undef PG8_SB
#undef PG8_STAGE
#undef PG8_LDA
#undef PG8_LDB
#undef PG8_MMA
#undef PG8_WAIT_V
#undef PG8_WAIT_L
#undef PG8_BAR
#undef PG8_SCHED
}
}

constexpr int DM = 1024, TP = 2064, NPR = 8 * TP  , NR = NPR + 1024  , MP = 17664  , MT = 69;
constexpr int NTHREADS = 512, LDS_BYTES = pg8::STAGE_BYTES;
constexpr size_t UB = (size_t)MP * 1024 * 2;
constexpr size_t WS_WIN = 0;
constexpr size_t WS_WOUT = WS_WIN + (size_t)6400 * 1024 * 2;
constexpr size_t WS_WR = WS_WOUT + (size_t)1024 * 2048 * 2;
constexpr size_t WS_WL2 = WS_WR + (size_t)4608 * 1024 * 2;
constexpr size_t WS_WO = WS_WL2 + (size_t)2048 * 256 * 2;
constexpr size_t WS_WEND = WS_WO + (size_t)1024 * 1024 * 2;
static_assert(WS_WEND <= UB, "weights fit one unit");
constexpr size_t WS_X1 = 1 * UB;
constexpr size_t WS_QKVPRE = 3 * UB;
constexpr size_t WS_OBUF = 3 * UB;
constexpr size_t WS_UT = 1 * UB;
constexpr size_t WS_WW = 5 * UB;
constexpr size_t WS_AQ = 13 * UB;
constexpr size_t WS_XS = 3 * UB;
constexpr size_t WS_LOUT = 3 * UB;
constexpr size_t WS_X2 = 3 * UB;
constexpr size_t WS_YBUF = 3 * UB;
constexpr size_t WS_DB = 5 * UB;
constexpr size_t WS_KKB = 7 * UB;
constexpr size_t WS_BBB = 8 * UB;
constexpr size_t WS_Z = 7 * UB;
constexpr size_t WS_K2 = 13 * UB;
constexpr size_t WS_YG = 13 * UB;
constexpr size_t WS_QKV = 9 * UB;
constexpr size_t WS_OG = 9 * UB;
constexpr size_t WS_RKVZ = 9 * UB;
constexpr size_t WS_XN0 = 13 * UB;
constexpr size_t WS_BA = 14 * UB;
constexpr size_t WS_GB = WS_BA + (size_t)MP * 32 * 4;
constexpr size_t WS_LH = WS_GB + (size_t)MP * 32 * 4;
constexpr size_t WS_RK = WS_LH + (size_t)MP * 256 * 2;
constexpr size_t WS_GC = WS_RK + (size_t)MP * 16 * 4;
constexpr size_t WS_BAR = WS_GC + (size_t)4224 * 64 * 4;
constexpr size_t WS_END = WS_BAR + 16384;
constexpr int NCH = 33, NITEM = 128 * NCH;
constexpr size_t O_YP = 0, O_YS = 16777216, O_PG = 17825792, O_PGC = 19922944, O_PR = 20021248, O_PRS = 20545536, O_SG = 20553728, O_SGC = 54108160, O_SR = 55681024, O_SRS = 64069632;

struct TJob { const float* src; h16* dst; int srcK, srcN, dst_ld, row0, nrows, col0, ncols, tile0; };
struct Args {
    const float* in[29];
    float* out; unsigned char* ws;
    int ph_lo, ph_hi;
};
constexpr int NTILES_PREP = 3648;
enum { I_XP = 0, I_XS, I_SG, I_SGC, I_SR, I_SRS, I_META, I_NW, I_FNW, I_WIN, I_CW, I_ALOG, I_DTB, I_GNW, I_WOUT, I_MU, I_WRKVZ, I_W0, I_W1, I_W2, I_A0, I_A1, I_A2, I_KK, I_KA, I_RK, I_LNW, I_LNB, I_WO };

__device__ __forceinline__ float wave_sum(float v) {
#pragma unroll
    for (int o = 32; o > 0; o >>= 1) v += __shfl_xor(v, o);
    return v;
}
#define DPP_ADD(x, ctrl) ((x) + __builtin_bit_cast(float, __builtin_amdgcn_update_dpp(0, __builtin_bit_cast(int, (x)), (ctrl), 0xF, 0xF, true)))
__device__ __forceinline__ float red8(float x) { x = DPP_ADD(x, 0xB1); x = DPP_ADD(x, 0x4E); x = DPP_ADD(x, 0x141); return x; }
__device__ __forceinline__ float red16(float x) { x = DPP_ADD(x, 0xB1); x = DPP_ADD(x, 0x4E); x = DPP_ADD(x, 0x141); x = DPP_ADD(x, 0x140); return x; }
__device__ __forceinline__ float wsum(float x) { x = red16(x); x += __shfl_xor(x, 16); x += __shfl_xor(x, 32); return x; }
__device__ __forceinline__ float sq4(const f32x4 v) { return v[0] * v[0] + v[1] * v[1] + v[2] * v[2] + v[3] * v[3]; }
__device__ __forceinline__ float fexp_(float x) { return __builtin_amdgcn_exp2f(x * 1.4426950408889634f); }
__device__ __forceinline__ float sigmoidf_(float x) { return __builtin_amdgcn_rcpf(1.0f + fexp_(-x)); }
__device__ __forceinline__ float siluf_(float x) { return x * __builtin_amdgcn_rcpf(1.0f + fexp_(-x)); }
__device__ __forceinline__ float softplusf_(float x) { if (x > 20.0f) return x; const float t = fexp_(x); return t < 0.02f ? t * (1.0f - t * (0.5f - t * 0.33333334f)) : __builtin_amdgcn_logf(1.0f + t) * 0.6931471805599453f; }
__device__ __forceinline__ void row_bt(int r, int& b, int& t, bool& samp) {
    if (r < NPR) { b = r / TP; t = r - b * TP; samp = false; } else { const int q = r - NPR; b = q >> 3; t = q & 7; samp = true; }
}
__device__ __forceinline__ const float* xrow(const Args& a, int r) {
    if (r < NPR) { const int b = r / TP, t = r - b * TP; return t < 16 ? a.in[I_META] + (size_t)t * DM : a.in[I_XP] + ((size_t)b * 2048 + (t - 16)) * DM; }
    return a.in[I_XS] + (size_t)(r - NPR) * DM;
}
__device__ __forceinline__ h16x8 pack8(const f32x4 v0, const f32x4 v1) {
    h16x8 w; w[0] = (h16)v0[0]; w[1] = (h16)v0[1]; w[2] = (h16)v0[2]; w[3] = (h16)v0[3]; w[4] = (h16)v1[0]; w[5] = (h16)v1[1]; w[6] = (h16)v1[2]; w[7] = (h16)v1[3]; return w;
}


#define XB_TMO      128
#define XB_XCNT(j)  (256  + 64 * (j))
#define XB_XSUB(j)  (1280 + 64 * (j))
#define XB_XGEN(j)  (2304 + 64 * (j))
#define XB_TOP      3328
#define XB_TOPGEN   3392
#define XCD_BAR_WORDS 3456
#define XB_SPIN_CAP (1u << 20)
__device__ __forceinline__ unsigned xb_ld(unsigned* p)              { return __hip_atomic_load(p, __ATOMIC_RELAXED, __HIP_MEMORY_SCOPE_AGENT); }
__device__ __forceinline__ unsigned xb_add(unsigned* p, unsigned v) { return __hip_atomic_fetch_add(p, v, __ATOMIC_RELAXED, __HIP_MEMORY_SCOPE_AGENT); }
__device__ __forceinline__ unsigned xb_xcc_id() { return (unsigned)__builtin_amdgcn_s_getreg((3 << 11) | 20) & 0xFu; }
#define XB_SPIN(cond, bar) do { unsigned _sp = 0; while (cond) { __builtin_amdgcn_s_sleep(1); \
    if ((++_sp & 255u) == 0u) { if (xb_ld(&(bar)[XB_TMO])) break; if (_sp > XB_SPIN_CAP) { atomicAdd(&(bar)[XB_TMO], 1u); break; } } } } while (0)
struct XcdBarrier { unsigned* bar; unsigned x; volatile PG8_LAS unsigned* st; };
__device__ __forceinline__ XcdBarrier xcd_barrier_post(unsigned* bar, volatile PG8_LAS unsigned* st) {
    XcdBarrier b; b.bar = bar; b.x = xb_xcc_id(); b.st = st;
    if (threadIdx.x == 0) (void)xb_add(&bar[XB_XCNT(b.x)], 1u);
    return b;
}
__device__ __forceinline__ void xcd_barrier_complete(unsigned* bar, unsigned x, unsigned& nloc, unsigned& nx) {
    const unsigned G = gridDim.x * gridDim.y * gridDim.z;
    unsigned sum, cnt, mine, sp = 0u;
    for (;;) {
        sum = 0u; cnt = 0u; mine = 0u;
#pragma unroll
        for (unsigned j = 0; j < 16; ++j) { const unsigned c = xb_ld(&bar[XB_XCNT(j)]); sum += c; cnt += (c > 0u) ? 1u : 0u; mine = (j == x) ? c : mine; }
        if (sum == G) break;
        __builtin_amdgcn_s_sleep(1);
        if ((++sp & 255u) == 0u) { if (xb_ld(&bar[XB_TMO])) break; if (sp > XB_SPIN_CAP) { atomicAdd(&bar[XB_TMO], 1u); break; } }
    }
    nloc = mine > 0u ? mine : 1u; nx = cnt > 0u ? cnt : 1u;
}
__device__ __forceinline__ void xcd_barrier(const XcdBarrier& b) {
    asm volatile("s_waitcnt vmcnt(0)" ::: "memory");
    __syncthreads();
    if (threadIdx.x == 0) {
        unsigned* bar = b.bar;
        __builtin_amdgcn_s_waitcnt(0);
        unsigned nloc = b.st[0], nx = b.st[1];
        if (nloc == 0u) { xcd_barrier_complete(bar, b.x, nloc, nx); b.st[0] = nloc; b.st[1] = nx; }
        const unsigned old = xb_add(&bar[XB_XSUB(b.x)], 1u);
        const unsigned gen = old / nloc;
        if (old + 1u == (gen + 1u) * nloc) {
            __builtin_amdgcn_fence(__ATOMIC_RELEASE, "agent");
            asm volatile("s_waitcnt vmcnt(0)" ::: "memory");
            const unsigned og = xb_add(&bar[XB_TOP], 1u);
            const unsigned tg = og / nx;
            if (og + 1u == (tg + 1u) * nx) xb_add(&bar[XB_TOPGEN], 1u);
            else XB_SPIN(xb_ld(&bar[XB_TOPGEN]) == tg, bar);
            __builtin_amdgcn_fence(__ATOMIC_ACQUIRE, "agent");
            xb_add(&bar[XB_XGEN(b.x)], 1u);
            asm volatile("s_waitcnt vmcnt(0)" ::: "memory");
        } else {
            XB_SPIN(xb_ld(&bar[XB_XGEN(b.x)]) == gen, bar);
            __builtin_amdgcn_fence(__ATOMIC_ACQUIRE, "agent");
            asm volatile("s_waitcnt vmcnt(0)" ::: "memory");
        }
    }
    __syncthreads();
}

__device__ __forceinline__ void phase_prep(const Args& a, float* ldsf) {
    const int tid = threadIdx.x, lane = tid & 63, wid = tid >> 6;
    for (int tile = blockIdx.x; tile < NTILES_PREP; tile += gridDim.x) {
        TJob jb;
        { h16* Win = (h16*)(a.ws + WS_WIN); h16* Wout = (h16*)(a.ws + WS_WOUT); h16* Wr = (h16*)(a.ws + WS_WR); h16* Wl2 = (h16*)(a.ws + WS_WL2); h16* Wo = (h16*)(a.ws + WS_WO);
          if (tile < 1600)      jb = TJob{a.in[I_WIN], Win, 1024, 6176, 1024, 0, 6400, 0, 1024, 0};
          else if (tile < 2112) jb = TJob{a.in[I_WOUT], Wout, 2048, 1024, 2048, 0, 1024, 0, 2048, 1600};
          else if (tile < 3136) { const int s = (tile - 2112) >> 8; jb = TJob{a.in[I_WRKVZ] + (size_t)s * 1024 * 1024, Wr, 1024, 1024, 1024, s * 1024, 1024, 0, 1024, 2112 + s * 256}; }
          else if (tile < 3200) jb = TJob{a.in[I_W1], Wr, 1024, 64, 1024, 4096, 256, 0, 1024, 3136};
          else if (tile < 3264) jb = TJob{a.in[I_A1], Wr, 1024, 64, 1024, 4352, 256, 0, 1024, 3200};
          else if (tile < 3328) jb = TJob{a.in[I_W2], Wl2, 64, 1024, 256, 0, 1024, 0, 256, 3264};
          else if (tile < 3392) jb = TJob{a.in[I_A2], Wl2, 64, 1024, 256, 1024, 1024, 64, 256, 3328};
          else                  jb = TJob{a.in[I_WO], Wo, 1024, 1024, 1024, 0, 1024, 0, 1024, 3392}; }
        const int lt = tile - jb.tile0, nck = jb.ncols >> 6, tn = lt / nck, tk = lt - tn * nck;
        __syncthreads();
#pragma unroll
        for (int e = 0; e < 8; ++e) {
            const int idx = e * 512 + tid, kk = idx >> 6, nn = idx & 63;
            const int ks = tk * 64 + kk - jb.col0, ns = tn * 64 + nn;
            float v = 0.f;
            if (ks >= 0 && ks < jb.srcK && ns < jb.srcN) v = jb.src[(size_t)ks * jb.srcN + ns];
            ldsf[kk * 65 + nn] = v;
        }
        __syncthreads();
#pragma unroll
        for (int e = 0; e < 8; ++e) {
            const int idx = e * 512 + tid, nn = idx >> 6, kk = idx & 63;
            jb.dst[(size_t)(jb.row0 + tn * 64 + nn) * jb.dst_ld + tk * 64 + kk] = (h16)ldsf[kk * 65 + nn];
        }
    }
    h16* xn0 = (h16*)(a.ws + WS_XN0);
    const float* nw = a.in[I_NW];
    for (int row = blockIdx.x * 8 + wid; row < MP; row += gridDim.x * 8) {
        h16* op = xn0 + (size_t)row * DM;
        if (row >= NR) {
#pragma unroll
            for (int i = 0; i < 4; ++i) *(h16x4*)(op + i * 256 + lane * 4) = (h16x4){(h16)0.f, (h16)0.f, (h16)0.f, (h16)0.f};
            continue;
        }
        const float* xp = xrow(a, row);
        f32x4 v[4]; float ss = 0.f;
#pragma unroll
        for (int i = 0; i < 4; ++i) { v[i] = *(const f32x4*)(xp + i * 256 + lane * 4); ss += v[i][0] * v[i][0] + v[i][1] * v[i][1] + v[i][2] * v[i][2] + v[i][3] * v[i][3]; }
        ss = wave_sum(ss);
        const float sc = rsqrtf(ss * (1.0f / 1024.0f) + 1e-6f);
#pragma unroll
        for (int i = 0; i < 4; ++i) { const f32x4 w = *(const f32x4*)(nw + i * 256 + lane * 4); h16x4 o;
#pragma unroll
            for (int j = 0; j < 4; ++j) o[j] = (h16)(v[i][j] * sc * w[j]);
            *(h16x4*)(op + i * 256 + lane * 4) = o; }
    }
}

struct EpiProj {
    static constexpr bool PERM = true;
    h16* qkv; h16* z; float* ba;
    __device__ __forceinline__ void operator()(const f32x4 (&acc)[2][2][4][2], const pg8::Unit& u, int wr, int wc, int fr, int fq) const {
        const int row0 = u.pm * 256 + wr * 64 + fr;
        if (u.pn < 24) {
            h16* base = u.pn < 16 ? qkv : z; const int ld = u.pn < 16 ? 4096 : 2048; const int col0 = (u.pn < 16 ? u.pn : u.pn - 16) * 256 + wc * 32 + 8 * fq;
#pragma unroll
            for (int ai = 0; ai < 2; ++ai)
#pragma unroll
                for (int m = 0; m < 4; ++m) { h16* rowp = base + (size_t)(row0 + ai * 128 + m * 16) * ld + col0;
#pragma unroll
                    for (int bj = 0; bj < 2; ++bj) *(h16x8*)(rowp + bj * 128) = pack8(acc[ai][bj][m][0], acc[ai][bj][m][1]); }
        } else if (wc == 0) {
#pragma unroll
            for (int ai = 0; ai < 2; ++ai)
#pragma unroll
                for (int m = 0; m < 4; ++m) { float* rowp = ba + (size_t)(row0 + ai * 128 + m * 16) * 32 + 8 * fq;
                    *(f32x4*)rowp = acc[ai][0][m][0]; *(f32x4*)(rowp + 4) = acc[ai][0][m][1]; }
        }
    }
};
struct EpiH16 {
    static constexpr bool PERM = true;
    h16* O; int ld;
    __device__ __forceinline__ void operator()(const f32x4 (&acc)[2][2][4][2], const pg8::Unit& u, int wr, int wc, int fr, int fq) const {
        const int row0 = u.pm * 256 + wr * 64 + fr, col0 = u.pn * 256 + wc * 32 + 8 * fq;
#pragma unroll
        for (int ai = 0; ai < 2; ++ai)
#pragma unroll
            for (int m = 0; m < 4; ++m) { h16* rowp = O + (size_t)(row0 + ai * 128 + m * 16) * ld + col0;
#pragma unroll
                for (int bj = 0; bj < 2; ++bj) *(h16x8*)(rowp + bj * 128) = pack8(acc[ai][bj][m][0], acc[ai][bj][m][1]); }
    }
};
struct EpiResX {
    static constexpr bool PERM = false;
    const float* meta; const float* xpr; const float* xsm; float* O;
    __device__ __forceinline__ void operator()(const f32x4 (&acc)[2][2][4][2], const pg8::Unit& u, int wr, int wc, int fr, int fq) const {
        const int row0 = u.pm * 256 + wr * 64 + fr, col0 = u.pn * 256 + wc * 32 + 4 * fq;
#pragma unroll
        for (int ai = 0; ai < 2; ++ai)
#pragma unroll
            for (int m = 0; m < 4; ++m) { const int row = row0 + ai * 128 + m * 16; if (row >= NR) continue;
                const float* xp;
                if (row < NPR) { const int b = row / TP, t = row - b * TP; xp = t < 16 ? meta + (size_t)t * DM : xpr + ((size_t)b * 2048 + (t - 16)) * DM; } else xp = xsm + (size_t)(row - NPR) * DM;
                xp += col0; float* rowp = O + (size_t)row * DM + col0;
#pragma unroll
                for (int bj = 0; bj < 2; ++bj)
#pragma unroll
                    for (int n = 0; n < 2; ++n) *(f32x4*)(rowp + bj * 128 + n * 16) = *(const f32x4*)(xp + bj * 128 + n * 16) + acc[ai][bj][m][n]; }
    }
};
struct EpiResB {
    static constexpr bool PERM = false;
    const float* base; float* O;
    __device__ __forceinline__ void operator()(const f32x4 (&acc)[2][2][4][2], const pg8::Unit& u, int wr, int wc, int fr, int fq) const {
        const int row0 = u.pm * 256 + wr * 64 + fr, col0 = u.pn * 256 + wc * 32 + 4 * fq;
#pragma unroll
        for (int ai = 0; ai < 2; ++ai)
#pragma unroll
            for (int m = 0; m < 4; ++m) { const int row = row0 + ai * 128 + m * 16; if (row >= NR) continue;
                const float* xp = base + (size_t)row * DM + col0; float* rowp = O + (size_t)row * DM + col0;
#pragma unroll
                for (int bj = 0; bj < 2; ++bj)
#pragma unroll
                    for (int n = 0; n < 2; ++n) *(f32x4*)(rowp + bj * 128 + n * 16) = *(const f32x4*)(xp + bj * 128 + n * 16) + acc[ai][bj][m][n]; }
    }
};
struct EpiG {
    static constexpr bool PERM = true;
    h16* rkvz; h16* lh;
    __device__ __forceinline__ void operator()(const f32x4 (&acc)[2][2][4][2], const pg8::Unit& u, int wr, int wc, int fr, int fq) const {
        const int s = u.pm / MT, i = u.pm - s * MT, row0 = i * 256 + wr * 64 + fr;
        if (s < 4) {
            h16* base = rkvz + (size_t)s * MP * 1024; const int col0 = (u.pn - 4 * s) * 256 + wc * 32 + 8 * fq;
#pragma unroll
            for (int ai = 0; ai < 2; ++ai)
#pragma unroll
                for (int m = 0; m < 4; ++m) { h16* rowp = base + (size_t)(row0 + ai * 128 + m * 16) * 1024 + col0;
#pragma unroll
                    for (int bj = 0; bj < 2; ++bj) *(h16x8*)(rowp + bj * 128) = pack8(acc[ai][bj][m][0], acc[ai][bj][m][1]); }
        } else if (wc < 2) {
            const int cb = (s == 4 ? 0 : 64) + wc * 32 + 8 * fq;
#pragma unroll
            for (int ai = 0; ai < 2; ++ai)
#pragma unroll
                for (int m = 0; m < 4; ++m) { h16* rowp = lh + (size_t)(row0 + ai * 128 + m * 16) * 256;
                    f32x4 v0 = acc[ai][0][m][0], v1 = acc[ai][0][m][1];
                    if (s == 4) {
#pragma unroll
                        for (int j = 0; j < 4; ++j) { v0[j] = tanhf(v0[j]); v1[j] = tanhf(v1[j]); } }
                    *(h16x8*)(rowp + cb) = pack8(v0, v1);
                    *(h16x8*)(rowp + 128 + cb) = pack8((f32x4){0.f, 0.f, 0.f, 0.f}, (f32x4){0.f, 0.f, 0.f, 0.f}); }
        }
    }
};
struct OrderG {
    pg8::StaticOrder so; int G, c;
    __device__ void init(int G_, int c_) { so.init(4 * MT * 256, 1024, G_, c_); G = G_; c = c_; }
    __device__ bool next(int i, pg8::Unit& u) const {
        long L = (long)i * G + c;
        if (L < 4 * MT * 4) { pg8::Unit v; so.next(i, v); u.pm = v.pm; u.pn = (v.pm / MT) * 4 + v.pn; return true; }
        L -= 4 * MT * 4; if (L >= 2 * MT) return false;
        const int s = 4 + (int)(L / MT), ii = (int)(L % MT); u.pm = s * MT + ii; u.pn = 12 + s; return true;
    }
};

__device__ __forceinline__ void phase_conv(const Args& a, float* ldsf) {
    const int tid = threadIdx.x, lane = tid & 63, wid = tid >> 6;
    const h16* pre = (const h16*)(a.ws + WS_QKVPRE); h16* qkv = (h16*)(a.ws + WS_QKV);
    const float* ba = (const float*)(a.ws + WS_BA); float* gb = (float*)(a.ws + WS_GB);
    const float* cst = a.in[I_SGC];
    for (int i = tid; i < 4096; i += NTHREADS) { const f32x4 w = *(const f32x4*)(a.in[I_CW] + (size_t)i * 4); ldsf[i] = w[0]; ldsf[4096 + i] = w[1]; ldsf[8192 + i] = w[2]; ldsf[12288 + i] = w[3]; }
    __syncthreads();
    for (int row = blockIdx.x * 8 + wid; row < NR; row += gridDim.x * 8) {
        int b, t; bool samp; row_bt(row, b, t, samp);
        for (int half = 0; half < 2; ++half) {
            h16x8 x[4][4];
#pragma unroll
            for (int sg = 0; sg < 4; ++sg) {
                const int c0 = (half * 4 + sg) * 512 + lane * 8;
#pragma unroll
                for (int jj = 0; jj < 4; ++jj) {
                    const int idx = t + jj;
                    if (idx >= 3) x[sg][jj] = *(const h16x8*)(pre + (size_t)(row - 3 + jj) * 4096 + c0);
                    else if (samp) { const float* bp = cst + ((size_t)b * 3 + idx) * 4096 + c0; const f32x4 p0 = *(const f32x4*)bp, p1 = *(const f32x4*)(bp + 4); x[sg][jj] = pack8(p0, p1); }
                    else x[sg][jj] = pack8((f32x4){0.f, 0.f, 0.f, 0.f}, (f32x4){0.f, 0.f, 0.f, 0.f});
                }
            }
#pragma unroll
            for (int sg = 0; sg < 4; ++sg) {
                const int seg = half * 4 + sg, c0 = seg * 512 + lane * 8;
                float y[8];
#pragma unroll
                for (int j = 0; j < 8; ++j) y[j] = 0.f;
#pragma unroll
                for (int jj = 0; jj < 4; ++jj) { const f32x4 w0 = *(const f32x4*)(ldsf + jj * 4096 + c0), w1 = *(const f32x4*)(ldsf + jj * 4096 + c0 + 4);
#pragma unroll
                    for (int j = 0; j < 4; ++j) { y[j] += (float)x[sg][jj][j] * w0[j]; y[4 + j] += (float)x[sg][jj][4 + j] * w1[j]; } }
                float ss = 0.f;
#pragma unroll
                for (int j = 0; j < 8; ++j) { y[j] = siluf_(y[j]); ss += y[j] * y[j]; }
                float sc = 1.0f;
                if (seg < 4) { ss = red16(ss); sc = rsqrtf(ss + 1e-6f) * (seg < 2 ? 0.08838834764831845f : 1.0f); }
                h16x8 o;
#pragma unroll
                for (int j = 0; j < 8; ++j) o[j] = (h16)(y[j] * sc);
                *(h16x8*)(qkv + (size_t)row * 4096 + c0) = o;
                float* cso = nullptr;
                if (!samp && t >= TP - 3) cso = a.out + O_PGC + ((size_t)b * 3 + (t - (TP - 3))) * 4096 + c0;
                if (samp && t >= 5) cso = a.out + O_SGC + ((size_t)b * 3 + (t - 5)) * 4096 + c0;
                if (cso) { const h16x8 u = x[sg][3]; *(f32x4*)cso = (f32x4){(float)u[0], (float)u[1], (float)u[2], (float)u[3]}; *(f32x4*)(cso + 4) = (f32x4){(float)u[4], (float)u[5], (float)u[6], (float)u[7]}; }
            }
        }
        if (lane < 16) {
            const float bv = ba[(size_t)row * 32 + lane], av = ba[(size_t)row * 32 + 16 + lane];
            gb[(size_t)row * 32 + lane] = sigmoidf_(bv);
            gb[(size_t)row * 32 + 16 + lane] = -expf(a.in[I_ALOG][lane]) * softplusf_(av + a.in[I_DTB][lane]);
        }
    }
}

__device__ __forceinline__ void phase_gdn_scan(const Args& a, float* ldsf) {
    const int tid = threadIdx.x;
    const int vl = tid >> 3, kq = tid & 7;
    const h16* qkv = (const h16*)(a.ws + WS_QKV); const float* gb = (const float*)(a.ws + WS_GB); h16* obuf = (h16*)(a.ws + WS_OBUF);
    const int stt = tid >> 6, sp = tid & 63;
    float Sn[16]; h16x4 pqk = {}; h16 pv = (h16)0.f; float pg = 0.f, pb = 0.f;
#define GS_FETCH(itx) do { const int q_ = (itx), seq_ = q_ >> 1, vh_ = q_ & 1, b_ = seq_ >> 4, hv_ = seq_ & 15, hq_ = hv_ >> 1; const int r0_ = NPR + b_ * 8; \
        const float* spp_ = a.in[I_SG] + ((size_t)(b_ * 16 + hv_) * 128 + kq * 16) * 128 + vh_ * 64 + vl; \
        _Pragma("unroll") for (int i = 0; i < 16; ++i) Sn[i] = spp_[(size_t)i * 128]; \
        const h16* rp_ = qkv + (size_t)(r0_ + stt) * 4096; \
        pqk = *(const h16x4*)(rp_ + (sp < 32 ? hq_ * 128 + sp * 4 : 1024 + hq_ * 128 + (sp - 32) * 4)); pv = rp_[2048 + hv_ * 128 + vh_ * 64 + sp]; \
        if (tid < 8) { pb = gb[(size_t)(r0_ + tid) * 32 + hv_]; pg = gb[(size_t)(r0_ + tid) * 32 + 16 + hv_]; } } while (0)
    int it = blockIdx.x;
    if (it < 4096) GS_FETCH(it);
    int cur = 0;
    for (; it < 4096; it += gridDim.x) {
        const int seq = it >> 1, vhalf = it & 1, b = seq >> 4, hv = seq & 15;
        const int row0 = NPR + b * 8, v = vhalf * 64 + vl;
        float S[16];
#pragma unroll
        for (int i = 0; i < 16; ++i) S[i] = Sn[i];
        float* Lb = ldsf + cur * 2576;
        *(f32x4*)(Lb + (sp < 32 ? 0 : 1024) + stt * 128 + (sp & 31) * 4) = (f32x4){(float)pqk[0], (float)pqk[1], (float)pqk[2], (float)pqk[3]};
        Lb[2048 + stt * 64 + sp] = (float)pv;
        if (tid < 8) { Lb[2560 + tid] = fexp_(pg); Lb[2568 + tid] = pb; }
        __syncthreads();
        if (it + (int)gridDim.x < 4096) GS_FETCH(it + gridDim.x);
        float osel = 0.f;
#pragma unroll 2
        for (int tt = 0; tt < 8; ++tt) {
            const float al = Lb[2560 + tt], be = Lb[2568 + tt], vv = Lb[2048 + tt * 64 + vl];
            const f32x4* kp = (const f32x4*)(Lb + 1024 + tt * 128 + kq * 16); const f32x4* qp = (const f32x4*)(Lb + tt * 128 + kq * 16);
            float kr[16];
            float d0 = 0.f, d1 = 0.f;
#pragma unroll
            for (int i = 0; i < 4; ++i) { const f32x4 kv = kp[i]; kr[4 * i] = kv[0]; kr[4 * i + 1] = kv[1]; kr[4 * i + 2] = kv[2]; kr[4 * i + 3] = kv[3]; }
#pragma unroll
            for (int i = 0; i < 16; i += 2) { d0 = __builtin_fmaf(kr[i], S[i], d0); d1 = __builtin_fmaf(kr[i + 1], S[i + 1], d1); }
            const float dot = red8(d0 + d1);
            const float c = be * (vv - al * dot);
            float o0 = 0.f, o1 = 0.f;
#pragma unroll
            for (int i = 0; i < 4; ++i) { const f32x4 qv = qp[i];
#pragma unroll
                for (int j = 0; j < 4; ++j) { const float s_ = al * S[4 * i + j] + kr[4 * i + j] * c; S[4 * i + j] = s_; if (j & 1) o1 = __builtin_fmaf(qv[j], s_, o1); else o0 = __builtin_fmaf(qv[j], s_, o0); } }
            const float od = red8(o0 + o1);
            osel = (kq == tt) ? od : osel;
        }
        obuf[(size_t)(row0 + kq) * 2048 + hv * 128 + v] = (h16)osel;
        float* so = a.out + O_SG + ((size_t)(b * 16 + hv) * 128 + kq * 16) * 128 + v;
#pragma unroll
        for (int i = 0; i < 16; ++i) so[(size_t)i * 128] = S[i];
        cur ^= 1;
    }
#undef GS_FETCH
}

__device__ __forceinline__ void phase_gdn_pre(const Args& a, float* ldsf) {
    const int tid = threadIdx.x, hb = tid >> 8, ht = tid & 255, hw = ht >> 6, l = tid & 63, lr = l & 15, lq = l >> 4;
    const h16* qkv = (const h16*)(a.ws + WS_QKV); const float* gb = (const float*)(a.ws + WS_GB);
    h16* UT = (h16*)(a.ws + WS_UT); h16* WW = (h16*)(a.ws + WS_WW); h16* AQ = (h16*)(a.ws + WS_AQ); float* GC = (float*)(a.ws + WS_GC);
    float* Am = ldsf + hb * 9472;
    h16* XT = (h16*)(Am + 4352);
    float* gs = Am + 4096, *bs = Am + 4160, *gcs = Am + 4224;
    const int niter = (NITEM + gridDim.x * 2 - 1) / (gridDim.x * 2);
    for (int n = 0; n < niter; ++n) {
        const int itm = (n * gridDim.x + blockIdx.x) * 2 + hb;
        const bool valid = itm < NITEM;
        const int seq = valid ? itm / NCH : 0, c = valid ? itm - seq * NCH : 0, b = seq >> 4, hv = seq & 15, hq = hv >> 1;
        const int rowb = b * TP + 64 * c, nval = (TP - 64 * c) < 64 ? (TP - 64 * c) : 64;
        const int ib = hw;
        h16x8 aq[4], ak[4], kf[4][4]; h16x2 xr[32]; float gv = 0.f, bv = 0.f;
#pragma unroll
        for (int ks = 0; ks < 4; ++ks) { aq[ks] = *(const h16x8*)(qkv + (size_t)(rowb + 16 * ib + lr) * 4096 + hq * 128 + 32 * ks + 8 * lq); ak[ks] = *(const h16x8*)(qkv + (size_t)(rowb + 16 * ib + lr) * 4096 + 1024 + hq * 128 + 32 * ks + 8 * lq);
#pragma unroll
            for (int jb = 0; jb < 4; ++jb) kf[jb][ks] = *(const h16x8*)(qkv + (size_t)(rowb + 16 * jb + lr) * 4096 + 1024 + hq * 128 + 32 * ks + 8 * lq); }
        { const h16* xp = qkv + (size_t)rowb * 4096 + (ht < 128 ? 2048 + hv * 128 + ht : 1024 + hq * 128 + (ht - 128));
#pragma unroll
          for (int i = 0; i < 32; ++i) { xr[i][0] = xp[(size_t)(2 * i) * 4096]; xr[i][1] = xp[(size_t)(2 * i + 1) * 4096]; } }
        if (ht < 64 && ht < nval) { gv = gb[(size_t)(rowb + ht) * 32 + 16 + hv]; bv = gb[(size_t)(rowb + ht) * 32 + hv]; }
        __syncthreads();
        if (ht < 64) { gs[ht] = gv; bs[ht] = bv; }
        __syncthreads();
        if (ht < 64) { float sgc = 0.f;
#pragma unroll
            for (int j4 = 0; j4 < 16; ++j4) { const f32x4 g4 = *(const f32x4*)(gs + 4 * j4);
#pragma unroll
                for (int jj = 0; jj < 4; ++jj) sgc += (4 * j4 + jj <= ht) ? g4[jj] : 0.f; }
            gcs[ht] = sgc; if (valid) GC[(size_t)itm * 64 + ht] = sgc; }
        __syncthreads();
        if (valid) {
            float gci[4], bei[4];
#pragma unroll
            for (int r = 0; r < 4; ++r) { gci[r] = gcs[16 * ib + 4 * lq + r]; bei[r] = bs[16 * ib + 4 * lq + r]; }
#pragma unroll
            for (int jb = 0; jb < 4; ++jb) {
                h16* aqp = AQ + (size_t)itm * 4096 + (size_t)(16 * ib + 4 * lq) * 64 + 16 * jb + lr;
                if (jb > ib) {
#pragma unroll
                    for (int r = 0; r < 4; ++r) aqp[r * 64] = (h16)0.f;
                } else {
                    f32x4 ckk = (f32x4){0.f, 0.f, 0.f, 0.f}, cqk = (f32x4){0.f, 0.f, 0.f, 0.f};
#pragma unroll
                    for (int ks = 0; ks < 4; ++ks) {
                        ckk = __builtin_amdgcn_mfma_f32_16x16x32_f16(ak[ks], kf[jb][ks], ckk, 0, 0, 0); cqk = __builtin_amdgcn_mfma_f32_16x16x32_f16(aq[ks], kf[jb][ks], cqk, 0, 0, 0); }
                    const int j = 16 * jb + lr; const float gcj = gcs[j];
#pragma unroll
                    for (int r = 0; r < 4; ++r) { const int i = 16 * ib + 4 * lq + r; const float dec = fexp_(gci[r] - gcj);
                        Am[i * 64 + j] = (j < i) ? bei[r] * ckk[r] * dec : 0.f;
                        aqp[r * 64] = (h16)((j <= i) ? cqk[r] * dec : 0.f); }
                }
            }
        }
        __syncthreads();
        if (valid) {
            float x[64];
            if (ht < 128) {
#pragma unroll
                for (int i = 0; i < 64; ++i) x[i] = (float)xr[i >> 1][i & 1] * bs[i]; }
            else {
#pragma unroll
                for (int i = 0; i < 64; ++i) x[i] = (float)xr[i >> 1][i & 1] * bs[i] * fexp_(gcs[i]); }
            {
                f32x4 ab0[8], ab1[8];
#define SUB_LOAD(dst, i, jlo) do { _Pragma("unroll") for (int v_ = 0; v_ < 8; ++v_) if ((jlo) + 4 * v_ < (i)) dst[v_] = *(const f32x4*)(Am + (i) * 64 + (jlo) + 4 * v_); } while (0)
#define SUB_FMA(src, i, jlo) do { _Pragma("unroll") for (int v_ = 0; v_ < 8; ++v_) { const int j_ = (jlo) + 4 * v_; \
                    if (j_ < (i))     a0 = __builtin_fmaf(src[v_][0], x[j_], a0); if (j_ + 1 < (i)) a1 = __builtin_fmaf(src[v_][1], x[j_ + 1], a1); \
                    if (j_ + 2 < (i)) a2 = __builtin_fmaf(src[v_][2], x[j_ + 2], a2); if (j_ + 3 < (i)) a3 = __builtin_fmaf(src[v_][3], x[j_ + 3], a3); } } while (0)
                SUB_LOAD(ab0, 1, 0);
#pragma unroll
                for (int i = 1; i < 31; i += 2) {
                    { float a0 = 0.f, a1 = 0.f, a2 = 0.f, a3 = 0.f; SUB_LOAD(ab1, i + 1, 0); __builtin_amdgcn_sched_barrier(0); SUB_FMA(ab0, i, 0); x[i] -= (a0 + a1) + (a2 + a3); }
                    { float a0 = 0.f, a1 = 0.f, a2 = 0.f, a3 = 0.f; SUB_LOAD(ab0, i + 2, 0); __builtin_amdgcn_sched_barrier(0); SUB_FMA(ab1, i + 1, 0); x[i + 1] -= (a0 + a1) + (a2 + a3); }
                }
                { float a0 = 0.f, a1 = 0.f, a2 = 0.f, a3 = 0.f; SUB_FMA(ab0, 31, 0); x[31] -= (a0 + a1) + (a2 + a3); }
                {
#pragma unroll
                    for (int i8 = 0; i8 < 4; ++i8) { h16x8 o;
#pragma unroll
                        for (int jj = 0; jj < 8; ++jj) o[jj] = (h16)x[8 * i8 + jj];
                        *(h16x8*)(XT + ht * 40 + 8 * i8) = o; }
                    h16x8 afr[2];
#pragma unroll
                    for (int rt = 0; rt < 2; ++rt) { const f32x4 p0 = *(const f32x4*)(Am + (32 + 16 * rt + lr) * 64 + 8 * lq), p1 = *(const f32x4*)(Am + (32 + 16 * rt + lr) * 64 + 8 * lq + 4); afr[rt] = pack8(p0, p1); }
                    __builtin_amdgcn_fence(__ATOMIC_RELEASE, "wavefront");
                    __builtin_amdgcn_wave_barrier();
                    f32x4 cc[2][4];
#pragma unroll
                    for (int ct = 0; ct < 4; ++ct) { const h16x8 bf = *(const h16x8*)(XT + (64 * hw + 16 * ct + lr) * 40 + 8 * lq);
#pragma unroll
                        for (int rt = 0; rt < 2; ++rt) cc[rt][ct] = __builtin_amdgcn_mfma_f32_16x16x32_f16(afr[rt], bf, (f32x4){0.f, 0.f, 0.f, 0.f}, 0, 0, 0); }
                    __builtin_amdgcn_wave_barrier();
#pragma unroll
                    for (int ct = 0; ct < 4; ++ct)
#pragma unroll
                        for (int rt = 0; rt < 2; ++rt) { h16x4 o; o[0] = (h16)cc[rt][ct][0]; o[1] = (h16)cc[rt][ct][1]; o[2] = (h16)cc[rt][ct][2]; o[3] = (h16)cc[rt][ct][3];
                            *(h16x4*)(XT + (64 * hw + 16 * ct + lr) * 40 + 16 * rt + 4 * lq) = o; }
                    __builtin_amdgcn_fence(__ATOMIC_RELEASE, "wavefront");
                    __builtin_amdgcn_wave_barrier();
#pragma unroll
                    for (int i8 = 0; i8 < 4; ++i8) { const h16x8 cv = *(const h16x8*)(XT + ht * 40 + 8 * i8);
#pragma unroll
                        for (int jj = 0; jj < 8; ++jj) x[32 + 8 * i8 + jj] -= (float)cv[jj]; }
                }
                SUB_LOAD(ab0, 33, 32);
#pragma unroll
                for (int i = 33; i < 63; i += 2) {
                    { float a0 = 0.f, a1 = 0.f, a2 = 0.f, a3 = 0.f; SUB_LOAD(ab1, i + 1, 32); __builtin_amdgcn_sched_barrier(0); SUB_FMA(ab0, i, 32); x[i] -= (a0 + a1) + (a2 + a3); }
                    { float a0 = 0.f, a1 = 0.f, a2 = 0.f, a3 = 0.f; SUB_LOAD(ab0, i + 2, 32); __builtin_amdgcn_sched_barrier(0); SUB_FMA(ab1, i + 1, 32); x[i + 1] -= (a0 + a1) + (a2 + a3); }
                }
                { float a0 = 0.f, a1 = 0.f, a2 = 0.f, a3 = 0.f; SUB_FMA(ab0, 63, 32); x[63] -= (a0 + a1) + (a2 + a3); }
#undef SUB_LOAD
#undef SUB_FMA
            }
            if (ht < 128) { h16* up = UT + (size_t)itm * 8192 + (size_t)ht * 64;
#pragma unroll
                for (int i8 = 0; i8 < 8; ++i8) { h16x8 o;
#pragma unroll
                    for (int jj = 0; jj < 8; ++jj) o[jj] = (h16)x[8 * i8 + jj];
                    *(h16x8*)(up + 8 * i8) = o; } }
            else { h16* wp = WW + (size_t)itm * 8192 + (ht - 128);
#pragma unroll
                for (int i = 0; i < 64; ++i) wp[(size_t)i * 128] = (h16)x[i]; }
        }
    }
}

__device__ __forceinline__ void phase_gdn_chunk_scan(const Args& a, unsigned char* smem) {
    const int tid = threadIdx.x, wid = tid >> 6, l = tid & 63, lr = l & 15, lq = l >> 4;
    const int ib = wid & 3, vp = wid >> 2;
    const h16* qkv = (const h16*)(a.ws + WS_QKV);
    const h16* UT = (const h16*)(a.ws + WS_UT); const h16* WW = (const h16*)(a.ws + WS_WW); const h16* AQ = (const h16*)(a.ws + WS_AQ); const float* GC = (const float*)(a.ws + WS_GC);
    h16* obuf = (h16*)(a.ws + WS_OBUF);
    h16* ST = (h16*)smem;
    h16* vnT = ST + 64 * 136;
    h16* vsT = vnT + 64 * 72;
    h16* kT = vsT + 64 * 72;
    for (int it = blockIdx.x; it < 256; it += gridDim.x) {
        const int seq = it >> 1, vhalf = it & 1, b = seq >> 4, hv = seq & 15, hq = hv >> 1, v0 = vhalf * 64;
        __syncthreads();
        for (int e = tid; e < 64 * 136 / 8; e += NTHREADS) *(h16x8*)(ST + e * 8) = pack8((f32x4){0.f, 0.f, 0.f, 0.f}, (f32x4){0.f, 0.f, 0.f, 0.f});
        f32x4 Sacc[4];
#pragma unroll
        for (int vt = 0; vt < 4; ++vt) Sacc[vt] = (f32x4){0.f, 0.f, 0.f, 0.f};
        h16x8 wf[4], qf[4], af[2], ks0, ks1; h16x4 ut[2]; f32x4 gcr; float gl;
        const int si = tid >> 3, skg = tid & 7;
#define GDN_LOAD(c) do { const int itm_ = seq * NCH + (c); const int rowb_ = b * TP + 64 * (c); \
            _Pragma("unroll") for (int ks = 0; ks < 4; ++ks) { wf[ks] = *(const h16x8*)(WW + (size_t)itm_ * 8192 + (size_t)(16 * ib + lr) * 128 + 32 * ks + 8 * lq); \
                qf[ks] = *(const h16x8*)(qkv + (size_t)(rowb_ + 16 * ib + lr) * 4096 + hq * 128 + 32 * ks + 8 * lq); } \
            _Pragma("unroll") for (int k2 = 0; k2 < 2; ++k2) af[k2] = *(const h16x8*)(AQ + (size_t)itm_ * 4096 + (size_t)(16 * ib + lr) * 64 + 32 * k2 + 8 * lq); \
            _Pragma("unroll") for (int vt = 0; vt < 2; ++vt) ut[vt] = *(const h16x4*)(UT + (size_t)itm_ * 8192 + (size_t)(v0 + 16 * (2 * vp + vt) + lr) * 64 + 16 * ib + 4 * lq); \
            gcr = *(const f32x4*)(GC + (size_t)itm_ * 64 + 16 * ib + 4 * lq); gl = GC[(size_t)itm_ * 64 + 63]; \
            { const h16* kp_ = qkv + (size_t)(rowb_ + si) * 4096 + 1024 + hq * 128 + 16 * skg; ks0 = *(const h16x8*)kp_; ks1 = *(const h16x8*)(kp_ + 8); } } while (0)
        GDN_LOAD(0);
        for (int c = 0; c < NCH; ++c) {
            const int rowb = b * TP + 64 * c, nval = (TP - 64 * c) < 64 ? (TP - 64 * c) : 64;
            __syncthreads();
#pragma unroll
            for (int jj = 0; jj < 8; ++jj) { kT[(16 * skg + jj) * 72 + si] = ks0[jj]; kT[(16 * skg + 8 + jj) * 72 + si] = ks1[jj]; }
            f32x4 c1[2], c2[2];
#pragma unroll
            for (int vt = 0; vt < 2; ++vt) { c1[vt] = (f32x4){0.f, 0.f, 0.f, 0.f}; c2[vt] = (f32x4){0.f, 0.f, 0.f, 0.f}; }
#pragma unroll
            for (int vt = 0; vt < 2; ++vt)
#pragma unroll
                for (int ks = 0; ks < 4; ++ks) { const h16x8 bf = *(const h16x8*)(ST + (16 * (2 * vp + vt) + lr) * 136 + 32 * ks + 8 * lq);
                    c1[vt] = __builtin_amdgcn_mfma_f32_16x16x32_f16(wf[ks], bf, c1[vt], 0, 0, 0); c2[vt] = __builtin_amdgcn_mfma_f32_16x16x32_f16(qf[ks], bf, c2[vt], 0, 0, 0); }
            const float egl = fexp_(gl);
            f32x4 eg, es;
#pragma unroll
            for (int r = 0; r < 4; ++r) { eg[r] = fexp_(gcr[r]); es[r] = fexp_(gl - gcr[r]); }
#pragma unroll
            for (int vt = 0; vt < 2; ++vt) { h16x4 vn, vs;
#pragma unroll
                for (int r = 0; r < 4; ++r) { const float x = (float)ut[vt][r] - c1[vt][r]; vn[r] = (h16)x; vs[r] = (h16)(x * es[r]); }
                *(h16x4*)(vnT + (16 * (2 * vp + vt) + lr) * 72 + 16 * ib + 4 * lq) = vn; *(h16x4*)(vsT + (16 * (2 * vp + vt) + lr) * 72 + 16 * ib + 4 * lq) = vs; }
            const h16x8 afc0 = af[0], afc1 = af[1];
            __syncthreads();
            if (c + 1 < NCH) GDN_LOAD(c + 1);
#pragma unroll
            for (int vt = 0; vt < 2; ++vt) {
                f32x4 c3 = (f32x4){0.f, 0.f, 0.f, 0.f};
                c3 = __builtin_amdgcn_mfma_f32_16x16x32_f16(afc0, *(const h16x8*)(vnT + (16 * (2 * vp + vt) + lr) * 72 + 8 * lq), c3, 0, 0, 0);
                c3 = __builtin_amdgcn_mfma_f32_16x16x32_f16(afc1, *(const h16x8*)(vnT + (16 * (2 * vp + vt) + lr) * 72 + 32 + 8 * lq), c3, 0, 0, 0);
#pragma unroll
                for (int r = 0; r < 4; ++r) { const int i = 16 * ib + 4 * lq + r;
                    if (i < nval) obuf[(size_t)(rowb + i) * 2048 + hv * 128 + v0 + 16 * (2 * vp + vt) + lr] = (h16)(eg[r] * c2[vt][r] + c3[r]); }
            }
            const h16x8 ka0 = *(const h16x8*)(kT + (16 * wid + lr) * 72 + 8 * lq), ka1 = *(const h16x8*)(kT + (16 * wid + lr) * 72 + 32 + 8 * lq);
#pragma unroll
            for (int vt = 0; vt < 4; ++vt) {
                Sacc[vt] = Sacc[vt] * egl;
                Sacc[vt] = __builtin_amdgcn_mfma_f32_16x16x32_f16(ka0, *(const h16x8*)(vsT + (16 * vt + lr) * 72 + 8 * lq), Sacc[vt], 0, 0, 0);
                Sacc[vt] = __builtin_amdgcn_mfma_f32_16x16x32_f16(ka1, *(const h16x8*)(vsT + (16 * vt + lr) * 72 + 32 + 8 * lq), Sacc[vt], 0, 0, 0);
                h16x4 sh;
#pragma unroll
                for (int r = 0; r < 4; ++r) sh[r] = (h16)Sacc[vt][r];
                *(h16x4*)(ST + (16 * vt + lr) * 136 + 16 * wid + 4 * lq) = sh;
            }
        }
#undef GDN_LOAD
        float* so = a.out + O_PG + ((size_t)(b * 16 + hv) * 128 + 16 * wid + 4 * lq) * 128 + v0 + lr;
#pragma unroll
        for (int vt = 0; vt < 4; ++vt)
#pragma unroll
            for (int r = 0; r < 4; ++r) so[(size_t)r * 128 + 16 * vt] = Sacc[vt][r];
    }
}

__device__ __forceinline__ void phase_gdn_gate(const Args& a) {
    const int lane = threadIdx.x & 63, wid = threadIdx.x >> 6;
    const h16* obuf = (const h16*)(a.ws + WS_OBUF); const h16* z = (const h16*)(a.ws + WS_Z); h16* og = (h16*)(a.ws + WS_OG);
    const f32x4 gw0 = *(const f32x4*)(a.in[I_GNW] + (lane & 15) * 8), gw1 = *(const f32x4*)(a.in[I_GNW] + (lane & 15) * 8 + 4);
    for (int row = blockIdx.x * 8 + wid; row < NR; row += gridDim.x * 8) {
        f32x4 o0[4], o1[4]; h16x8 zz[4], oh[4];
#pragma unroll
        for (int j = 0; j < 4; ++j) { const size_t e = (size_t)row * 2048 + j * 512 + lane * 8; oh[j] = *(const h16x8*)(obuf + e); zz[j] = *(const h16x8*)(z + e); }
#pragma unroll
        for (int j = 0; j < 4; ++j) { o0[j] = (f32x4){(float)oh[j][0], (float)oh[j][1], (float)oh[j][2], (float)oh[j][3]}; o1[j] = (f32x4){(float)oh[j][4], (float)oh[j][5], (float)oh[j][6], (float)oh[j][7]}; }
#pragma unroll
        for (int j = 0; j < 4; ++j) {
            const float ss = red16(sq4(o0[j]) + sq4(o1[j]));
            const float sc = rsqrtf(ss * (1.0f / 128.0f) + 1e-6f);
            h16x8 r;
#pragma unroll
            for (int i = 0; i < 4; ++i) { r[i] = (h16)(o0[j][i] * sc * gw0[i] * siluf_((float)zz[j][i])); r[4 + i] = (h16)(o1[j][i] * sc * gw1[i] * siluf_((float)zz[j][4 + i])); }
            *(h16x8*)(og + (size_t)row * 2048 + j * 512 + lane * 8) = r;
        }
    }
}

__device__ __forceinline__ void phase_shift(const Args& a) {
    const int lane = threadIdx.x & 63, wid = threadIdx.x >> 6;
    const float* x1 = (const float*)(a.ws + WS_X1); h16* xs = (h16*)(a.ws + WS_XS);
    const float* nw = a.in[I_NW] + DM; const float* mu = a.in[I_MU];
    for (int pr = blockIdx.x * 8 + wid; pr < NR / 2; pr += gridDim.x * 8) {
        const int row = pr * 2;
        int b, t; bool samp; row_bt(row, b, t, samp);
        f32x4 xa[4], xb[4], xp[4];
#pragma unroll
        for (int i = 0; i < 4; ++i) { xa[i] = *(const f32x4*)(x1 + (size_t)row * DM + i * 256 + lane * 4); xb[i] = *(const f32x4*)(x1 + (size_t)(row + 1) * DM + i * 256 + lane * 4); }
        if (t > 0) {
#pragma unroll
            for (int i = 0; i < 4; ++i) xp[i] = *(const f32x4*)(x1 + (size_t)(row - 1) * DM + i * 256 + lane * 4); }
        else if (samp) {
#pragma unroll
            for (int i = 0; i < 4; ++i) xp[i] = *(const f32x4*)(a.in[I_SRS] + (size_t)b * DM + i * 256 + lane * 4); }
        else {
#pragma unroll
            for (int i = 0; i < 4; ++i) xp[i] = (f32x4){0.f, 0.f, 0.f, 0.f}; }
        float sa = 0.f, sb = 0.f, sp = 0.f;
#pragma unroll
        for (int i = 0; i < 4; ++i) { sa += sq4(xa[i]); sb += sq4(xb[i]); sp += sq4(xp[i]); }
        sa = wsum(sa); sb = wsum(sb);
        const float ca = rsqrtf(sa * (1.0f / 1024.0f) + 1e-6f), cb = rsqrtf(sb * (1.0f / 1024.0f) + 1e-6f);
        float cp = 1.0f;
        if (t > 0) { sp = wsum(sp); cp = rsqrtf(sp * (1.0f / 1024.0f) + 1e-6f); }
#pragma unroll
        for (int i = 0; i < 4; ++i) { const f32x4 w = *(const f32x4*)(nw + i * 256 + lane * 4); xa[i] = xa[i] * ca * w; xb[i] = xb[i] * cb * w; if (t > 0) xp[i] = xp[i] * cp * w; }
        for (int s = 0; s < 6; ++s) {
#pragma unroll
            for (int i = 0; i < 4; ++i) { const f32x4 m = *(const f32x4*)(mu + (size_t)s * DM + i * 256 + lane * 4);
                const f32x4 r0 = xa[i] + (xp[i] - xa[i]) * m, r1 = xb[i] + (xa[i] - xb[i]) * m;
                h16x4 o0, o1; o0[0] = (h16)r0[0]; o0[1] = (h16)r0[1]; o0[2] = (h16)r0[2]; o0[3] = (h16)r0[3]; o1[0] = (h16)r1[0]; o1[1] = (h16)r1[1]; o1[2] = (h16)r1[2]; o1[3] = (h16)r1[3];
                *(h16x4*)(xs + ((size_t)s * MP + row) * DM + i * 256 + lane * 4) = o0; *(h16x4*)(xs + ((size_t)s * MP + row + 1) * DM + i * 256 + lane * 4) = o1; }
        }
        float* so = nullptr;
        if (!samp && t == TP - 2) so = a.out + O_PRS + (size_t)b * DM;
        if (samp && t == 6) so = a.out + O_SRS + (size_t)b * DM;
        if (so) {
#pragma unroll
            for (int i = 0; i < 4; ++i) *(f32x4*)(so + i * 256 + lane * 4) = xb[i]; }
    }
}

__device__ __forceinline__ void phase_rwkv_prep(const Args& a) {
    const int lane = threadIdx.x & 63, wid = threadIdx.x >> 6;
    h16* rkvz = (h16*)(a.ws + WS_RKVZ); const h16* lo = (const h16*)(a.ws + WS_LOUT);
    float* dbuf = (float*)(a.ws + WS_DB); h16* kkb = (h16*)(a.ws + WS_KKB); h16* bbb = (h16*)(a.ws + WS_BBB); float* rkb = (float*)(a.ws + WS_RK); h16* k2b = (h16*)(a.ws + WS_K2);
    float pw0[2][8], pa0[2][8], pkk[2][8], pka[2][8], prk[2][8];
#pragma unroll
    for (int j = 0; j < 2; ++j)
#pragma unroll
        for (int i = 0; i < 8; ++i) { const int c = j * 512 + lane * 8 + i; pw0[j][i] = a.in[I_W0][c]; pa0[j][i] = a.in[I_A0][c]; pkk[j][i] = a.in[I_KK][c]; pka[j][i] = a.in[I_KA][c]; prk[j][i] = a.in[I_RK][c]; }
    for (int row = blockIdx.x * 8 + wid; row < NR; row += gridDim.x * 8) {
        h16x8 r[2], k[2], wl[2], al[2];
#pragma unroll
        for (int j = 0; j < 2; ++j) { const size_t e = (size_t)row * 1024 + j * 512 + lane * 8; const size_t e2 = (size_t)row * 2048 + j * 512 + lane * 8;
            r[j] = *(const h16x8*)(rkvz + e); k[j] = *(const h16x8*)(rkvz + (size_t)MP * 1024 + e); wl[j] = *(const h16x8*)(lo + e2); al[j] = *(const h16x8*)(lo + e2 + 1024); }
#pragma unroll
        for (int j = 0; j < 2; ++j) {
            float kkv[8], aa[8], dd[8]; h16x8 k2o; float ss = 0.f, rk = 0.f;
#pragma unroll
            for (int i = 0; i < 8; ++i) {
                const float w = -softplusf_(-(pw0[j][i] + (float)wl[j][i])) - 0.5f;
                dd[i] = fexp_(-fexp_(w));
                aa[i] = sigmoidf_(pa0[j][i] + (float)al[j][i]);
                const float kf = (float)k[j][i];
                kkv[i] = kf * pkk[j][i]; ss += kkv[i] * kkv[i];
                const float k2 = kf * (1.0f + (aa[i] - 1.0f) * pka[j][i]);
                rk += (float)r[j][i] * k2 * prk[j][i];
                k2o[i] = (h16)k2;
            }
            ss = red8(ss); rk = red8(rk);
            const float inv = rsqrtf(ss + 1e-6f);
            h16x8 kko, bbo;
#pragma unroll
            for (int i = 0; i < 8; ++i) { const float kk = kkv[i] * inv; kko[i] = (h16)kk; bbo[i] = (h16)(kk * aa[i]); }
            const size_t e = (size_t)row * 1024 + j * 512 + lane * 8;
            *(h16x8*)(k2b + e) = k2o; *(h16x8*)(kkb + e) = kko; *(h16x8*)(bbb + e) = bbo;
            *(f32x4*)(dbuf + e) = (f32x4){dd[0], dd[1], dd[2], dd[3]}; *(f32x4*)(dbuf + e + 4) = (f32x4){dd[4], dd[5], dd[6], dd[7]};
            if ((lane & 7) == 0) rkb[(size_t)row * 16 + j * 8 + (lane >> 3)] = rk;
        }
    }
}

struct RwStage { h16x4 r[2], k[2], v[2], kk[2], b[2]; f32x4 d[2]; };
__device__ __forceinline__ void phase_rwkv_scan(const Args& a, float* ldsf) {
    const int tid = threadIdx.x, lane = tid & 63, wid = tid >> 6;
    const bool prod = wid >= 4;
    const int g = lane >> 4, kq = lane & 15;
    const int st = tid & 255, stt = st >> 4, sc4 = (st & 15) * 4;
    const h16* rkvz = (const h16*)(a.ws + WS_RKVZ); const float* dbuf = (const float*)(a.ws + WS_DB); const h16* k2b = (const h16*)(a.ws + WS_K2);
    const h16* kkb = (const h16*)(a.ws + WS_KKB); const h16* bbb = (const h16*)(a.ws + WS_BBB);
    float* ybuf = (float*)(a.ws + WS_YBUF);
#define RW_GLOAD(R, tbase) do { _Pragma("unroll") for (int u_ = 0; u_ < 2; ++u_) { const int tok_ = (tbase) + stt + 16 * u_; if (tok_ < T) { const size_t e_ = (size_t)(row0 + tok_) * 1024 + h * 64 + sc4; \
        R.r[u_] = *(const h16x4*)(rkvz + e_); R.k[u_] = *(const h16x4*)(k2b + e_); R.v[u_] = *(const h16x4*)(rkvz + (size_t)2 * MP * 1024 + e_); R.d[u_] = *(const f32x4*)(dbuf + e_); \
        R.kk[u_] = *(const h16x4*)(kkb + e_); R.b[u_] = *(const h16x4*)(bbb + e_); } } } while (0)
#define RW_LWRITE(R, Lb) do { _Pragma("unroll") for (int u_ = 0; u_ < 2; ++u_) { float* p_ = (Lb) + (stt + 16 * u_) * 64 + sc4; \
        *(f32x4*)p_ = (f32x4){(float)R.r[u_][0], (float)R.r[u_][1], (float)R.r[u_][2], (float)R.r[u_][3]}; \
        *(f32x4*)(p_ + 2048) = (f32x4){(float)R.k[u_][0], (float)R.k[u_][1], (float)R.k[u_][2], (float)R.k[u_][3]}; \
        *(f32x4*)(p_ + 4096) = R.d[u_]; \
        *(f32x4*)(p_ + 6144) = (f32x4){(float)R.kk[u_][0], (float)R.kk[u_][1], (float)R.kk[u_][2], (float)R.kk[u_][3]}; \
        *(f32x4*)(p_ + 8192) = (f32x4){(float)R.b[u_][0], (float)R.b[u_][1], (float)R.b[u_][2], (float)R.b[u_][3]}; \
        *(f32x4*)(p_ + 10240) = (f32x4){(float)R.v[u_][0], (float)R.v[u_][1], (float)R.v[u_][2], (float)R.v[u_][3]}; } } while (0)
    for (int it = blockIdx.x; it < 256 + 4096; it += gridDim.x) {
        const bool samp = it >= 256; const int q = samp ? it - 256 : it;
        const int seq = q >> 1, half = q & 1, b = seq >> 4, h = seq & 15;
        const int T = samp ? 8 : TP, row0 = samp ? NPR + b * 8 : b * TP;
        const int v0 = half * 32 + (wid & 3) * 8 + g * 2;
        f32x4 S0 = {0.f, 0.f, 0.f, 0.f}, S1 = {0.f, 0.f, 0.f, 0.f};
        if (!prod && samp) { const float* sp = a.in[I_SR] + ((size_t)(b * 16 + h) * 64 + v0) * 64 + kq * 4; S0 = *(const f32x4*)sp; S1 = *(const f32x4*)(sp + 64); }
        RwStage RA = {}, RB = {};
        if (prod) { RW_GLOAD(RA, 0); RW_GLOAD(RB, 32); }
        __syncthreads();
        for (int t0 = 0; t0 < T; t0 += 64) {
#pragma unroll
            for (int par = 0; par < 2; ++par) {
                const int tb = t0 + 32 * par;
                if (tb >= T) break;
                float* Lb = ldsf + par * 12288;
                if (prod) { if (par == 0) RW_LWRITE(RA, Lb); else RW_LWRITE(RB, Lb); }
                __syncthreads();
                if (prod) {
                    if (par == 0) RW_GLOAD(RA, tb + 64); else RW_GLOAD(RB, tb + 64);
                } else {
                    for (int hh = 0; hh < 4; ++hh) {
                        if (tb + hh * 8 >= T) break;
                        float ya[8], yb[8];
                        f32x4 Rr[2], Rk[2], Rd[2], Rq[2], Rb[2]; f32x2 Rv[2];
#define RW_LOAD(slot, idx) do { const float* p_ = Lb + (idx) * 64 + kq * 4; \
                            Rq[slot] = *(const f32x4*)(p_ + 6144); Rd[slot] = *(const f32x4*)(p_ + 4096); Rb[slot] = *(const f32x4*)(p_ + 8192); Rk[slot] = *(const f32x4*)(p_ + 2048); \
                            Rr[slot] = *(const f32x4*)p_; Rv[slot] = *(const f32x2*)(Lb + 10240 + (idx) * 64 + v0); } while (0)
                        RW_LOAD(0, hh * 8);
#pragma unroll
                        for (int t8 = 0; t8 < 8; ++t8) {
                            const int sl = t8 & 1;
                            if (t8 < 7) RW_LOAD(sl ^ 1, hh * 8 + t8 + 1);
                            __builtin_amdgcn_sched_barrier(0);
                            const f32x4 rr = Rr[sl], kk2 = Rk[sl], dd = Rd[sl], qq = Rq[sl], bb = Rb[sl]; const f32x2 vv = Rv[sl];
                            const f32x4 m0 = S0 * qq, m1 = S1 * qq;
                            const float nsa0 = -red16((m0[0] + m0[1]) + (m0[2] + m0[3])), nsa1 = -red16((m1[0] + m1[1]) + (m1[2] + m1[3]));
                            S0 = S0 * dd + nsa0 * bb + vv[0] * kk2;
                            S1 = S1 * dd + nsa1 * bb + vv[1] * kk2;
                            const f32x4 n0 = S0 * rr, n1 = S1 * rr;
                            ya[t8] = (n0[0] + n0[1]) + (n0[2] + n0[3]); yb[t8] = (n1[0] + n1[1]) + (n1[2] + n1[3]);
                        }
#undef RW_LOAD
#pragma unroll
                        for (int t8 = 0; t8 < 8; ++t8) { ya[t8] = red16(ya[t8]); yb[t8] = red16(yb[t8]); }
                        f32x2 ysel = {ya[0], yb[0]};
#pragma unroll
                        for (int t8 = 1; t8 < 8; ++t8) { ysel[0] = (kq == t8) ? ya[t8] : ysel[0]; ysel[1] = (kq == t8) ? yb[t8] : ysel[1]; }
                        if (kq < 8) *(f32x2*)(ybuf + (size_t)(row0 + tb + hh * 8 + kq) * 1024 + h * 64 + v0) = ysel;
                    }
                }
            }
        }
        if (!prod) { float* so = a.out + (samp ? O_SR : O_PR) + ((size_t)(b * 16 + h) * 64 + v0) * 64 + kq * 4; *(f32x4*)so = S0; *(f32x4*)(so + 64) = S1; }
    }
#undef RW_GLOAD
#undef RW_LWRITE
}

__device__ __forceinline__ void phase_rwkv_gate(const Args& a) {
    const int lane = threadIdx.x & 63, wid = threadIdx.x >> 6;
    const float* ybuf = (const float*)(a.ws + WS_YBUF); const float* rkb = (const float*)(a.ws + WS_RK);
    const h16* rkvz = (const h16*)(a.ws + WS_RKVZ); h16* yg = (h16*)(a.ws + WS_YG);
    float lw[2][8], lb[2][8];
#pragma unroll
    for (int j = 0; j < 2; ++j)
#pragma unroll
        for (int i = 0; i < 8; ++i) { const int c = j * 512 + lane * 8 + i; lw[j][i] = a.in[I_LNW][c]; lb[j][i] = a.in[I_LNB][c]; }
    for (int row = blockIdx.x * 8 + wid; row < NR; row += gridDim.x * 8) {
        f32x4 y0[2], y1[2]; h16x8 vv[2], zz[2]; float rk[2];
#pragma unroll
        for (int j = 0; j < 2; ++j) { const size_t e = (size_t)row * 1024 + j * 512 + lane * 8;
            y0[j] = *(const f32x4*)(ybuf + e); y1[j] = *(const f32x4*)(ybuf + e + 4); vv[j] = *(const h16x8*)(rkvz + (size_t)2 * MP * 1024 + e); zz[j] = *(const h16x8*)(rkvz + (size_t)3 * MP * 1024 + e);
            rk[j] = rkb[(size_t)row * 16 + j * 8 + (lane >> 3)]; }
#pragma unroll
        for (int j = 0; j < 2; ++j) {
            float y[8] = {y0[j][0], y0[j][1], y0[j][2], y0[j][3], y1[j][0], y1[j][1], y1[j][2], y1[j][3]};
            float sm = 0.f;
#pragma unroll
            for (int i = 0; i < 8; ++i) sm += y[i];
            const float mean = red8(sm) * (1.0f / 64.0f);
            float sv = 0.f;
#pragma unroll
            for (int i = 0; i < 8; ++i) { y[i] -= mean; sv += y[i] * y[i]; }
            const float rs = rsqrtf(red8(sv) * (1.0f / 64.0f) + 64e-5f);
            h16x8 o;
#pragma unroll
            for (int i = 0; i < 8; ++i) { const float yn = y[i] * rs * lw[j][i] + lb[j][i] + rk[j] * (float)vv[j][i]; o[i] = (h16)(yn * siluf_((float)zz[j][i])); }
            *(h16x8*)(yg + (size_t)row * 1024 + j * 512 + lane * 8) = o;
        }
    }
}

__device__ __forceinline__ void phase_final(const Args& a) {
    const int lane = threadIdx.x & 63, wid = threadIdx.x >> 6;
    const float* x2 = (const float*)(a.ws + WS_X2); const float* nw = a.in[I_FNW];
    for (int pr = blockIdx.x * 8 + wid; pr < NR / 2; pr += gridDim.x * 8) {
        const int row = pr * 2;
        int b, t; bool samp; row_bt(row, b, t, samp);
        if (!samp && t < 16) continue;
        float* op = samp ? a.out + O_YS + (size_t)(row - NPR) * DM : a.out + O_YP + ((size_t)b * 2048 + (t - 16)) * DM;
        const float* p = x2 + (size_t)row * DM; f32x4 v[4], u[4]; float ss = 0.f, su = 0.f;
#pragma unroll
        for (int i = 0; i < 4; ++i) { v[i] = *(const f32x4*)(p + i * 256 + lane * 4); u[i] = *(const f32x4*)(p + DM + i * 256 + lane * 4); }
#pragma unroll
        for (int i = 0; i < 4; ++i) { ss += sq4(v[i]); su += sq4(u[i]); }
        ss = wsum(ss); su = wsum(su);
        const float sc = rsqrtf(ss * (1.0f / 1024.0f) + 1e-6f), scu = rsqrtf(su * (1.0f / 1024.0f) + 1e-6f);
#pragma unroll
        for (int i = 0; i < 4; ++i) { const f32x4 w = *(const f32x4*)(nw + i * 256 + lane * 4); *(f32x4*)(op + i * 256 + lane * 4) = v[i] * sc * w; *(f32x4*)(op + DM + i * 256 + lane * 4) = u[i] * scu * w; }
    }
}

constexpr int NPHASE = 15;
#ifndef PROBE_MASK
#define PROBE_MASK 0
#endif
__global__ void __launch_bounds__(NTHREADS, 2) mk_fwd(Args a) {
    extern __shared__ __attribute__((aligned(16))) unsigned char smem[];
    PG8_LAS unsigned char* lds = (PG8_LAS unsigned char*)smem;
    float* ldsf = (float*)smem;
    const int G = gridDim.x, c = blockIdx.x;
#if MK_COOP
    cg::grid_group grid = cg::this_grid();
    __shared__ uint4 xb_words;
    if (threadIdx.x == 0) xb_words = make_uint4(0u, 0u, 0u, 0u);
    __syncthreads();
    const XcdBarrier xbar = xcd_barrier_post((unsigned*)(a.ws + WS_BAR), (volatile PG8_LAS unsigned*)&xb_words);
    if (a.ph_hi > 1000) grid.sync();
#define SEAM(p) do { if ((p) + 1 < a.ph_hi) xcd_barrier(xbar); } while (0)
#else
#define SEAM(p) do { } while (0)
#endif
#define IN(p) (a.ph_lo <= (p) && (p) < a.ph_hi)
#define RUN(p, ...) if (IN(p)) { __syncthreads(); __VA_ARGS__; if ((PROBE_MASK >> (p)) & 1) { __syncthreads(); __VA_ARGS__; } SEAM(p); }
    RUN(0, phase_prep(a, ldsf))
    RUN(1, { pg8::Gemm g{(const h16*)(a.ws + WS_XN0), (const h16*)(a.ws + WS_WIN), MP, 6400, 1024}; pg8::StaticOrder S; S.init(MP, 6400, G, c);
        EpiProj E{(h16*)(a.ws + WS_QKVPRE), (h16*)(a.ws + WS_Z), (float*)(a.ws + WS_BA)};
        pg8::gemm_phase<EpiProj, pg8::StaticOrder>(lds, g, S, E); })
    RUN(2, phase_conv(a, ldsf))
    RUN(3, phase_gdn_pre(a, ldsf))
    RUN(4, { phase_gdn_chunk_scan(a, smem); __syncthreads(); phase_gdn_scan(a, ldsf); })
    RUN(5, phase_gdn_gate(a))
    RUN(6, { pg8::Gemm g{(const h16*)(a.ws + WS_OG), (const h16*)(a.ws + WS_WOUT), MP, 1024, 2048}; pg8::StaticOrder S; S.init(MP, 1024, G, c);
        EpiResX E{a.in[I_META], a.in[I_XP], a.in[I_XS], (float*)(a.ws + WS_X1)};
        pg8::gemm_phase<EpiResX, pg8::StaticOrder>(lds, g, S, E); })
    RUN(7, phase_shift(a))
    RUN(8, { pg8::Gemm g{(const h16*)(a.ws + WS_XS), (const h16*)(a.ws + WS_WR), 6 * MP, 4608, 1024}; OrderG S; S.init(G, c);
        EpiG E{(h16*)(a.ws + WS_RKVZ), (h16*)(a.ws + WS_LH)};
        pg8::gemm_phase<EpiG, OrderG>(lds, g, S, E); })
    RUN(9, { pg8::Gemm g{(const h16*)(a.ws + WS_LH), (const h16*)(a.ws + WS_WL2), MP, 2048, 256}; pg8::StaticOrder S; S.init(MP, 2048, G, c);
        EpiH16 E{(h16*)(a.ws + WS_LOUT), 2048};
        pg8::gemm_phase<EpiH16, pg8::StaticOrder>(lds, g, S, E); })
    RUN(10, phase_rwkv_prep(a))
    RUN(11, phase_rwkv_scan(a, ldsf))
    RUN(12, phase_rwkv_gate(a))
    RUN(13, { pg8::Gemm g{(const h16*)(a.ws + WS_YG), (const h16*)(a.ws + WS_WO), MP, 1024, 1024}; pg8::StaticOrder S; S.init(MP, 1024, G, c);
        EpiResB E{(const float*)(a.ws + WS_X1), (float*)(a.ws + WS_X2)};
        pg8::gemm_phase<EpiResB, pg8::StaticOrder>(lds, g, S, E); })
    RUN(14, phase_final(a))
#undef RUN
#undef IN
#undef SEAM
}

extern "C" void kernel_launch(void* const* d_in, const int* in_sizes, int n_in, void* d_out, int out_size, void* d_ws, size_t ws_size, hipStream_t stream) {
    static int grid = 0;
    if (grid == 0) {
        if (n_in != 29 || ws_size < WS_END) { fprintf(stderr, "kernel_launch: unexpected n_in %d or ws_size %zu (< %zu)\n", n_in, ws_size, (size_t)WS_END); grid = -1; return; }
        int dev = 0, cus = 0, per_cu = 0;
        hipGetDevice(&dev); hipDeviceGetAttribute(&cus, hipDeviceAttributeMultiprocessorCount, dev);
        if (hipFuncSetAttribute((const void*)mk_fwd, hipFuncAttributeMaxDynamicSharedMemorySize, LDS_BYTES) != hipSuccess) { fprintf(stderr, "kernel_launch: hipFuncSetAttribute failed\n"); }
        if (hipOccupancyMaxActiveBlocksPerMultiprocessor(&per_cu, (const void*)mk_fwd, NTHREADS, LDS_BYTES) != hipSuccess || per_cu < 1) { fprintf(stderr, "kernel_launch: occupancy query gave %d\n", per_cu); per_cu = 1; }
        (void)hipGetLastError();
        grid = cus * 1;
        if (grid <= 0) grid = 256;
    }
    if (grid < 0) return;
    Args a; memset(&a, 0, sizeof(a));
    for (int i = 0; i < 29; ++i) a.in[i] = (const float*)d_in[i];
    a.out = (float*)d_out; a.ws = (unsigned char*)d_ws;
#if MK_COOP
    a.ph_lo = 0; a.ph_hi = NPHASE;
    if (hipMemsetAsync((unsigned char*)d_ws + WS_BAR, 0, 16384, stream) != hipSuccess) fprintf(stderr, "kernel_launch: memset of barrier words failed\n");
    void* args[] = {&a};
    hipError_t e = hipLaunchCooperativeKernel((const void*)mk_fwd, dim3(grid), dim3(NTHREADS), args, LDS_BYTES, stream);
    if (e != hipSuccess) fprintf(stderr, "cooperative launch failed: %s (grid %d)\n", hipGetErrorString(e), grid);
#else
    for (int p = 0; p < NPHASE; ++p) { a.ph_lo = p; a.ph_hi = p + 1; hipLaunchKernelGGL(mk_fwd, dim3(grid), dim3(NTHREADS), LDS_BYTES, stream, a); }
#endif
}
```
